# Optimizing an MI355X kernel written in HIP

```python
import jax, jax.numpy as jnp
from jax import lax
import numpy as np

D_MODEL = 2048
BATCH = 1
SEQ = 8192
DEPTH = 2
DEC_BATCH = 16
DEC_SEQ = 32
PAST_LEN = 2048

CHUNK = 64
N_EVEN = (DEPTH + 1) // 2
N_ODD = DEPTH // 2
EPS = 1e-6
HEAD_DIM = 64
A_HEADS = D_MODEL // 2 // HEAD_DIM
A_KV_HEADS = A_HEADS // 4
A_GROUP = A_HEADS // A_KV_HEADS
WINDOW = 128
WIN_CHUNKS = WINDOW // CHUNK
ROT_DIM = HEAD_DIM // 4
ROPE_THETA = 500000.0
A_WIDTH = A_HEADS * HEAD_DIM
KV_WIDTH = A_KV_HEADS * HEAD_DIM
GMLP_CHUNK = 128
GMLP_DIM = 128
B_GROUPS = D_MODEL // 2 // GMLP_DIM
B_WIDTH = B_GROUPS * GMLP_DIM
EVEN_IN = A_WIDTH + 2 * KV_WIDTH + 2 * B_WIDTH
EVEN_OUT = A_WIDTH + B_WIDTH
C_HEAD_DIM = 128
C_HEADS = D_MODEL // C_HEAD_DIM
C_WIDTH = C_HEADS * C_HEAD_DIM
ODD_IN = 4 * C_WIDTH
HGRN_BLOCK = 16
D_FF = 4 * D_MODEL

kernel_name = 'hybrid_streaming_swa_gmlp_hgrn2_step'


def rms_norm(x, g):
    xf = x.astype(jnp.float32)
    y = xf * lax.rsqrt(jnp.mean(xf * xf, axis=-1, keepdims=True) + EPS)
    return (y * g.astype(jnp.float32)).astype(x.dtype)


def layer_norm(x, g):
    xf = x.astype(jnp.float32)
    mu = jnp.mean(xf, axis=-1, keepdims=True)
    xc = xf - mu
    y = xc * lax.rsqrt(jnp.mean(xc * xc, axis=-1, keepdims=True) + EPS)
    return (y * g.astype(jnp.float32)).astype(x.dtype)


def partial_rope(x, pos):
    half = ROT_DIM // 2
    inv = ROPE_THETA ** (-(jnp.arange(half, dtype=jnp.float32) * (2.0 / ROT_DIM)))
    ang = pos.astype(jnp.float32)[:, None] * inv[None, :]
    cos = jnp.cos(ang)[None, :, None, :]
    sin = jnp.sin(ang)[None, :, None, :]
    xr = x[..., :ROT_DIM].astype(jnp.float32)
    x1, x2 = xr[..., :half], xr[..., half:]
    rot = jnp.concatenate([x1 * cos - x2 * sin, x2 * cos + x1 * sin], axis=-1).astype(x.dtype)
    return jnp.concatenate([rot, x[..., ROT_DIM:]], axis=-1)


def sink_attention(q, k, v, sinks, mask):
    s = jnp.einsum('...qkgd,...skd->...kgqs', q, k, preferred_element_type=jnp.float32) * (HEAD_DIM ** -0.5)
    if mask is not None:
        s = jnp.where(mask, s, -jnp.inf)
    sink = jnp.broadcast_to(sinks.astype(jnp.float32)[:, :, None, None], s.shape[:-1] + (1,))
    p = jax.nn.softmax(jnp.concatenate([s, sink], axis=-1), axis=-1)[..., :-1]
    return jnp.einsum('...kgqs,...skd->...qkgd', p.astype(v.dtype), v)


def swa_prompt(q, k, v, sinks):
    B, S = q.shape[:2]
    nb = S // CHUNK
    qb = q.reshape(B, nb, CHUNK, A_KV_HEADS, A_GROUP, HEAD_DIM)
    pad = ((0, 0), (WIN_CHUNKS * CHUNK, 0), (0, 0), (0, 0))

    def band(t):
        tb = jnp.pad(t, pad).reshape(B, nb + WIN_CHUNKS, CHUNK, A_KV_HEADS, HEAD_DIM)
        return jnp.concatenate([tb[:, j:j + nb] for j in range(WIN_CHUNKS + 1)], axis=2)

    blk = jnp.arange(nb)[:, None] + jnp.arange(WIN_CHUNKS + 1)[None, :] - WIN_CHUNKS
    valid = jnp.repeat(blk >= 0, CHUNK, axis=1)
    mask = valid[:, None, None, None, :]
    o = sink_attention(qb, band(k), band(v), sinks, mask)
    return o.reshape(B, S, A_WIDTH)


def chunk_gmlp(u, v, ws, bias):
    B, T = v.shape[:2]
    tp = -(-T // GMLP_CHUNK) * GMLP_CHUNK
    vp = jnp.pad(v, ((0, 0), (0, tp - T), (0, 0), (0, 0)))
    vp = vp.reshape(B, tp // GMLP_CHUNK, GMLP_CHUNK, B_GROUPS, GMLP_DIM)
    cidx = jnp.arange(GMLP_CHUNK) // CHUNK
    w = jnp.where(cidx[None, :, None] >= cidx[None, None, :], ws, 0.0).astype(v.dtype)
    mixed = jnp.einsum('hpq,bcqhd->bcphd', w, vp) + bias.T.astype(v.dtype)[None, None, :, :, None]
    mixed = mixed.reshape(B, tp, B_GROUPS, GMLP_DIM)[:, :T]
    return u * mixed


def even_layer(xn, pos, w_in, w_out, sinks, g_vnorm, ws, bias, cache_k, cache_v):
    B, T, _ = xn.shape
    cuts = [A_WIDTH, A_WIDTH + KV_WIDTH, A_WIDTH + 2 * KV_WIDTH, A_WIDTH + 2 * KV_WIDTH + B_WIDTH]
    q, k, v, zu, zv = jnp.split(xn @ w_in, cuts, axis=-1)
    q = partial_rope(q.reshape(B, T, A_HEADS, HEAD_DIM), pos)
    k = partial_rope(k.reshape(B, T, A_KV_HEADS, HEAD_DIM), pos)
    v = v.reshape(B, T, A_KV_HEADS, HEAD_DIM)
    sk = sinks.reshape(A_KV_HEADS, A_GROUP)
    if cache_k is None:
        a = swa_prompt(q, k, v, sk)
        k_all, v_all = k, v
    else:
        k_all = jnp.concatenate([cache_k, k], axis=1)
        v_all = jnp.concatenate([cache_v, v], axis=1)
        qg = q.reshape(B, T, A_KV_HEADS, A_GROUP, HEAD_DIM)
        a = sink_attention(qg, k_all, v_all, sk, None).reshape(B, T, A_WIDTH)
    u = jax.nn.gelu(zu).reshape(B, T, B_GROUPS, GMLP_DIM)
    gv = layer_norm(jax.nn.gelu(zv).reshape(B, T, B_GROUPS, GMLP_DIM), g_vnorm.reshape(B_GROUPS, GMLP_DIM))
    b = chunk_gmlp(u, gv, ws, bias).reshape(B, T, B_WIDTH)
    y = jnp.concatenate([a, b], axis=-1) @ w_out
    return y, k_all[:, -WINDOW:], v_all[:, -WINDOW:], gv


def hgrn2_recurrence(q, k, v, logf, s0, block):
    B, T, H, _ = q.shape
    n = T // block

    def blocks(t):
        return jnp.moveaxis(t.reshape(B, n, block, H, t.shape[-1]), 1, 0)

    tri = jnp.tril(jnp.ones((block, block), dtype=bool))[None, :, :, None, None]

    def step(S, inp):
        qc, kc, vc, lfc = inp
        b = jnp.cumsum(lfc, axis=1)
        dec = jnp.exp(jnp.where(tri, b[:, :, None] - b[:, None, :], -jnp.inf))
        scores = jnp.einsum('bthd,bshd,btshd->bhts', qc, kc, dec)
        o = jnp.einsum('bhts,bshe->bthe', scores, vc) + jnp.einsum('bthd,bhde->bthe', qc * jnp.exp(b), S)
        b_last = b[:, -1]
        S = jnp.exp(b_last)[..., None] * S + jnp.einsum('bshd,bshe->bhde', kc * jnp.exp(b_last[:, None] - b), vc)
        return S, o

    S, o = lax.scan(step, s0, (blocks(q), blocks(k), blocks(v), blocks(logf)))
    return jnp.moveaxis(o, 0, 1).reshape(B, T, H, v.shape[-1]), S


def odd_layer(xn, w_in, w_out, lb, g_onorm, state0, block):
    B, T, _ = xn.shape
    zq, zf, zi, zg = jnp.split(xn @ w_in, 4, axis=-1)
    shp = (B, T, C_HEADS, C_HEAD_DIM)
    f = lb + (1.0 - lb) * jax.nn.sigmoid(zf.astype(jnp.float32))
    q = jax.nn.silu(zq.astype(jnp.float32)).reshape(shp)
    k = (1.0 - f).reshape(shp)
    logf = jnp.log(f).reshape(shp)
    o, S = hgrn2_recurrence(q, k, zi.astype(jnp.float32).reshape(shp), logf, state0.astype(jnp.float32), block)
    o = rms_norm(o, g_onorm.reshape(C_HEADS, C_HEAD_DIM)).reshape(B, T, C_WIDTH)
    o = (o * jax.nn.sigmoid(zg.astype(jnp.float32))).astype(xn.dtype)
    return o @ w_out, S


def sq_relu_mlp(xn, w_up, w_down):
    return jnp.square(jax.nn.relu(xn @ w_up)) @ w_down


def setup_inputs(seed: int = 0) -> dict:
    key = jax.random.key(seed)
    ks = jax.random.split(key, 21)

    def nrm(k, shape, scale):
        return jax.random.normal(k, shape, jnp.float32) * scale

    return {
        'x_prompt': nrm(ks[0], (BATCH, SEQ, D_MODEL), 1.0),
        'x_sample': nrm(ks[1], (DEC_BATCH, DEC_SEQ, D_MODEL), 1.0),
        'cache_swa_k': nrm(ks[2], (N_EVEN, DEC_BATCH, WINDOW, A_KV_HEADS, HEAD_DIM), 1.0),
        'cache_swa_v': nrm(ks[3], (N_EVEN, DEC_BATCH, WINDOW, A_KV_HEADS, HEAD_DIM), 1.0),
        'state_hgrn': nrm(ks[4], (N_ODD, DEC_BATCH, C_HEADS, C_HEAD_DIM, C_HEAD_DIM), 0.5),
        'norm_mix': 1.0 + nrm(ks[5], (DEPTH, D_MODEL), 0.02),
        'norm_ffn': 1.0 + nrm(ks[6], (DEPTH, D_MODEL), 0.02),
        'norm_final': 1.0 + nrm(ks[7], (D_MODEL,), 0.02),
        'w_in_even': nrm(ks[8], (N_EVEN, D_MODEL, EVEN_IN), D_MODEL ** -0.5),
        'w_out_even': nrm(ks[9], (N_EVEN, EVEN_OUT, D_MODEL), EVEN_OUT ** -0.5),
        'attn_sinks': nrm(ks[10], (N_EVEN, A_HEADS), 1.0),
        'gmlp_vnorm': 1.0 + nrm(ks[11], (N_EVEN, B_WIDTH), 0.02),
        'gmlp_ws': nrm(ks[12], (N_EVEN, B_GROUPS, GMLP_CHUNK, GMLP_CHUNK), GMLP_CHUNK ** -0.5),
        'gmlp_bias': 1.0 + nrm(ks[13], (N_EVEN, B_GROUPS, GMLP_CHUNK), 0.1),
        'w_in_odd': nrm(ks[14], (N_ODD, D_MODEL, ODD_IN), D_MODEL ** -0.5),
        'w_out_odd': nrm(ks[15], (N_ODD, C_WIDTH, D_MODEL), C_WIDTH ** -0.5),
        'hgrn_lb': 1.0 + nrm(ks[16], (DEPTH, C_WIDTH), 0.1),
        'hgrn_onorm': 1.0 + nrm(ks[17], (N_ODD, C_WIDTH), 0.02),
        'w_ffn_up': nrm(ks[18], (DEPTH, D_MODEL, D_FF), D_MODEL ** -0.5),
        'w_ffn_down': nrm(ks[19], (DEPTH, D_FF, D_MODEL), D_FF ** -0.5),
    }


def reference(x_prompt, x_sample, cache_swa_k, cache_swa_v, state_hgrn, norm_mix, norm_ffn, norm_final,
              w_in_even, w_out_even, attn_sinks, gmlp_vnorm, gmlp_ws, gmlp_bias, w_in_odd, w_out_odd,
              hgrn_lb, hgrn_onorm, w_ffn_up, w_ffn_down):
    pos_p = jnp.arange(x_prompt.shape[1], dtype=jnp.int32)
    pos_s = PAST_LEN + jnp.arange(x_sample.shape[1], dtype=jnp.int32)
    p_lb = jax.nn.softmax(hgrn_lb.astype(jnp.float32), axis=0)
    lb_all = jnp.cumsum(p_lb, axis=0) - p_lb[0]
    hp, hs = x_prompt, x_sample
    kp, vp, ks, vs, gs, sp, ss = [], [], [], [], [], [], []
    for l in range(DEPTH):
        e = l // 2
        xp_n = rms_norm(hp, norm_mix[l])
        xs_n = rms_norm(hs, norm_mix[l])
        if l % 2 == 0:
            yp, nkp, nvp, _ = even_layer(xp_n, pos_p, w_in_even[e], w_out_even[e], attn_sinks[e], gmlp_vnorm[e],
                                         gmlp_ws[e], gmlp_bias[e], None, None)
            ys, nks, nvs, gvs = even_layer(xs_n, pos_s, w_in_even[e], w_out_even[e], attn_sinks[e], gmlp_vnorm[e],
                                           gmlp_ws[e], gmlp_bias[e], cache_swa_k[e], cache_swa_v[e])
            kp.append(nkp); vp.append(nvp); ks.append(nks); vs.append(nvs); gs.append(gvs)
        else:
            s0 = jnp.zeros((x_prompt.shape[0], C_HEADS, C_HEAD_DIM, C_HEAD_DIM), jnp.float32)
            yp, Sp = odd_layer(xp_n, w_in_odd[e], w_out_odd[e], lb_all[l], hgrn_onorm[e], s0, HGRN_BLOCK)
            ys, Ss = odd_layer(xs_n, w_in_odd[e], w_out_odd[e], lb_all[l], hgrn_onorm[e], state_hgrn[e],
                               x_sample.shape[1])
            sp.append(Sp.astype(state_hgrn.dtype)); ss.append(Ss.astype(state_hgrn.dtype))
        hp = hp + yp
        hs = hs + ys
        hp = hp + sq_relu_mlp(rms_norm(hp, norm_ffn[l]), w_ffn_up[l], w_ffn_down[l])
        hs = hs + sq_relu_mlp(rms_norm(hs, norm_ffn[l]), w_ffn_up[l], w_ffn_down[l])
    y_prompt = rms_norm(hp, norm_final)
    y_sample = rms_norm(hs, norm_final)
    return (y_prompt, y_sample, jnp.stack(kp), jnp.stack(vp), jnp.stack(ks), jnp.stack(vs), jnp.stack(gs),
            jnp.stack(sp), jnp.stack(ss))
```

```cpp
#include <hip/hip_runtime.h>
#include <hip/hip_cooperative_groups.h>
#include <cstdio>
#include <cstdint>
namespace cg = cooperative_groups;
namespace pg8 {
#define PG8_LAS __attribute__((address_space(3)))
typedef unsigned short bf16_t;
typedef short bf16x8 __attribute__((ext_vector_type(8)));
typedef float f32x4 __attribute__((ext_vector_type(4)));
typedef unsigned u32x4 __attribute__((ext_vector_type(4)));
constexpr int BM = 256, BK = 64, HALF = 128, HTB = HALF * BK * 2  , STAGE_BYTES = 8 * HTB, NXCD = 8, WGM = 8;

__host__ __device__ __forceinline__ int lds_byte(int r, int c) { const int st = (r >> 4) * 2 + (c >> 5), rr = r & 15, cc = c & 31, ob = rr * 64 + cc * 2; return st * 1024 + (ob ^ (((ob >> 9) & 1) << 5)); }
__host__ __device__ __forceinline__ void stage_rc(int b, int& R, int& C) { const int st = b / 1024, sb = b % 1024, swz = sb ^ (((sb >> 9) & 1) << 5); R = (st >> 1) * 16 + swz / 64; C = (st & 1) * 32 + (swz % 64) / 2; }
__host__ __device__ __forceinline__ int perm32(int rho) { const int n = rho >> 4, i = rho & 15; return 8 * (i >> 2) + 4 * n + (i & 3); }

struct Unit { int pm, pn, k0, nt, part; };
struct Gemm { const bf16_t* A; const bf16_t* Bt; int M, N, K; };

struct StaticOrder {
    int nM, nN, nwg, G, c, ntk;
    __host__ __device__ void init(int M, int N, int G_, int c_, int K_ = 2048) { nM = M / BM; nN = N / BM; nwg = nM * nN; G = G_; c = c_; ntk = K_ / BK; }
    __host__ __device__ bool next(int i, Unit& u) const {
        const long L = (long)i * G + c; if (L >= nwg) return false;
        int wgid = (int)L; { const int q = nwg / NXCD, r = nwg % NXCD, xcd = wgid % NXCD, off = wgid / NXCD; wgid = (xcd < r ? xcd * (q + 1) : r * (q + 1) + (xcd - r) * q) + off; }
        const int nig = WGM * nN, gid = wgid / nig, fm = gid * WGM, gsz = (nM - fm) < WGM ? (nM - fm) : WGM;
        u.pm = fm + ((wgid % nig) % gsz); u.pn = (wgid % nig) / gsz; u.k0 = 0; u.nt = ntk; u.part = 0; return true;
    }
    __device__ __forceinline__ void a_ready(const Unit&) const {}
    __device__ __forceinline__ void done(const Unit&) const {}
};
struct SplitOrder {
    int c, ntk, nsl;
    __host__ __device__ void init(int c_, int K_) { c = c_; ntk = K_ / BK; nsl = 8; }
    __host__ __device__ bool next(int i, Unit& u) const {
        if (i == 0) { const int wgid = (c % 8) * 32 + c / 8, w = wgid % 64; u.pm = (wgid / 64) * 8 + (w % 8); u.pn = w / 8; u.k0 = 0; u.nt = ntk; u.part = 0; return true; }
        if (i == 1 && c < 16 * nsl) { const int ts = c / nsl, sl = c % nsl; u.pm = 32 + (ts >> 3); u.pn = ts & 7; u.nt = ntk / nsl; u.k0 = sl * u.nt; u.part = 1 + sl; return true; }
        return false;
    }
    __device__ __forceinline__ void a_ready(const Unit&) const {}
    __device__ __forceinline__ void done(const Unit&) const {}
};

typedef float f32x2c_t __attribute__((ext_vector_type(2))); typedef __bf16 bf16x2c_t __attribute__((ext_vector_type(2)));
__device__ __forceinline__ unsigned cvt_pk_bf16(float lo, float hi) { const f32x2c_t v = {lo, hi}; const bf16x2c_t b = __builtin_convertvector(v, bf16x2c_t); return __builtin_bit_cast(unsigned, b); }
typedef float f32x2 __attribute__((ext_vector_type(2)));
typedef unsigned u32x2 __attribute__((ext_vector_type(2)));
constexpr int O_YP = 0, O_YS = 16777216, O_KP = 17825792, O_VP = 17858560, O_KS = 17891328, O_VS = 18415616, O_GV = 18939904, O_SP = 19464192, O_SS = 19726336;
constexpr int MROWS = 8704, MPR = 8192, DM = 2048;
__device__ __forceinline__ unsigned short f2bf1(float f) { unsigned u = __builtin_bit_cast(unsigned, f); return (unsigned short)((u + 0x7fffu + ((u >> 16) & 1u)) >> 16); }
__device__ __forceinline__ float gelu_tanh(float x) {
    const float uu = 0.7978845608028654f * (x + 0.044715f * x * x * x);
    const float e = __expf(2.f * uu);
    const float t = 1.f - 2.f * __builtin_amdgcn_rcpf(e + 1.f);
    return 0.5f * x * (1.f + t);
}
__device__ __forceinline__ float sigm(float x) { return __builtin_amdgcn_rcpf(1.f + __expf(-x)); }

__device__ __forceinline__ float xsum16(float s) { const auto r = __builtin_amdgcn_permlane16_swap(__builtin_bit_cast(unsigned, s), __builtin_bit_cast(unsigned, s), false, false); return __builtin_bit_cast(float, r[0]) + __builtin_bit_cast(float, r[1]); }
__device__ __forceinline__ float xsum32(float s) { const auto r = __builtin_amdgcn_permlane32_swap(__builtin_bit_cast(unsigned, s), __builtin_bit_cast(unsigned, s), false, false); return __builtin_bit_cast(float, r[0]) + __builtin_bit_cast(float, r[1]); }
__device__ __forceinline__ float xpart32(float v, bool upper) { const auto r = __builtin_amdgcn_permlane32_swap(__builtin_bit_cast(unsigned, v), __builtin_bit_cast(unsigned, v), false, false); return __builtin_bit_cast(float, upper ? r[0] : r[1]); }
__device__ __forceinline__ float row_rstd(const float* ssp, int row, int fq) {
    const float* p = ssp + (size_t)row * 32 + fq * 8;
    const f32x4 a = *(const f32x4*)p, b = *(const f32x4*)(p + 4);
    float t = ((a[0] + a[1]) + (a[2] + a[3])) + ((b[0] + b[1]) + (b[2] + b[3]));
    t += __shfl_xor(t, 16); t += __shfl_xor(t, 32);
    return rsqrtf(t * (1.f / 2048.f) + 1e-6f);
}
struct EpiInEven {
    static constexpr bool PERM = false, AFTER_DRAIN = false;
    const float* ss; const float* cs; bf16_t *Q, *Kp, *Ks, *Vtp, *Vts, *U; float* GVr; float* out;
    template <int KIND> __device__ __forceinline__ void body(const f32x4 (&acc)[2][2][4][2], const Unit& u, int wr, int wc, int fr, int fq) const {
        const int pn = u.pn;
        const float* ssk = ss; int frk = fr; asm volatile("" : "+v"(frk), "+v"(fq)); asm volatile("" : "+s"(wc), "+s"(wr));
        float rs8[8];
#pragma unroll
        for (int q = 0; q < 8; ++q) rs8[q] = row_rstd(ssk, u.pm * BM + (q >> 2) * HALF + wr * 64 + (q & 3) * 16 + frk, fq);
#pragma unroll
        for (int ai = 0; ai < 2; ++ai)
#pragma unroll
            for (int m = 0; m < 4; ++m) {
                const int row = u.pm * BM + ai * HALF + wr * 64 + m * 16 + frk;
                const float rstd = rs8[ai * 4 + m];
                const bool smp = row >= MPR; const int sb = (row - MPR) >> 5, st = (row - MPR) & 31;
#pragma unroll
                for (int bj = 0; bj < 2; ++bj)
#pragma unroll
                    for (int n = 0; n < 2; ++n) {
                        f32x4 v = acc[ai][bj][m][n] * rstd;
                        const int cl = bj * HALF + wc * 32 + n * 16 + fq * 4;
                        if (KIND <= 1) {
                            if (n == 0 && (wc & 1) == 0) {
                                f32x4 p; p[0] = __shfl_xor(v[0], 32); p[1] = __shfl_xor(v[1], 32); p[2] = __shfl_xor(v[2], 32); p[3] = __shfl_xor(v[3], 32);
                                const f32x4 c0 = *(const f32x4*)(cs + (size_t)row * 16 + (fq & 1) * 8), c1 = *(const f32x4*)(cs + (size_t)row * 16 + (fq & 1) * 8 + 4);
                                const float sg = (fq < 2) ? -1.f : 1.f;
                                v[0] = v[0] * c0[0] + sg * p[0] * c0[1]; v[1] = v[1] * c0[2] + sg * p[1] * c0[3];
                                v[2] = v[2] * c1[0] + sg * p[2] * c1[1]; v[3] = v[3] * c1[2] + sg * p[3] * c1[3];
                            }
                            if (KIND == 0) {
                                v = v * 0.125f; u32x2 w; w.x = cvt_pk_bf16(v[0], v[1]); w.y = cvt_pk_bf16(v[2], v[3]);
                                *(u32x2*)(Q + (size_t)row * 1024 + pn * 256 + cl) = w;
                            } else {
                                u32x2 w; w.x = cvt_pk_bf16(v[0], v[1]); w.y = cvt_pk_bf16(v[2], v[3]);
                                if (smp) { *(u32x2*)(Ks + ((size_t)(sb * 160 + 128 + st)) * 256 + cl) = w; *(f32x4*)(out + O_KS + ((size_t)(sb * 128 + 96 + st)) * 256 + cl) = v; }
                                else { *(u32x2*)(Kp + (size_t)row * 256 + cl) = w; if (row >= MPR - 128) *(f32x4*)(out + O_KP + (size_t)(row - (MPR - 128)) * 256 + cl) = v; }
                            }
                        } else if (KIND == 2) {
                            if (smp) { *(f32x4*)(out + O_VS + ((size_t)(sb * 128 + 96 + st)) * 256 + cl) = v;
#pragma unroll
                                for (int j = 0; j < 4; ++j) Vts[((size_t)(sb * 256 + cl + j)) * 160 + 128 + st] = f2bf1(v[j]); }
                            else { if (row >= MPR - 128) *(f32x4*)(out + O_VP + (size_t)(row - (MPR - 128)) * 256 + cl) = v;
#pragma unroll
                                for (int j = 0; j < 4; ++j) Vtp[(size_t)(cl + j) * MPR + row] = f2bf1(v[j]); }
                        } else if (KIND == 3) {
                            u32x2 w; w.x = cvt_pk_bf16(gelu_tanh(v[0]), gelu_tanh(v[1])); w.y = cvt_pk_bf16(gelu_tanh(v[2]), gelu_tanh(v[3]));
                            *(u32x2*)(U + (size_t)row * 1024 + (pn - 6) * 256 + cl) = w;
                        } else {
                            f32x4 g; g[0] = gelu_tanh(v[0]); g[1] = gelu_tanh(v[1]); g[2] = gelu_tanh(v[2]); g[3] = gelu_tanh(v[3]);
                            *(f32x4*)(GVr + (size_t)row * 1024 + (pn - 10) * 256 + cl) = g;
                        }
                        asm volatile("" ::: "memory");
                    }
            }
    }
    __device__ __forceinline__ void operator()(const f32x4 (&acc)[2][2][4][2], const Unit& u, int wr, int wc, int fr, int fq) const {
        const int pn = u.pn;
        if (pn < 4) body<0>(acc, u, wr, wc, fr, fq);
        else if (pn == 4) body<1>(acc, u, wr, wc, fr, fq);
        else if (pn == 5) body<2>(acc, u, wr, wc, fr, fq);
        else if (pn < 10) body<3>(acc, u, wr, wc, fr, fq);
        else body<4>(acc, u, wr, wc, fr, fq);
    }
};
template <bool FROMX> struct EpiRes {
    static constexpr bool PERM = false, AFTER_DRAIN = false;
    const float* xp; const float* xs; float* H; bf16_t* Hb; float* ssout; float* part;
    __device__ __forceinline__ void operator()(const f32x4 (&acc)[2][2][4][2], const Unit& u, int wr, int wc, int fr, int fq) const {
        asm volatile("" : "+v"(fr), "+v"(fq), "+s"(wc), "+s"(wr));
        if (u.part) {
#pragma unroll
            for (int ai = 0; ai < 2; ++ai)
#pragma unroll
                for (int m = 0; m < 4; ++m) {
                    float* hp = part + ((size_t)(u.part - 1) * 512 + (size_t)((u.pm - 32) * BM + ai * HALF + wr * 64 + m * 16 + fr)) * DM + u.pn * BM + wc * 32 + fq * 4;
#pragma unroll
                    for (int bj = 0; bj < 2; ++bj)
#pragma unroll
                        for (int n = 0; n < 2; ++n) *(f32x4*)(hp + bj * HALF + n * 16) = acc[ai][bj][m][n];
                    asm volatile("" ::: "memory");
                }
            return;
        }
        const int colb = u.pn * BM + wc * 32 + fq * 4;
        f32x4 bcur[4], bnxt[4];
        { const int row = u.pm * BM + wr * 64 + fr; const float* base = FROMX ? (row < MPR ? xp + (size_t)row * DM : xs + (size_t)(row - MPR) * DM) : H + (size_t)row * DM;
#pragma unroll
          for (int p = 0; p < 4; ++p) bcur[p] = *(const f32x4*)(base + colb + (p >> 1) * HALF + (p & 1) * 16); }
#pragma unroll
        for (int q = 0; q < 8; ++q) {
            const int ai = q >> 2, m = q & 3;
            const int row = u.pm * BM + ai * HALF + wr * 64 + m * 16 + fr;
            if (q < 7) { const int rown = u.pm * BM + ((q + 1) >> 2) * HALF + wr * 64 + ((q + 1) & 3) * 16 + fr;
                const float* basen = FROMX ? (rown < MPR ? xp + (size_t)rown * DM : xs + (size_t)(rown - MPR) * DM) : H + (size_t)rown * DM;
#pragma unroll
                for (int p = 0; p < 4; ++p) bnxt[p] = *(const f32x4*)(basen + colb + (p >> 1) * HALF + (p & 1) * 16); }
            float s = 0.f;
#pragma unroll
            for (int p = 0; p < 4; ++p) {
                const int bj = p >> 1, n = p & 1, col = colb + bj * HALF + n * 16;
                const f32x4 h = bcur[p] + acc[ai][bj][m][n];
                *(f32x4*)(H + (size_t)row * DM + col) = h;
                u32x2 w; w.x = cvt_pk_bf16(h[0], h[1]); w.y = cvt_pk_bf16(h[2], h[3]);
                *(u32x2*)(Hb + (size_t)row * DM + col) = w;
                s += (h[0] * h[0] + h[1] * h[1]) + (h[2] * h[2] + h[3] * h[3]);
            }
            s += __shfl_xor(s, 16); s += __shfl_xor(s, 32);
            if (fq == 0) ssout[(size_t)row * 32 + u.pn * 4 + wc] = s;
#pragma unroll
            for (int p = 0; p < 4; ++p) bcur[p] = bnxt[p];
        }
    }
};
struct EpiUp {
    static constexpr bool PERM = true, AFTER_DRAIN = false;
    const float* ss; bf16_t* HID;
    __device__ __forceinline__ void operator()(const f32x4 (&acc)[2][2][4][2], const Unit& u, int wr, int wc, int fr, int fq) const {
        asm volatile("" : "+v"(fr), "+v"(fq), "+s"(wc), "+s"(wr));
        float rs8[8];
#pragma unroll
        for (int q = 0; q < 8; ++q) rs8[q] = row_rstd(ss, u.pm * BM + (q >> 2) * HALF + wr * 64 + (q & 3) * 16 + fr, fq);
#pragma unroll
        for (int ai = 0; ai < 2; ++ai)
#pragma unroll
            for (int m = 0; m < 4; ++m) {
                const int row = u.pm * BM + ai * HALF + wr * 64 + m * 16 + fr;
                const float rstd = rs8[ai * 4 + m];
                bf16_t* rowp = HID + (size_t)row * 8192 + u.pn * BM + wc * 32 + 8 * fq;
#pragma unroll
                for (int bj = 0; bj < 2; ++bj) {
                    f32x4 v0 = acc[ai][bj][m][0] * rstd, v1 = acc[ai][bj][m][1] * rstd;
#pragma unroll
                    for (int j = 0; j < 4; ++j) { const float a = fmaxf(v0[j], 0.f), b = fmaxf(v1[j], 0.f); v0[j] = a * a; v1[j] = b * b; }
                    u32x4 w; w.x = cvt_pk_bf16(v0[0], v0[1]); w.y = cvt_pk_bf16(v0[2], v0[3]); w.z = cvt_pk_bf16(v1[0], v1[1]); w.w = cvt_pk_bf16(v1[2], v1[3]);
                    *(u32x4*)(rowp + bj * HALF) = w;
                }
            }
    }
};
struct EpiInOdd {
    static constexpr bool PERM = true, AFTER_DRAIN = false;
    const float* ss; const float* lbw; float* QH; float* FH; bf16_t* VH; bf16_t* GH;
    __device__ __forceinline__ void operator()(const f32x4 (&acc)[2][2][4][2], const Unit& u, int wr, int wc, int fr, int fq) const {
        const int sec = u.pn >> 3, pnl = u.pn & 7;
        asm volatile("" : "+v"(fr), "+v"(fq), "+s"(wc), "+s"(wr));
        float rs8[8];
#pragma unroll
        for (int q = 0; q < 8; ++q) rs8[q] = row_rstd(ss, u.pm * BM + (q >> 2) * HALF + wr * 64 + (q & 3) * 16 + fr, fq);
        f32x4 lbv[2][2];
#pragma unroll
        for (int bj = 0; bj < 2; ++bj) { lbv[bj][0] = (f32x4){0.f, 0.f, 0.f, 0.f}; lbv[bj][1] = lbv[bj][0]; }
        if (sec == 1) {
#pragma unroll
            for (int bj = 0; bj < 2; ++bj) { const int col = pnl * BM + bj * HALF + wc * 32 + fq * 8;
                const f32x4 l0a = *(const f32x4*)(lbw + col), l0b = *(const f32x4*)(lbw + col + 4), l1a = *(const f32x4*)(lbw + DM + col), l1b = *(const f32x4*)(lbw + DM + col + 4);
#pragma unroll
                for (int j = 0; j < 4; ++j) { lbv[bj][0][j] = sigm(l1a[j] - l0a[j]); lbv[bj][1][j] = sigm(l1b[j] - l0b[j]); } }
        }
#pragma unroll
        for (int ai = 0; ai < 2; ++ai)
#pragma unroll
            for (int m = 0; m < 4; ++m) {
                const int row = u.pm * BM + ai * HALF + wr * 64 + m * 16 + fr;
                const float rstd = rs8[ai * 4 + m];
#pragma unroll
                for (int bj = 0; bj < 2; ++bj) {
                    f32x4 v0 = acc[ai][bj][m][0] * rstd, v1 = acc[ai][bj][m][1] * rstd;
                    const int col = pnl * BM + bj * HALF + wc * 32 + fq * 8;
                    if (sec == 0) {
#pragma unroll
                        for (int j = 0; j < 4; ++j) { v0[j] = v0[j] * sigm(v0[j]); v1[j] = v1[j] * sigm(v1[j]); }
                        *(f32x4*)(QH + (size_t)row * DM + col) = v0; *(f32x4*)(QH + (size_t)row * DM + col + 4) = v1;
                    } else if (sec == 1) {
#pragma unroll
                        for (int j = 0; j < 4; ++j) { const float la = lbv[bj][0][j], lb2 = lbv[bj][1][j]; v0[j] = la + (1.f - la) * sigm(v0[j]); v1[j] = lb2 + (1.f - lb2) * sigm(v1[j]); }
                        *(f32x4*)(FH + (size_t)row * DM + col) = v0; *(f32x4*)(FH + (size_t)row * DM + col + 4) = v1;
                    } else if (sec == 2) {
                        u32x4 w; w.x = cvt_pk_bf16(v0[0], v0[1]); w.y = cvt_pk_bf16(v0[2], v0[3]); w.z = cvt_pk_bf16(v1[0], v1[1]); w.w = cvt_pk_bf16(v1[2], v1[3]);
                        *(u32x4*)(VH + (size_t)row * DM + col) = w;
                    } else {
                        u32x4 w; w.x = cvt_pk_bf16(sigm(v0[0]), sigm(v0[1])); w.y = cvt_pk_bf16(sigm(v0[2]), sigm(v0[3])); w.z = cvt_pk_bf16(sigm(v1[0]), sigm(v1[1])); w.w = cvt_pk_bf16(sigm(v1[2]), sigm(v1[3]));
                        *(u32x4*)(GH + (size_t)row * DM + col) = w;
                    }
                }
            }
    }
};
template <class Epi, class Sched, bool ALIGN_EPI = false, bool SP2 = false>
__device__ __forceinline__ void gemm_phase(PG8_LAS unsigned char* lds, const Gemm g, const Sched& S, const Epi& E, const int tid) {
    const int wid = __builtin_amdgcn_readfirstlane(tid >> 6), lane = tid & 63, wr = wid >> 2, wc = wid & 3, fr = lane & 15, fq = lane >> 4;
    const int K = g.K;
    unsigned voffA[2], voffB[2];
#pragma unroll
    for (int i = 0; i < 2; ++i) { int R, C; stage_rc(tid * 16 + i * 8192, R, C); const int Rb = Epi::PERM ? ((R & ~31) + perm32(R & 31)) : R;
        voffA[i] = (unsigned)(R * K + C) * 2u; voffB[i] = (unsigned)(Rb * K + C) * 2u; }
    const size_t kstep = (size_t)(BK * 2);
    const size_t hstep = (size_t)HALF * K * 2;
    const size_t tstep = 2 * hstep;
    const unsigned ldsw = (unsigned)wid * 1024u;
    const int aoff = lds_byte(wr * 64 + fr, fq * 8), boff = lds_byte(wc * 32 + fr, fq * 8);
#define PG8_SA(b, h) (((b) * 2 + (h)) * HTB)
#define PG8_SB(b, h) ((4 + (b) * 2 + (h)) * HTB)
#define PG8_STAGE(bufoff, gbase, voff) do { _Pragma("unroll") for (int _i = 0; _i < 2; ++_i) \
        __builtin_amdgcn_global_load_lds((const unsigned*)((const char*)(gbase) + (voff)[_i]), (PG8_LAS unsigned*)(lds + (bufoff) + ldsw + _i * 8192), 16, 0, 0); } while (0)
#define PG8_LDA(dst, b, h) do { _Pragma("unroll") for (int m = 0; m < 4; ++m) _Pragma("unroll") for (int k = 0; k < 2; ++k) dst[m][k] = *(const PG8_LAS bf16x8*)(lds + PG8_SA(b, h) + aoff + m * 2048 + k * 1024); } while (0)
#define PG8_LDB(dst, b, h) do { _Pragma("unroll") for (int n = 0; n < 2; ++n) _Pragma("unroll") for (int k = 0; k < 2; ++k) dst[n][k] = *(const PG8_LAS bf16x8*)(lds + PG8_SB(b, h) + boff + n * 2048 + k * 1024); } while (0)
#define PG8_MMA(ai, bj, At, Bt) do { __builtin_amdgcn_s_setprio(1); _Pragma("unroll") for (int m = 0; m < 4; ++m) _Pragma("unroll") for (int n = 0; n < 2; ++n) _Pragma("unroll") for (int k = 0; k < 2; ++k) \
        acc[ai][bj][m][n] = __builtin_amdgcn_mfma_f32_16x16x32_bf16(Bt[n][k], At[m][k], acc[ai][bj][m][n], 0, 0, 0); __builtin_amdgcn_s_setprio(0); } while (0)
#define PG8_WAIT_V(n) asm volatile("s_waitcnt vmcnt(" #n ")" ::: "memory")
#define PG8_WAIT_L(n) asm volatile("s_waitcnt lgkmcnt(" #n ")" ::: "memory")
#define PG8_BAR __builtin_amdgcn_s_barrier()
#define PG8_SCHED __builtin_amdgcn_sched_barrier(0)
    Unit cur, nxt; int ui = 0;
    if (!S.next(0, cur)) return;
    f32x4 acc[2][2][4][2];
#pragma unroll
    for (int a = 0; a < 2; ++a)
#pragma unroll
        for (int b = 0; b < 2; ++b)
#pragma unroll
            for (int m = 0; m < 4; ++m)
#pragma unroll
                for (int n = 0; n < 2; ++n) acc[a][b][m][n] = (f32x4){0.f, 0.f, 0.f, 0.f};
    bf16x8 At[4][2], B0[2][2], B1[2][2];
    const char* cA = (const char*)g.A + (size_t)cur.pm * tstep + (size_t)cur.k0 * kstep; const char* cB = (const char*)g.Bt + (size_t)cur.pn * tstep + (size_t)cur.k0 * kstep;
    S.a_ready(cur);
    if constexpr (SP2) {
        PG8_STAGE(PG8_SB(0, 0), cB, voffB); PG8_STAGE(PG8_SB(0, 1), cB + hstep, voffB); PG8_STAGE(PG8_SA(0, 0), cA, voffA); PG8_STAGE(PG8_SA(0, 1), cA + hstep, voffA);
        if (wr == 1) PG8_BAR;
        PG8_WAIT_V(2); PG8_BAR;
        PG8_STAGE(PG8_SB(1, 0), cB + kstep, voffB); PG8_STAGE(PG8_SA(1, 0), cA + kstep, voffA); PG8_STAGE(PG8_SB(1, 1), cB + hstep + kstep, voffB);
        PG8_WAIT_V(6); PG8_BAR;
    } else {
        PG8_STAGE(PG8_SB(0, 0), cB, voffB); PG8_STAGE(PG8_SA(0, 0), cA, voffA); PG8_STAGE(PG8_SB(0, 1), cB + hstep, voffB); PG8_STAGE(PG8_SA(0, 1), cA + hstep, voffA);
        if (wr == 1) PG8_BAR;
        PG8_WAIT_V(4); PG8_BAR;
        PG8_STAGE(PG8_SB(1, 0), cB + kstep, voffB); PG8_STAGE(PG8_SA(1, 0), cA + kstep, voffA); PG8_STAGE(PG8_SB(1, 1), cB + hstep + kstep, voffB);
        PG8_WAIT_V(6); PG8_BAR;
    }
    for (;;) {
        const bool has_next = S.next(ui + 1, nxt);
        const char* nA = has_next ? (const char*)g.A + (size_t)nxt.pm * tstep + (size_t)nxt.k0 * kstep : cA; const char* nB = has_next ? (const char*)g.Bt + (size_t)nxt.pn * tstep + (size_t)nxt.k0 * kstep : cB;
        const int nt = cur.nt;
        for (int t = 0; t < nt; t += 2) {
            const bool last = (t == nt - 2);
            const char* a1 = cA + (size_t)(t + 1) * kstep;
            const char* a2 = last ? nA : cA + (size_t)(t + 2) * kstep; const char* b2 = last ? nB : cB + (size_t)(t + 2) * kstep;
            const char* a3 = a2 + kstep; const char* b3 = b2 + kstep;
            if (last && has_next) S.a_ready(nxt);
            if constexpr (SP2) {
            PG8_LDB(B0, 0, 0); PG8_LDB(B1, 0, 1); PG8_SCHED; PG8_LDA(At, 0, 0); PG8_STAGE(PG8_SA(1, 1), a1 + hstep, voffA);
            PG8_WAIT_V(8); PG8_WAIT_L(0); PG8_BAR; PG8_MMA(0, 0, At, B0); PG8_MMA(0, 1, At, B1); PG8_BAR; PG8_SCHED;
            PG8_LDA(At, 0, 1); PG8_STAGE(PG8_SB(0, 0), b2, voffB); PG8_STAGE(PG8_SB(0, 1), b2 + hstep, voffB); PG8_STAGE(PG8_SA(0, 0), a2, voffA);
            PG8_WAIT_V(8); PG8_WAIT_L(0); PG8_BAR; PG8_MMA(1, 0, At, B0); PG8_MMA(1, 1, At, B1); PG8_BAR; PG8_SCHED;
            PG8_LDB(B0, 1, 0); PG8_LDB(B1, 1, 1); PG8_SCHED; PG8_LDA(At, 1, 0); PG8_STAGE(PG8_SA(0, 1), a2 + hstep, voffA);
            PG8_WAIT_V(8); PG8_WAIT_L(0); PG8_BAR; PG8_MMA(0, 0, At, B0); PG8_MMA(0, 1, At, B1); PG8_BAR; PG8_SCHED;
            PG8_LDA(At, 1, 1); PG8_STAGE(PG8_SB(1, 0), b3, voffB); PG8_STAGE(PG8_SB(1, 1), b3 + hstep, voffB); PG8_STAGE(PG8_SA(1, 0), a3, voffA);
            PG8_WAIT_V(8); PG8_WAIT_L(0); PG8_BAR; PG8_MMA(1, 0, At, B0); PG8_MMA(1, 1, At, B1); PG8_BAR; PG8_SCHED;
            } else {
            PG8_LDB(B0, 0, 0); PG8_SCHED; PG8_LDA(At, 0, 0); PG8_STAGE(PG8_SA(1, 1), a1 + hstep, voffA);
            PG8_WAIT_L(8); PG8_BAR; PG8_WAIT_L(0); PG8_MMA(0, 0, At, B0); PG8_BAR; PG8_SCHED;
            PG8_LDB(B1, 0, 1); PG8_STAGE(PG8_SB(0, 0), b2, voffB);
            PG8_BAR; PG8_WAIT_L(0); PG8_MMA(0, 1, At, B1); PG8_BAR;
            PG8_LDA(At, 0, 1); PG8_STAGE(PG8_SA(0, 0), a2, voffA);
            PG8_BAR; PG8_WAIT_L(0); PG8_MMA(1, 0, At, B0); PG8_BAR; PG8_SCHED;
            PG8_STAGE(PG8_SB(0, 1), b2 + hstep, voffB);
            PG8_WAIT_V(6); PG8_BAR; PG8_MMA(1, 1, At, B1); PG8_BAR;
            PG8_LDB(B0, 1, 0); PG8_SCHED; PG8_LDA(At, 1, 0); PG8_STAGE(PG8_SA(0, 1), a2 + hstep, voffA);
            PG8_WAIT_L(8); PG8_BAR; PG8_WAIT_L(0); PG8_MMA(0, 0, At, B0); PG8_BAR; PG8_SCHED;
            PG8_LDB(B1, 1, 1); PG8_STAGE(PG8_SB(1, 0), b3, voffB);
            PG8_BAR; PG8_WAIT_L(0); PG8_MMA(0, 1, At, B1); PG8_BAR;
            PG8_LDA(At, 1, 1); PG8_STAGE(PG8_SA(1, 0), a3, voffA);
            PG8_BAR; PG8_WAIT_L(0); PG8_MMA(1, 0, At, B0); PG8_BAR; PG8_SCHED;
            PG8_STAGE(PG8_SB(1, 1), b3 + hstep, voffB);
            PG8_WAIT_V(6); PG8_BAR; PG8_MMA(1, 1, At, B1); PG8_BAR;
            }
        }
        if constexpr (ALIGN_EPI) { if (wr == 0) PG8_BAR; }
        if constexpr (!Epi::AFTER_DRAIN) { E(acc, cur, wr, wc, fr, fq); S.done(cur); }
        if (!has_next) break;
#pragma unroll
        for (int a = 0; a < 2; ++a)
#pragma unroll
            for (int b = 0; b < 2; ++b)
#pragma unroll
                for (int m = 0; m < 4; ++m)
#pragma unroll
                    for (int n = 0; n < 2; ++n) acc[a][b][m][n] = (f32x4){0.f, 0.f, 0.f, 0.f};
        cur = nxt; cA = nA; cB = nB; ++ui;
        if constexpr (ALIGN_EPI) { if (wr == 1) PG8_BAR; }
    }
    PG8_WAIT_V(0);
    if constexpr (!ALIGN_EPI) { if (wr == 0) PG8_BAR; }
    PG8_BAR;
    if constexpr (Epi::AFTER_DRAIN) { E.fused(acc, cur, wr, wc, fr, fq, lds, wid, lane); S.done(cur); }
#undef PG8_SA
#undef PG8_SB
#undef PG8_STAGE
#undef PG8_LDA
#undef PG8_LDB
#undef PG8_MMA
#undef PG8_WAIT_V
#undef PG8_WAIT_L
#undef PG8_BAR
#undef PG8_SCHED
}
}
#define LAS __attribute__((address_space(3)))
typedef unsigned short bf16;
typedef unsigned v4u __attribute__((ext_vector_type(4)));
typedef unsigned v2u __attribute__((ext_vector_type(2)));
typedef float f32x4 __attribute__((ext_vector_type(4)));
typedef float f32x2 __attribute__((ext_vector_type(2)));
typedef float f32x16 __attribute__((ext_vector_type(16)));
typedef short bf16x8 __attribute__((ext_vector_type(8)));
typedef short s16x4 __attribute__((ext_vector_type(4)));
using pg8::O_YP; using pg8::O_YS; using pg8::O_KP; using pg8::O_VP; using pg8::O_KS; using pg8::O_VS; using pg8::O_GV; using pg8::O_SP; using pg8::O_SS;
constexpr int M = 8704, MP = 8192, D = 2048, NIN_E = 3584, DFF = 8192, NWAVES = 8, NTHR = 512;
constexpr size_t MiB = 1u << 20;
constexpr size_t WS_SS = 464 * MiB;
constexpr size_t SSN = (size_t)8704 * 32;
constexpr size_t WS_CS = 1 * MiB;
constexpr size_t WS_W5 = 2 * MiB, WS_W6 = 34 * MiB, WS_WU1 = 42 * MiB, WS_WD1 = 74 * MiB;
constexpr size_t WS_W1 = 106 * MiB, WS_W2 = 120 * MiB, WS_WU0 = 128 * MiB, WS_WD0 = 160 * MiB;
constexpr size_t WS_BIG = 192 * MiB;
constexpr size_t WS_Q = WS_BIG, WS_KP = WS_BIG + 17 * MiB, WS_KS = WS_BIG + 21 * MiB, WS_VTP = WS_BIG + 23 * MiB, WS_VTS = WS_BIG + 27 * MiB, WS_U = WS_BIG + 29 * MiB, WS_GVR = WS_BIG + 46 * MiB;
constexpr size_t WS_QH = 106 * MiB, WS_FH = 174 * MiB, WS_VH = 242 * MiB, WS_GH = 276 * MiB;
constexpr size_t WS_H = 328 * MiB;
constexpr size_t WS_A1 = 396 * MiB;
constexpr size_t WS_A2 = 430 * MiB;
constexpr size_t WS_END = 470 * MiB;
constexpr size_t WS_SEG = WS_A1, WS_DEC = WS_A1 + 16 * MiB;
constexpr int LDS_BYTES = 147456;
constexpr int NPH = 16;

__device__ __forceinline__ unsigned f2bf(float f) { unsigned u = __builtin_bit_cast(unsigned, f); return (u + 0x7fffu + ((u >> 16) & 1u)) >> 16; }
__device__ __forceinline__ unsigned pk2(float lo, float hi) { return pg8::cvt_pk_bf16(lo, hi); }
__device__ __forceinline__ float bf2f(unsigned short b) { return __builtin_bit_cast(float, (unsigned)b << 16); }
__device__ __forceinline__ float wave_sum(float v) {
#pragma unroll
    for (int o = 1; o < 64; o <<= 1) v += __shfl_xor(v, o);
    return v;
}
struct Args { const float* in[20]; float* out; unsigned char* ws; int ph_lo, ph_hi; };

__device__ __forceinline__ void tr64_item(const float* __restrict__ W, int K, int N, bf16* WT, const float* __restrict__ g, LAS float* scr, int item, int lane) {
    const int nblk = N / 64, kb = item / nblk, nb = item % nblk, k0 = 64 * kb, n0 = 64 * nb;
    const int kr = lane >> 4, l4 = lane & 15;
    f32x4 v[16];
#pragma unroll
    for (int i = 0; i < 16; ++i) v[i] = __builtin_nontemporal_load((const f32x4*)(W + (size_t)(k0 + 4 * i + kr) * N + n0 + 4 * l4));
#pragma unroll
    for (int i = 0; i < 16; ++i) { const int k = 4 * i + kr; if (g) v[i] = v[i] * g[k0 + k];
        *(LAS f32x4*)(scr + k * 64 + ((4 * l4) ^ ((k >> 3) << 2))) = v[i]; }
    asm volatile("s_waitcnt lgkmcnt(0)" ::: "memory");
    const int c = lane & 7, nn = lane >> 3;
#pragma unroll
    for (int j = 0; j < 8; ++j) { const int n = nn + 8 * j; const LAS float* s = scr + (8 * c) * 64 + (n ^ (c << 2));
        v4u o; o.x = pk2(s[0 * 64], s[1 * 64]); o.y = pk2(s[2 * 64], s[3 * 64]); o.z = pk2(s[4 * 64], s[5 * 64]); o.w = pk2(s[6 * 64], s[7 * 64]);
        *(v4u*)(WT + (size_t)(n0 + n) * K + k0 + 8 * c) = o; }
    asm volatile("s_waitcnt lgkmcnt(0)" ::: "memory");
}
__device__ __forceinline__ void attn_wave(const bf16* Qp, const bf16* Kp, int kstride, const bf16* Vt, int vstride, int nkb, float sink, bf16* Op, int lane) {
    const int r = lane & 31, h = lane >> 5;
    bf16x8 qf[4];
#pragma unroll
    for (int s = 0; s < 4; ++s) qf[s] = *(const bf16x8*)(Qp + (size_t)r * 1024 + 16 * s + 8 * h);
    f32x16 S[6];
#pragma unroll
    for (int kb = 0; kb < 6; ++kb) {
        S[kb] = (f32x16){0.f,0.f,0.f,0.f,0.f,0.f,0.f,0.f,0.f,0.f,0.f,0.f,0.f,0.f,0.f,0.f};
        if (kb < nkb) {
#pragma unroll
            for (int s = 0; s < 4; ++s) { const bf16x8 kf = *(const bf16x8*)(Kp + (size_t)(kb * 32 + r) * kstride + 16 * s + 8 * h);
                S[kb] = __builtin_amdgcn_mfma_f32_32x32x16_bf16(kf, qf[s], S[kb], 0, 0, 0); }
        }
    }
    float mx = sink;
#pragma unroll
    for (int kb = 0; kb < 6; ++kb) if (kb < nkb) {
#pragma unroll
        for (int i = 0; i < 16; ++i) mx = fmaxf(mx, S[kb][i]); }
    mx = fmaxf(mx, __shfl_xor(mx, 32));
    float l = 0.f;
#pragma unroll
    for (int kb = 0; kb < 6; ++kb) if (kb < nkb) {
#pragma unroll
        for (int i = 0; i < 16; ++i) { const float p = __expf(S[kb][i] - mx); S[kb][i] = p; l += p; } }
    l += __shfl_xor(l, 32);
    l += __expf(sink - mx);
    f32x16 O[2];
    O[0] = (f32x16){0.f,0.f,0.f,0.f,0.f,0.f,0.f,0.f,0.f,0.f,0.f,0.f,0.f,0.f,0.f,0.f}; O[1] = O[0];
#pragma unroll
    for (int kb = 0; kb < 6; ++kb) if (kb < nkb) {
#pragma unroll
        for (int s = 0; s < 2; ++s) {
            v4u pw; pw.x = pk2(S[kb][8 * s + 0], S[kb][8 * s + 1]); pw.y = pk2(S[kb][8 * s + 2], S[kb][8 * s + 3]); pw.z = pk2(S[kb][8 * s + 4], S[kb][8 * s + 5]); pw.w = pk2(S[kb][8 * s + 6], S[kb][8 * s + 7]);
            const bf16x8 pf = __builtin_bit_cast(bf16x8, pw);
#pragma unroll
            for (int db = 0; db < 2; ++db) {
                const bf16* vp = Vt + (size_t)(db * 32 + r) * vstride + kb * 32 + 16 * s + 4 * h;
                const v2u lo = *(const v2u*)vp, hi = *(const v2u*)(vp + 8);
                v4u vw; vw.x = lo.x; vw.y = lo.y; vw.z = hi.x; vw.w = hi.y;
                O[db] = __builtin_amdgcn_mfma_f32_32x32x16_bf16(__builtin_bit_cast(bf16x8, vw), pf, O[db], 0, 0, 0);
            }
        }
    }
    const float il = 1.f / l;
#pragma unroll
    for (int db = 0; db < 2; ++db)
#pragma unroll
        for (int g4 = 0; g4 < 4; ++g4) {
            v2u w; w.x = pk2(O[db][4 * g4 + 0] * il, O[db][4 * g4 + 1] * il); w.y = pk2(O[db][4 * g4 + 2] * il, O[db][4 * g4 + 3] * il);
            *(v2u*)(Op + (size_t)r * 2048 + db * 32 + 8 * g4 + 4 * h) = w;
        }
}

__device__ __forceinline__ void gmlp_unit(unsigned char* lds, const float* GVr, const bf16* U, const float* gamma, const float* Wsp, const float* bias, bf16* AB, float* gvout, int row0, int nrows, int hg, int tid) {
    bf16* gvT = (bf16*)lds;
    const int lane = tid & 63, wave = tid >> 6;
    {
        const int q = tid >> 2, part = tid & 3;
        f32x4 v[8]; float s = 0.f;
        if (q < nrows) {
#pragma unroll
            for (int j = 0; j < 8; ++j) { v[j] = *(const f32x4*)(GVr + (size_t)(row0 + q) * 1024 + hg * 128 + part * 32 + 4 * j); s += (v[j][0] + v[j][1]) + (v[j][2] + v[j][3]); }
        } else {
#pragma unroll
            for (int j = 0; j < 8; ++j) v[j] = (f32x4){0.f, 0.f, 0.f, 0.f};
        }
        s += __shfl_xor(s, 1); s += __shfl_xor(s, 2);
        const float mu = s * (1.f / 128.f); float s2 = 0.f;
#pragma unroll
        for (int j = 0; j < 8; ++j) { v[j] = v[j] - mu; s2 += (v[j][0] * v[j][0] + v[j][1] * v[j][1]) + (v[j][2] * v[j][2] + v[j][3] * v[j][3]); }
        s2 += __shfl_xor(s2, 1); s2 += __shfl_xor(s2, 2);
        const float rstd = rsqrtf(s2 * (1.f / 128.f) + 1e-6f);
#pragma unroll
        for (int j = 0; j < 8; ++j) {
            const f32x4 gm = *(const f32x4*)(gamma + hg * 128 + part * 32 + 4 * j);
            f32x4 o = v[j] * rstd * gm;
            if (q >= nrows) o = (f32x4){0.f, 0.f, 0.f, 0.f};
            if (gvout && q < nrows) *(f32x4*)(gvout + ((size_t)q * 8 + hg) * 128 + part * 32 + 4 * j) = o;
#pragma unroll
            for (int e = 0; e < 4; ++e) gvT[(part * 32 + 4 * j + e) * 136 + q] = (bf16)f2bf(o[e]);
        }
    }
    __syncthreads();
    const int r = lane & 31, hh = lane >> 5;
    const int pb = wave >> 1;
    if (pb * 32 < nrows) {
        const int nks = (nrows == 32) ? 2 : (pb < 2 ? 4 : 8);
        f32x16 acc[2];
        acc[0] = (f32x16){0.f,0.f,0.f,0.f,0.f,0.f,0.f,0.f,0.f,0.f,0.f,0.f,0.f,0.f,0.f,0.f}; acc[1] = acc[0];
        for (int s = 0; s < nks; ++s) {
            const float* wp = Wsp + ((size_t)hg * 128 + pb * 32 + r) * 128 + 16 * s + 8 * hh;
            const f32x4 w0 = *(const f32x4*)wp, w1 = *(const f32x4*)(wp + 4);
            v4u aw; aw.x = pk2(w0[0], w0[1]); aw.y = pk2(w0[2], w0[3]); aw.z = pk2(w1[0], w1[1]); aw.w = pk2(w1[2], w1[3]);
            const bf16x8 af = __builtin_bit_cast(bf16x8, aw);
#pragma unroll
            for (int t = 0; t < 2; ++t) {
                const int db = (wave & 1) * 2 + t;
                const bf16x8 bfr = *(const bf16x8*)(gvT + (db * 32 + r) * 136 + 16 * s + 8 * hh);
                acc[t] = __builtin_amdgcn_mfma_f32_32x32x16_bf16(af, bfr, acc[t], 0, 0, 0);
            }
        }
#pragma unroll
        for (int t = 0; t < 2; ++t) {
            const int dcol = hg * 128 + ((wave & 1) * 2 + t) * 32 + r;
#pragma unroll
            for (int i = 0; i < 16; ++i) {
                const int p = pb * 32 + (i & 3) + 8 * (i >> 2) + 4 * hh;
                const float mixed = acc[t][i] + bias[hg * 128 + p];
                const float uu = bf2f(U[(size_t)(row0 + p) * 1024 + dcol]);
                AB[(size_t)(row0 + p) * 2048 + 1024 + dcol] = (bf16)f2bf(uu * mixed);
            }
        }
    }
    __syncthreads();
}

template <bool OUT, bool DECAY>
__device__ __forceinline__ void hgrn_unit(unsigned char* lds, const float* QH, const float* FH, const bf16* VH, const bf16* GH, const float* gon, bf16* Oo,
                                          int hd, int row0, int L, int init, const float* sin, const float* SEG, const float* DEC, int gseg, float* sout, float* decout, int tid) {
    float* qs = (float*)lds;
    float* fs = qs + 2 * 2048;
    float* vs = fs + 2 * 2048;
    float* op = vs + 2 * 2048;
    const int lane = tid & 63, w = tid >> 6, e = (w & 1) * 64 + lane, dq = w >> 1, d0 = dq * 32;
    f32x2 S[16];
    if (init == 1) {
#pragma unroll
        for (int i = 0; i < 16; ++i) { S[i].x = sin[(size_t)(d0 + 2 * i) * 128 + e]; S[i].y = sin[(size_t)(d0 + 2 * i + 1) * 128 + e]; }
    } else {
#pragma unroll
        for (int i = 0; i < 16; ++i) S[i] = (f32x2){0.f, 0.f};
        if (init == 2) {
            for (int g = 0; g < gseg; ++g) {
                const float* Lp = SEG + ((size_t)(hd * 16 + g) * 128 + d0) * 128 + e; const float* Dp = DEC + (size_t)(hd * 16 + g) * 128 + d0;
#pragma unroll
                for (int i = 0; i < 16; ++i) { S[i].x = Dp[2 * i] * S[i].x + Lp[(size_t)(2 * i) * 128]; S[i].y = Dp[2 * i + 1] * S[i].y + Lp[(size_t)(2 * i + 1) * 128]; }
            }
        }
    }
    float dec = 1.f;
    const int tt = tid >> 5, c4 = (tid & 31) * 4;
    const int nb = L >> 4;
    f32x4 rq, rf; v2u rv;
    {
        const size_t off = (size_t)(row0 + tt) * 2048 + hd * 128 + c4;
        if (OUT) rq = *(const f32x4*)(QH + off);
        rf = *(const f32x4*)(FH + off); rv = *(const v2u*)(VH + off);
        if (OUT) *(f32x4*)(qs + tt * 128 + c4) = rq;
        *(f32x4*)(fs + tt * 128 + c4) = rf;
        *(f32x4*)(vs + tt * 128 + c4) = (f32x4){bf2f((unsigned short)(rv.x & 0xffff)), bf2f((unsigned short)(rv.x >> 16)), bf2f((unsigned short)(rv.y & 0xffff)), bf2f((unsigned short)(rv.y >> 16))};
    }
    __syncthreads();
    for (int b = 0; b < nb; ++b) {
        const int buf = b & 1;
        if (b + 1 < nb) {
            const size_t off = (size_t)(row0 + (b + 1) * 16 + tt) * 2048 + hd * 128 + c4;
            if (OUT) rq = *(const f32x4*)(QH + off);
            rf = *(const f32x4*)(FH + off); rv = *(const v2u*)(VH + off);
        }
        const float* qb = qs + buf * 2048 + d0; const float* fb = fs + buf * 2048 + d0; const float* vb = vs + buf * 2048 + e;
#pragma unroll 2
        for (int t = 0; t < 16; ++t) {
            const float v = vb[t * 128]; const f32x2 v2 = (f32x2){v, v};
            f32x2 o2 = (f32x2){0.f, 0.f};
#pragma unroll
            for (int i = 0; i < 8; ++i) {
                const f32x4 f4 = *(const f32x4*)(fb + t * 128 + 4 * i);
                S[2 * i] = (f32x2){f4[0], f4[1]} * (S[2 * i] - v2) + v2;
                S[2 * i + 1] = (f32x2){f4[2], f4[3]} * (S[2 * i + 1] - v2) + v2;
                if (OUT) { const f32x4 q4 = *(const f32x4*)(qb + t * 128 + 4 * i); o2 += (f32x2){q4[0], q4[1]} * S[2 * i]; o2 += (f32x2){q4[2], q4[3]} * S[2 * i + 1]; }
            }
            if (OUT) op[((buf * 16 + t) * 4 + dq) * 128 + e] = o2.x + o2.y;
        }
        if (DECAY) { if (tid < 128) {
#pragma unroll
            for (int t = 0; t < 16; ++t) dec *= fs[buf * 2048 + t * 128 + tid]; } }
        if (b + 1 < nb) {
            const int nbuf = buf ^ 1;
            if (OUT) *(f32x4*)(qs + nbuf * 2048 + tt * 128 + c4) = rq;
            *(f32x4*)(fs + nbuf * 2048 + tt * 128 + c4) = rf;
            *(f32x4*)(vs + nbuf * 2048 + tt * 128 + c4) = (f32x4){bf2f((unsigned short)(rv.x & 0xffff)), bf2f((unsigned short)(rv.x >> 16)), bf2f((unsigned short)(rv.y & 0xffff)), bf2f((unsigned short)(rv.y >> 16))};
        }
        __syncthreads();
        if (OUT) {
            const float* ob = op + (buf * 16 + tt) * 512 + c4;
            f32x4 o = *(const f32x4*)ob + *(const f32x4*)(ob + 128) + *(const f32x4*)(ob + 256) + *(const f32x4*)(ob + 384);
            float sq = (o[0] * o[0] + o[1] * o[1]) + (o[2] * o[2] + o[3] * o[3]);
#pragma unroll
            for (int x = 1; x < 32; x <<= 1) sq += __shfl_xor(sq, x);
            const float rms = rsqrtf(sq * (1.f / 128.f) + 1e-6f);
            const size_t off = (size_t)(row0 + b * 16 + tt) * 2048 + hd * 128 + c4;
            const v2u gw = *(const v2u*)(GH + off); const f32x4 gn = *(const f32x4*)(gon + hd * 128 + c4);
            const float r0 = o[0] * rms * gn[0] * bf2f((unsigned short)(gw.x & 0xffff)), r1 = o[1] * rms * gn[1] * bf2f((unsigned short)(gw.x >> 16));
            const float r2 = o[2] * rms * gn[2] * bf2f((unsigned short)(gw.y & 0xffff)), r3 = o[3] * rms * gn[3] * bf2f((unsigned short)(gw.y >> 16));
            v2u ow; ow.x = pk2(r0, r1); ow.y = pk2(r2, r3);
            *(v2u*)(Oo + off) = ow;
        }
    }
    if (sout) {
#pragma unroll
        for (int i = 0; i < 16; ++i) { sout[(size_t)(d0 + 2 * i) * 128 + e] = S[i].x; sout[(size_t)(d0 + 2 * i + 1) * 128 + e] = S[i].y; }
    }
    if (DECAY) { if (decout && tid < 128) decout[tid] = dec; }
    __syncthreads();
}
#define XB_TMO      128
#define XB_XCNT(j)  (256  + 64 * (j))
#define XB_XSUB(j)  (1280 + 64 * (j))
#define XB_XGEN(j)  (2304 + 64 * (j))
#define XB_TOP      3328
#define XB_TOPGEN   3392
#define XCD_BAR_WORDS 3456
#define XB_SPIN_CAP (1u << 18)

__device__ __forceinline__ unsigned xb_ld(unsigned* p)              { return __hip_atomic_load(p, __ATOMIC_RELAXED, __HIP_MEMORY_SCOPE_AGENT); }
__device__ __forceinline__ unsigned xb_add(unsigned* p, unsigned v) { return __hip_atomic_fetch_add(p, v, __ATOMIC_RELAXED, __HIP_MEMORY_SCOPE_AGENT); }
__device__ __forceinline__ unsigned xb_xcc_id() { return (unsigned)__builtin_amdgcn_s_getreg((3 << 11) | 20) & 0xFu; }
#define XB_SPIN(cond, bar) do { unsigned _sp = 0; while (cond) { __builtin_amdgcn_s_sleep(1); \
    if ((++_sp & 255u) == 0u) { if (xb_ld(&(bar)[XB_TMO])) break; if (_sp > XB_SPIN_CAP) { atomicAdd(&(bar)[XB_TMO], 1u); break; } } } } while (0)

struct XcdBarrier {
    unsigned* bar; unsigned x;
    volatile LAS unsigned* st;
};

__device__ __forceinline__ XcdBarrier xcd_barrier_post(unsigned* bar, volatile LAS unsigned* st) {
    XcdBarrier b; b.bar = bar; b.x = xb_xcc_id(); b.st = st;
    if (threadIdx.x == 0) (void)xb_add(&bar[XB_XCNT(b.x)], 1u);
    return b;
}
__device__ __forceinline__ void xcd_barrier_complete(unsigned* bar, unsigned x, unsigned& nloc, unsigned& nx) {
    const unsigned G = gridDim.x * gridDim.y * gridDim.z;
    unsigned sum, cnt, mine, sp = 0u;
    for (;;) {
        sum = 0u; cnt = 0u; mine = 0u;
#pragma unroll
        for (unsigned j = 0; j < 16; ++j) { const unsigned c = xb_ld(&bar[XB_XCNT(j)]); sum += c; cnt += (c > 0u) ? 1u : 0u; mine = (j == x) ? c : mine; }
        if (sum == G) break;
        __builtin_amdgcn_s_sleep(1);
        if ((++sp & 255u) == 0u) { if (xb_ld(&bar[XB_TMO])) break; if (sp > XB_SPIN_CAP) { atomicAdd(&bar[XB_TMO], 1u); break; } }
    }
    nloc = mine > 0u ? mine : 1u; nx = cnt > 0u ? cnt : 1u;
}

__device__ __forceinline__ void xcd_barrier(const XcdBarrier& b) {
    asm volatile("s_waitcnt vmcnt(0)" ::: "memory");
    __syncthreads();
    if (threadIdx.x == 0) {
        unsigned* bar = b.bar;
        __builtin_amdgcn_s_waitcnt(0);
        unsigned nloc = b.st[0], nx = b.st[1];
        if (nloc == 0u) { xcd_barrier_complete(bar, b.x, nloc, nx); b.st[0] = nloc; b.st[1] = nx; }
        const unsigned old = xb_add(&bar[XB_XSUB(b.x)], 1u);
        const unsigned gen = old / nloc;
        if (old + 1u == (gen + 1u) * nloc) {
            __builtin_amdgcn_fence(__ATOMIC_RELEASE, "agent");
            asm volatile("s_waitcnt vmcnt(0)" ::: "memory");
            const unsigned og = xb_add(&bar[XB_TOP], 1u);
            const unsigned tg = og / nx;
            if (og + 1u == (tg + 1u) * nx) xb_add(&bar[XB_TOPGEN], 1u);
            else XB_SPIN(xb_ld(&bar[XB_TOPGEN]) == tg, bar);
            __builtin_amdgcn_fence(__ATOMIC_ACQUIRE, "agent");
            xb_add(&bar[XB_XGEN(b.x)], 1u);
            asm volatile("s_waitcnt vmcnt(0)" ::: "memory");
        } else {
            XB_SPIN(xb_ld(&bar[XB_XGEN(b.x)]) == gen, bar);
            __builtin_amdgcn_fence(__ATOMIC_ACQUIRE, "agent");
            asm volatile("s_waitcnt vmcnt(0)" ::: "memory");
        }
    }
    __syncthreads();
}
constexpr int HG_QH = 0, HG_KT = 8704, HG_KHT = 17408, HG_VT = 27648, HG_D = 37888, HG_PART = 38400, HG_OST = 40448;
__device__ __forceinline__ bf16x8 pack8(const f32x16& x, int o) {
    v4u w; w.x = pg8::cvt_pk_bf16(x[o + 0], x[o + 1]); w.y = pg8::cvt_pk_bf16(x[o + 2], x[o + 3]); w.z = pg8::cvt_pk_bf16(x[o + 4], x[o + 5]); w.w = pg8::cvt_pk_bf16(x[o + 6], x[o + 7]);
    return __builtin_bit_cast(bf16x8, w);
}
template <bool OUT>
__device__ __forceinline__ void hg_unit(unsigned char* lds, const float* QH, const float* FH, const bf16* VH, const bf16* GH, const float* gon, bf16* Oo,
                                        int hd, int row0, int nch, int init, const float* sin, const float* SEG, const float* DEC, int gseg, float* sout, float* decout, int tid, float* zflag = nullptr) {
    bf16* Qh = (bf16*)(lds + HG_QH); bf16* Kt = (bf16*)(lds + HG_KT); bf16* KhT = (bf16*)(lds + HG_KHT); bf16* VT = (bf16*)(lds + HG_VT);
    float* Dv = (float*)(lds + HG_D); float* Pp = (float*)(lds + HG_PART); float* Ost = (float*)(lds + HG_OST);
    const int lane = tid & 63, w = __builtin_amdgcn_readfirstlane(tid >> 6), r = lane & 31, hh = lane >> 5;
    const int d = tid & 127, tq = __builtin_amdgcn_readfirstlane(tid >> 7);
    const f32x16 Z16 = (f32x16){0.f,0.f,0.f,0.f,0.f,0.f,0.f,0.f,0.f,0.f,0.f,0.f,0.f,0.f,0.f,0.f};
    f32x16 S[4];
#pragma unroll
    for (int db = 0; db < 4; ++db) S[db] = Z16;
    if (w < 4) {
        if (init == 1) {
#pragma unroll
            for (int db = 0; db < 4; ++db)
#pragma unroll
                for (int i = 0; i < 16; ++i) S[db][i] = sin[(size_t)(db * 32 + (i & 3) + 8 * (i >> 2) + 4 * hh) * 128 + w * 32 + r];
        }
    }
    float dec = 1.f;
    float pf[8], pq[8]; unsigned short pv[8];
    {
        const size_t off = (size_t)(row0 + tq * 8) * 2048 + hd * 128 + d;
#pragma unroll
        for (int j = 0; j < 8; ++j) { pf[j] = FH[off + (size_t)j * 2048]; pv[j] = VH[off + (size_t)j * 2048]; if (OUT) pq[j] = QH[off + (size_t)j * 2048]; }
    }
    for (int c = 0; c < nch; ++c) {
        v4u gw = (v4u){0u, 0u, 0u, 0u};
        if (OUT) gw = *(const v4u*)(GH + (size_t)(row0 + c * 32 + (tid >> 4)) * 2048 + hd * 128 + (tid & 15) * 8);
        float A[8]; float run = 1.f;
#pragma unroll
        for (int j = 0; j < 8; ++j) { run *= pf[j]; A[j] = run; }
        Pp[tq * 128 + d] = run;
        __syncthreads();
        const float p0 = Pp[d], p1 = Pp[128 + d], p2 = Pp[256 + d], p3 = Pp[384 + d];
        const float offp = tq == 0 ? 1.f : tq == 1 ? p0 : tq == 2 ? p0 * p1 : p0 * p1 * p2;
        const float tot = (p0 * p1) * (p2 * p3);
#pragma unroll
        for (int j = 0; j < 8; ++j) {
            const int t = tq * 8 + j; const float a = A[j] * offp, ia = __builtin_amdgcn_rcpf(a), k = 1.f - pf[j];
            if (OUT) Qh[t * 136 + d] = (bf16)f2bf(pq[j] * a);
            if (OUT) Kt[t * 136 + d] = (bf16)f2bf(k * ia);
            KhT[d * 40 + t] = (bf16)f2bf(k * tot * ia);
            VT[d * 40 + t] = pv[j];
        }
        if (tq == 0) { Dv[d] = tot; if (!OUT) dec *= tot; }
        if (c + 1 < nch) {
            const size_t off = (size_t)(row0 + (c + 1) * 32 + tq * 8) * 2048 + hd * 128 + d;
#pragma unroll
            for (int j = 0; j < 8; ++j) { pf[j] = FH[off + (size_t)j * 2048]; pv[j] = VH[off + (size_t)j * 2048]; if (OUT) pq[j] = QH[off + (size_t)j * 2048]; }
        }
        __syncthreads();
        if (w < 4) {
            if (OUT) {
                f32x16 P = Z16;
#pragma unroll
                for (int kk = 0; kk < 8; ++kk) {
                    const bf16x8 a = *(const bf16x8*)(Kt + r * 136 + 16 * kk + 8 * hh), b = *(const bf16x8*)(Qh + r * 136 + 16 * kk + 8 * hh);
                    P = __builtin_amdgcn_mfma_f32_32x32x16_bf16(a, b, P, 0, 0, 0);
                }
#pragma unroll
                for (int i = 0; i < 16; ++i) { const int s = (i & 3) + 8 * (i >> 2) + 4 * hh; if (s > r) P[i] = 0.f; }
                f32x16 o = Z16;
#pragma unroll
                for (int db = 0; db < 4; ++db)
#pragma unroll
                    for (int kk = 0; kk < 2; ++kk) {
                        const bf16* qp = Qh + r * 136 + db * 32 + 16 * kk + 4 * hh;
                        const v2u lo = *(const v2u*)qp, hi = *(const v2u*)(qp + 8);
                        v4u bw; bw.x = lo.x; bw.y = lo.y; bw.z = hi.x; bw.w = hi.y;
                        o = __builtin_amdgcn_mfma_f32_32x32x16_bf16(pack8(S[db], 8 * kk), __builtin_bit_cast(bf16x8, bw), o, 0, 0, 0);
                    }
#pragma unroll
                for (int kk = 0; kk < 2; ++kk) {
                    const bf16* vp = VT + (w * 32 + r) * 40 + 16 * kk + 4 * hh;
                    const v2u lo = *(const v2u*)vp, hi = *(const v2u*)(vp + 8);
                    v4u aw; aw.x = lo.x; aw.y = lo.y; aw.z = hi.x; aw.w = hi.y;
                    o = __builtin_amdgcn_mfma_f32_32x32x16_bf16(__builtin_bit_cast(bf16x8, aw), pack8(P, 8 * kk), o, 0, 0, 0);
                }
#pragma unroll
                for (int g4 = 0; g4 < 4; ++g4) *(f32x4*)(Ost + r * 132 + w * 32 + 8 * g4 + 4 * hh) = (f32x4){o[4 * g4], o[4 * g4 + 1], o[4 * g4 + 2], o[4 * g4 + 3]};
            }
#pragma unroll
            for (int db = 0; db < 4; ++db) {
#pragma unroll
                for (int g4 = 0; g4 < 4; ++g4) { const f32x4 dv = *(const f32x4*)(Dv + db * 32 + 8 * g4 + 4 * hh);
#pragma unroll
                    for (int j = 0; j < 4; ++j) S[db][4 * g4 + j] *= dv[j]; }
#pragma unroll
                for (int kk = 0; kk < 2; ++kk) {
                    const bf16x8 a = *(const bf16x8*)(KhT + (db * 32 + r) * 40 + 16 * kk + 8 * hh), b = *(const bf16x8*)(VT + (w * 32 + r) * 40 + 16 * kk + 8 * hh);
                    S[db] = __builtin_amdgcn_mfma_f32_32x32x16_bf16(a, b, S[db], 0, 0, 0);
                }
            }
        }
        if (OUT) {
            __syncthreads();
            const int t = tid >> 4, e8 = (tid & 15) * 8;
            const f32x4 o0 = *(const f32x4*)(Ost + t * 132 + e8), o1 = *(const f32x4*)(Ost + t * 132 + e8 + 4);
            float sq = ((o0[0] * o0[0] + o0[1] * o0[1]) + (o0[2] * o0[2] + o0[3] * o0[3])) + ((o1[0] * o1[0] + o1[1] * o1[1]) + (o1[2] * o1[2] + o1[3] * o1[3]));
#pragma unroll
            for (int x = 1; x < 16; x <<= 1) sq += __shfl_xor(sq, x);
            const float rms = rsqrtf(sq * (1.f / 128.f) + 1e-6f);
            const size_t off = (size_t)(row0 + c * 32 + t) * 2048 + hd * 128 + e8;
            const f32x4 g0 = *(const f32x4*)(gon + hd * 128 + e8), g1 = *(const f32x4*)(gon + hd * 128 + e8 + 4);
            v4u ow;
            ow.x = pk2(o0[0] * rms * g0[0] * bf2f((unsigned short)(gw.x & 0xffff)), o0[1] * rms * g0[1] * bf2f((unsigned short)(gw.x >> 16)));
            ow.y = pk2(o0[2] * rms * g0[2] * bf2f((unsigned short)(gw.y & 0xffff)), o0[3] * rms * g0[3] * bf2f((unsigned short)(gw.y >> 16)));
            ow.z = pk2(o1[0] * rms * g1[0] * bf2f((unsigned short)(gw.z & 0xffff)), o1[1] * rms * g1[1] * bf2f((unsigned short)(gw.z >> 16)));
            ow.w = pk2(o1[2] * rms * g1[2] * bf2f((unsigned short)(gw.w & 0xffff)), o1[3] * rms * g1[3] * bf2f((unsigned short)(gw.w >> 16)));
            *(v4u*)(Oo + off) = ow;
        }
    }
    if (sout && w < 4) {
#pragma unroll
        for (int db = 0; db < 4; ++db)
#pragma unroll
            for (int i = 0; i < 16; ++i) sout[(size_t)(db * 32 + (i & 3) + 8 * (i >> 2) + 4 * hh) * 128 + w * 32 + r] = S[db][i];
    }
    if (!OUT) {
        if (decout && tid < 128) decout[tid] = dec;
        const int anynz = __syncthreads_or(tid < 128 && dec > 0.f);
        if (zflag && tid == 0) *zflag = anynz ? 0.f : 1.f;
    }
    __syncthreads();
}
#ifndef DBG_A2PTR
#define DBG_A2PTR A2
#endif
#ifndef SEQ_LO
#define SEQ_LO 0xbad98e76d54d3210ull
#define SEQ_HI 0xcull
#define SEQ_N 17
#endif
#ifndef DBG_SSI
#define DBG_SSI 4
#endif
#ifndef PHMASK
#define PHMASK 0xffff
#endif
#define PHEN(k) (((PHMASK) >> (k)) & 1)
#ifndef MK_PER_PHASE
#define MK_PER_PHASE 0
#endif
#define CAS __attribute__((address_space(4)))
#define INP(i) (*(const float* const CAS*)(kp + 8 * (i)))
#define xp INP(0)
#define xs INP(1)
#define ss ((float*)(ws + WS_SS))
#define cs ((float*)(ws + WS_CS))
#define A1 ((bf16*)(ws + WS_A1))
#define A2 ((bf16*)(ws + WS_A2))
#define H ((float*)(ws + WS_H))
#define HID ((bf16*)(ws + WS_BIG))
#define Qb ((bf16*)(ws + WS_Q))
#define Kpb ((bf16*)(ws + WS_KP))
#define Ksb ((bf16*)(ws + WS_KS))
#define Vtp ((bf16*)(ws + WS_VTP))
#define Vts ((bf16*)(ws + WS_VTS))
#define Ub ((bf16*)(ws + WS_U))
#define GVr ((float*)(ws + WS_GVR))
#define QH ((float*)(ws + WS_QH))
#define FH ((float*)(ws + WS_FH))
#define VH ((bf16*)(ws + WS_VH))
#define GH ((bf16*)(ws + WS_GH))
#define SEG ((float*)(ws + WS_SEG))
#define DEC ((float*)(ws + WS_DEC))

#define CONV_L1(j_) do { int r_ = (j_); \
    if (r_ < 4096) { tr64_item(INP(14), 2048, 8192, (bf16*)(ws + WS_W5), INP(5) + 2048, scr, r_, lane); break; } r_ -= 4096; \
    if (r_ < 1024) { tr64_item(INP(15), 2048, 2048, (bf16*)(ws + WS_W6), nullptr, scr, r_, lane); break; } r_ -= 1024; \
    if (r_ < 4096) { tr64_item(INP(18) + (size_t)2048 * 8192, 2048, 8192, (bf16*)(ws + WS_WU1), INP(6) + 2048, scr, r_, lane); break; } r_ -= 4096; \
    tr64_item(INP(19) + (size_t)2048 * 8192, 8192, 2048, (bf16*)(ws + WS_WD1), nullptr, scr, r_, lane); } while (0)
#define CONV_RANGE(j0_, j1_, w0_, nw_) do { LAS float* scr = (LAS float*)(lds3 + wave * 16384); \
    for (int j__ = (j0_) + (w0_) * NWAVES + wave; j__ < (j1_); j__ += (nw_) * NWAVES) CONV_L1(j__); } while (0)
__global__ void __launch_bounds__(NTHR, 2) mk_fwd(Args a) {
    extern __shared__ __attribute__((aligned(16))) unsigned char lds[];
    const int G = gridDim.x, bid = blockIdx.x;
    cg::grid_group grid = cg::this_grid();
    volatile LAS unsigned* xb_misc = (volatile LAS unsigned*)((LAS unsigned char*)lds + 131072 + 320);
    if (threadIdx.x < 32) xb_misc[threadIdx.x] = 0u;
    __syncthreads();
    XcdBarrier xbar = xcd_barrier_post((unsigned*)a.ws, xb_misc + 8);

    int nfin = 0;
    for (int st = a.ph_lo; st < a.ph_hi; ++st) {
        const int ph = (int)(((st < 16 ? (unsigned long long)SEQ_LO >> (4 * st) : (unsigned long long)SEQ_HI >> (4 * (st - 16)))) & 15ull);
        int tid = threadIdx.x;
        const CAS unsigned char* kp = (const CAS unsigned char*)__builtin_amdgcn_kernarg_segment_ptr();
        asm volatile("" : "+v"(tid)); asm volatile("" : "+s"(kp));
        unsigned char* ws = *(unsigned char* const CAS*)(kp + 168); float* out = *(float* const CAS*)(kp + 160);
        const int lane = tid & 63, wave = __builtin_amdgcn_readfirstlane(tid >> 6);
        LAS unsigned char* lds3 = (LAS unsigned char*)lds;
        if (ph == 0 && PHEN(0)) {
            LAS float* scr = (LAS float*)(lds3 + wave * 16384);
            const int gw = bid * NWAVES + wave, NGW = G * NWAVES;
            constexpr int J_1 = 32 * 56, J_2 = 32 * 32, J_U = 32 * 128, J_D = 128 * 32;
            for (int it = gw; it < J_1 + J_2 + J_U + J_D; it += NGW) {
                int r = it;
                if (r < J_1) { tr64_item(INP(8), 2048, 3584, (bf16*)(ws + WS_W1), INP(5), scr, r, lane); continue; } r -= J_1;
                if (r < J_2) { tr64_item(INP(9), 2048, 2048, (bf16*)(ws + WS_W2), nullptr, scr, r, lane); continue; } r -= J_2;
                if (r < J_U) { tr64_item(INP(18), 2048, 8192, (bf16*)(ws + WS_WU0), INP(6), scr, r, lane); continue; } r -= J_U;
                tr64_item(INP(19), 8192, 2048, (bf16*)(ws + WS_WD0), nullptr, scr, r, lane);
            }
            CONV_RANGE(0, 2046, bid, G); CONV_RANGE(12572, 13312, bid, G);
            for (int m = gw; m < M; m += NGW) {
                const float* xr = m < MP ? xp + (size_t)m * D : xs + (size_t)(m - MP) * D;
                f32x4 v[8]; float s = 0.f;
#pragma unroll
                for (int j = 0; j < 8; ++j) { v[j] = __builtin_nontemporal_load((const f32x4*)(xr + 4 * lane + 256 * j)); s += (v[j][0] * v[j][0] + v[j][1] * v[j][1]) + (v[j][2] * v[j][2] + v[j][3] * v[j][3]); }
                s = wave_sum(s);
#pragma unroll
                for (int j = 0; j < 8; ++j) { v2u w; w.x = pk2(v[j][0], v[j][1]); w.y = pk2(v[j][2], v[j][3]); *(v2u*)(A1 + (size_t)m * D + 4 * lane + 256 * j) = w;
                    if (m >= MP) *(f32x4*)(H + (size_t)m * D + 4 * lane + 256 * j) = v[j]; }
                if (lane < 32) ss[(size_t)m * 32 + lane] = lane == 0 ? s : 0.f;
            }
            const int gt = bid * NTHR + tid, NGT = G * NTHR;
            for (int idx = gt; idx < M * 8; idx += NGT) {
                const int m = idx >> 3, i = idx & 7;
                const int pos = m < MP ? m : 2048 + ((m - MP) & 31);
                const float inv = i == 0 ? 1.f : i == 1 ? 1.939227432e-01f : i == 2 ? 3.760603070e-02f : i == 3 ? 7.292664610e-03f : i == 4 ? 1.414213562e-03f : i == 5 ? 2.742481884e-04f : i == 6 ? 5.318295734e-05f : 1.031338525e-05f;
                const float ang = (float)pos * inv;
                const float th = ang * 1.591549367e-01f, te = __builtin_fmaf(ang, 1.591549367e-01f, -th) + ang * 6.420638243e-09f;
                const float fr_ = (th - __builtin_rintf(th)) + te;
                cs[2 * idx] = __builtin_amdgcn_cosf(fr_); cs[2 * idx + 1] = __builtin_amdgcn_sinf(fr_);
            }
            const float* ck = INP(2); const float* cv = INP(3);
            for (int idx = gt; idx < 16 * 128 * 256; idx += NGT) {
                const int b = idx >> 15, rem = idx & 32767, j = rem >> 8, c = rem & 255;
                const float kv = ck[idx], vv = cv[idx];
                Ksb[(size_t)b * 40960 + rem] = (bf16)f2bf(kv);
                Vts[((size_t)b * 256 + c) * 160 + j] = (bf16)f2bf(vv);
                if (j >= 32) { out[O_KS + ((size_t)b * 128 + j - 32) * 256 + c] = kv; out[O_VS + ((size_t)b * 128 + j - 32) * 256 + c] = vv; }
            }
        } else if (ph == 1 && PHEN(1)) {
            pg8::Gemm g{A1, (const bf16*)(ws + WS_W1), M, NIN_E, D}; pg8::StaticOrder S; S.init(M, NIN_E, G, bid);
            pg8::EpiInEven E{ss, cs, Qb, Kpb, Ksb, Vtp, Vts, Ub, GVr, out};
            pg8::gemm_phase<pg8::EpiInEven, pg8::StaticOrder, true, true>(lds3, g, S, E, tid);
        } else if (ph == 2 && PHEN(2)) {
            for (int u = bid; u < 1216; u += G) {
                if (u < 576) {
                    bf16* Ks = (bf16*)lds; bf16* Vs = (bf16*)(lds + 27648);
                    const bf16* Kg; const bf16* Vg; int vstr, nkb;
                    if (u < 512) { const int c = u >> 2, kvh = u & 3, kc0 = c > 2 ? c - 2 : 0; nkb = (c - kc0 + 1) * 2;
                        Kg = Kpb + (size_t)(kc0 * 64) * 256 + kvh * 64; Vg = Vtp + (size_t)(kvh * 64) * 8192 + kc0 * 64; vstr = 8192; }
                    else { const int su = u - 512, b = su >> 2, kvh = su & 3; nkb = 5;
                        Kg = Ksb + (size_t)b * 40960 + kvh * 64; Vg = Vts + ((size_t)b * 256 + kvh * 64) * 160; vstr = 160; }
                    const int nkeys = nkb * 32, cpr = nkeys >> 3;
                    for (int p = tid; p < nkeys * 8; p += NTHR) { const int row = p >> 3, ch = p & 7; *(v4u*)(Ks + row * 72 + ch * 8) = *(const v4u*)(Kg + (size_t)row * 256 + ch * 8); }
                    for (int p = tid; p < 64 * cpr; p += NTHR) { const int dd = p / cpr, ch = p - dd * cpr; *(v4u*)(Vs + dd * 200 + ch * 8) = *(const v4u*)(Vg + (size_t)dd * vstr + ch * 8); }
                    __syncthreads();
                    if (u < 512) { const int c = u >> 2, kvh = u & 3, hq = kvh * 4 + (wave >> 1), tok0 = c * 64 + (wave & 1) * 32;
                        attn_wave(Qb + (size_t)tok0 * 1024 + hq * 64, Ks, 72, Vs, 200, nkb, INP(10)[hq], A2 + (size_t)tok0 * 2048 + hq * 64, lane);
                    } else if (wave < 4) { const int su = u - 512, b = su >> 2, kvh = su & 3, hq = kvh * 4 + wave;
                        attn_wave(Qb + (size_t)(MP + b * 32) * 1024 + hq * 64, Ks, 72, Vs, 200, nkb, INP(10)[hq], A2 + (size_t)(MP + b * 32) * 2048 + hq * 64, lane); }
                    __syncthreads();
                } else if (u < 1088) {
                    const int gu = u - 576;
                    gmlp_unit(lds, GVr, Ub, INP(11), INP(12), INP(13), A2, nullptr, (gu >> 3) * 128, 128, gu & 7, tid);
                } else {
                    const int gu = u - 1088, b = gu >> 3;
                    gmlp_unit(lds, GVr, Ub, INP(11), INP(12), INP(13), A2, out + O_GV + (size_t)b * 32 * 1024, MP + b * 32, 32, gu & 7, tid);
                }
            }
        } else if (ph == 3 && PHEN(3)) {
            pg8::Gemm g{A2, (const bf16*)(ws + WS_W2), M, D, D}; pg8::SplitOrder S; S.init(bid, D);
            pg8::EpiRes<true> E{xp, xs, H, A1, ss + SSN, (float*)(ws + WS_BIG)};
            pg8::gemm_phase<pg8::EpiRes<true>, pg8::SplitOrder, true, true>(lds3, g, S, E, tid);
        } else if ((ph == 4 || ph == 10) && PHEN(ph)) {
#ifdef DBG_HIDFILL
            { const int gt = bid * NTHR + tid, NGT = G * NTHR;
              for (size_t i = gt; i < (size_t)M * DFF / 2; i += NGT) { const unsigned a_ = (unsigned)((i * 37u) & 255u); ((unsigned*)HID)[i] = pk2((float)a_ * (1.f / 256.f), (float)(255u - a_) * (1.f / 512.f)); } }
            if (false)
#endif
            {
            pg8::Gemm g{A1, (const bf16*)(ws + (ph == 4 ? WS_WU0 : WS_WU1)), M, DFF, D}; pg8::StaticOrder S; S.init(M, DFF, G, bid);
            pg8::EpiUp E{ss + (ph == 4 ? SSN : 3 * SSN), HID};
            pg8::gemm_phase<pg8::EpiUp, pg8::StaticOrder, true, true>(lds3, g, S, E, tid);
            }
            if (bid >= 64) {
                if (ph == 4) CONV_RANGE(2046, 5120, bid - 64, 192); else CONV_RANGE(9498, 12572, bid - 64, 192);
            }
        } else if ((ph == 5 || ph == 9 || ph == 11) && PHEN(ph)) {
            const bf16* Aop = ph == 9 ? A2 : HID; const bf16* Bop = (const bf16*)(ws + (ph == 5 ? WS_WD0 : ph == 9 ? WS_W6 : WS_WD1));
            pg8::Gemm g{Aop, Bop, M, D, ph == 9 ? D : DFF}; pg8::SplitOrder S; S.init(bid, ph == 9 ? D : DFF);
#ifndef DBG_P5X
#define DBG_P5X false
#endif
            pg8::EpiRes<DBG_P5X> E{xp, xs, H, A1, ss + (ph == 5 ? 2 * SSN : ph == 9 ? 3 * SSN : 4 * SSN), (float*)(ws + (ph == 9 ? WS_BIG : WS_A2))};
            pg8::gemm_phase<pg8::EpiRes<DBG_P5X>, pg8::SplitOrder, true, true>(lds3, g, S, E, tid);
            if (bid >= 128) { if (ph == 5) CONV_RANGE(5120, 6156, bid - 128, 128); else if (ph == 9) CONV_RANGE(9230, 9498, bid - 128, 128); }
        } else if (ph == 6 && PHEN(6)) {
            pg8::Gemm g{A1, (const bf16*)(ws + WS_W5), M, DFF, D}; pg8::StaticOrder S; S.init(M, DFF, G, bid);
            pg8::EpiInOdd E{ss + 2 * SSN, INP(16), QH, FH, VH, GH};
            pg8::gemm_phase<pg8::EpiInOdd, pg8::StaticOrder, true, true>(lds3, g, S, E, tid);
            if (bid >= 64) CONV_RANGE(6156, 9230, bid - 64, 192);
        } else if (ph == 7 && PHEN(7)) {
            for (int u = bid; u < 240; u += G) { const int hd = u / 15, g = u % 15;
                hg_unit<false>(lds, QH, FH, VH, GH, INP(17), A2, hd, g * 512, 16, 0, nullptr, SEG, DEC, 0, SEG + (size_t)(hd * 16 + g) * 16384, DEC + (size_t)(hd * 16 + g) * 128, tid, DEC + 32768 + hd * 16 + g); }
        } else if (ph == 14 && PHEN(14)) {
            const int gt = bid * NTHR + tid, NGT = G * NTHR;
            for (int el = gt; el < 16 * 16384; el += NGT) {
                const int hd = el >> 14, de = el & 16383, dd = de >> 7;
                float L[15], Dg[15];
#pragma unroll
                for (int g = 0; g < 15; ++g) { L[g] = SEG[(size_t)(hd * 16 + g) * 16384 + de]; Dg[g] = DEC[(size_t)(hd * 16 + g) * 128 + dd]; }
                float acc = 0.f;
#pragma unroll
                for (int g = 0; g < 15; ++g) { acc = Dg[g] * acc + L[g]; SEG[(size_t)(hd * 16 + g) * 16384 + de] = acc; }
            }
        } else if (ph == 8 && PHEN(8)) {
            for (int u = bid; u < 512; u += G) {
                if (u < 256) { const int hd = u >> 4, g = u & 15;
                    hg_unit<true>(lds, QH, FH, VH, GH, INP(17), A2, hd, g * 512, 16, g ? 1 : 0, SEG + (size_t)(hd * 16 + (g ? g - 1 : 0)) * 16384, SEG, DEC, g, g == 15 ? out + O_SP + (size_t)hd * 16384 : nullptr, nullptr, tid);
                } else { const int su = u - 256, b = su >> 4, hd = su & 15;
                    hg_unit<true>(lds, QH, FH, VH, GH, INP(17), A2, hd, MP + b * 32, 1, 1, INP(4) + (size_t)(b * 16 + hd) * 16384, SEG, DEC, 0, out + O_SS + (size_t)(b * 16 + hd) * 16384, nullptr, tid); }
            }
        } else if (ph == 13 && PHEN(13)) {
            const int ssi = ++nfin;
            const float* part = (const float*)(ws + ((ssi & 1) == 0 ? WS_A2 : WS_BIG));
            const int gw = bid * NWAVES + wave, NGW = G * NWAVES;
            for (int it = gw; it < 512 * 4; it += NGW) {
                const int rs = it >> 2, qd = it & 3, m = MP + rs; const size_t co = (size_t)qd * 512 + 4 * lane;
                f32x4 h0 = *(const f32x4*)(H + (size_t)m * D + co), h1 = *(const f32x4*)(H + (size_t)m * D + co + 256);
#pragma unroll
                for (int sl = 0; sl < 8; ++sl) { const float* pp = part + ((size_t)sl * 512 + rs) * D + co; h0 += __builtin_nontemporal_load((const f32x4*)pp); h1 += __builtin_nontemporal_load((const f32x4*)(pp + 256)); }
                *(f32x4*)(H + (size_t)m * D + co) = h0; *(f32x4*)(H + (size_t)m * D + co + 256) = h1;
                v2u w; w.x = pk2(h0[0], h0[1]); w.y = pk2(h0[2], h0[3]); *(v2u*)(A1 + (size_t)m * D + co) = w;
                w.x = pk2(h1[0], h1[1]); w.y = pk2(h1[2], h1[3]); *(v2u*)(A1 + (size_t)m * D + co + 256) = w;
                float sq = ((h0[0] * h0[0] + h0[1] * h0[1]) + (h0[2] * h0[2] + h0[3] * h0[3])) + ((h1[0] * h1[0] + h1[1] * h1[1]) + (h1[2] * h1[2] + h1[3] * h1[3]));
                sq = wave_sum(sq);
                if (lane < 8) ss[(size_t)ssi * SSN + (size_t)m * 32 + qd * 8 + lane] = lane == 0 ? sq : 0.f;
            }
        } else if (ph == 12 && PHEN(12)) {
            const int gw = bid * NWAVES + wave, NGW = G * NWAVES;
            for (int m = gw; m < M; m += NGW) {
                f32x4 hv[8]; float sq = 0.f;
#ifdef DBG_DUMPQH
#pragma unroll
                for (int j = 0; j < 8; ++j) *(f32x4*)(out + (size_t)m * D + 4 * lane + 256 * j) = *(const f32x4*)(DBG_DUMPQH + (size_t)m * D + 4 * lane + 256 * j);
                continue;
#endif
#ifdef DBG_DUMPA2
                if (DBG_DUMPA2 == 2 && (m >= MP || (m & 511) < 64)) continue;
                if (DBG_DUMPA2 == 3 && m < MP) continue;
#pragma unroll
                for (int j = 0; j < 8; ++j) { const v2u w = *(const v2u*)(DBG_A2PTR + (size_t)m * D + 4 * lane + 256 * j);
                    *(f32x4*)(out + (size_t)m * D + 4 * lane + 256 * j) = (f32x4){bf2f((unsigned short)(w.x & 0xffff)), bf2f((unsigned short)(w.x >> 16)), bf2f((unsigned short)(w.y & 0xffff)), bf2f((unsigned short)(w.y >> 16))}; }
                continue;
#endif
#pragma unroll
                for (int j = 0; j < 8; ++j) { hv[j] = __builtin_nontemporal_load((const f32x4*)(H + (size_t)m * D + 4 * lane + 256 * j));
                    if (m >= MP) {
#pragma unroll
                        for (int sl = 0; sl < 8; ++sl) hv[j] += __builtin_nontemporal_load((const f32x4*)((const float*)(ws + WS_A2) + ((size_t)sl * 512 + (m - MP)) * D + 4 * lane + 256 * j)); } sq += (hv[j][0] * hv[j][0] + hv[j][1] * hv[j][1]) + (hv[j][2] * hv[j][2] + hv[j][3] * hv[j][3]); }
                const float rstd = rsqrtf(wave_sum(sq) * (1.f / 2048.f) + 1e-6f);
#pragma unroll
                for (int j = 0; j < 8; ++j) { const f32x4 gn = *(const f32x4*)(INP(7) + 4 * lane + 256 * j);
                    __builtin_nontemporal_store(hv[j] * rstd * gn, (f32x4*)(out + (size_t)m * D + 4 * lane + 256 * j)); }
            }
        }
        if (st + 1 < a.ph_hi) { if (a.ph_lo < 0) grid.sync(); else xcd_barrier(xbar); }
    }
#ifdef EXTRA_SYNC
    for (int i = 0; i < EXTRA_SYNC; ++i) xcd_barrier(xbar);
#endif
}

#undef xp
#undef xs
#undef ss
#undef cs
#undef A1
#undef A2
#undef H
#undef HID
#undef Qb
#undef Kpb
#undef Ksb
#undef Vtp
#undef Vts
#undef Ub
#undef GVr
#undef QH
#undef FH
#undef VH
#undef GH
#undef SEG
#undef DEC
#undef CONV_L1
#undef CONV_RANGE
extern "C" void kernel_launch(void* const* d_in, const int* in_sizes, int n_in, void* d_out, int out_size, void* d_ws, size_t ws_size, hipStream_t stream) {
    static int grid = 0;
    if (grid == 0) {
        if (n_in != 20 || ws_size < WS_END) { fprintf(stderr, "kernel_launch: unexpected n_in %d / ws %zu\n", n_in, ws_size); grid = -1; return; }
        int dev = 0, cus = 0, per_cu = 0;
        (void)hipGetDevice(&dev); (void)hipDeviceGetAttribute(&cus, hipDeviceAttributeMultiprocessorCount, dev);
        if (hipFuncSetAttribute((const void*)mk_fwd, hipFuncAttributeMaxDynamicSharedMemorySize, LDS_BYTES) != hipSuccess) { fprintf(stderr, "kernel_launch: hipFuncSetAttribute failed\n"); grid = -1; return; }
        if (hipOccupancyMaxActiveBlocksPerMultiprocessor(&per_cu, (const void*)mk_fwd, NTHR, LDS_BYTES) != hipSuccess || per_cu < 1) { fprintf(stderr, "kernel_launch: occupancy query says %d\n", per_cu); per_cu = 1; }
        (void)hipGetLastError();
        grid = cus * 1;
        if (grid <= 0) grid = 256;
    }
    if (grid < 0) return;
    (void)hipMemsetAsync(d_ws, 0, 65536, stream);
    Args a{};
    for (int i = 0; i < 20; ++i) a.in[i] = (const float*)d_in[i];
    a.out = (float*)d_out; a.ws = (unsigned char*)d_ws;
#ifdef DBG_FILL
    (void)hipMemsetAsync(d_out, 0, (size_t)23920640 * 4, stream);
#endif
#if MK_PER_PHASE
    for (int ph = 0; ph < NPH; ++ph) { a.ph_lo = ph; a.ph_hi = ph + 1; hipLaunchKernelGGL(mk_fwd, dim3(grid), dim3(NTHR), LDS_BYTES, stream, a); }
#else
    a.ph_lo = 0; a.ph_hi = SEQ_N;
    void* args[] = {&a};
    hipError_t e = hipLaunchCooperativeKernel((const void*)mk_fwd, dim3(grid), dim3(NTHR), args, LDS_BYTES, stream);
    if (e != hipSuccess) fprintf(stderr, "cooperative launch failed: %s (grid %d)\n", hipGetErrorString(e), grid);
#endif
}
```

```cpp
#include <hip/hip_runtime.h>
#include <hip/hip_cooperative_groups.h>
#include <cstdio>
#include <cstdint>
namespace cg = cooperative_groups;
namespace pg8 {
#define PG8_LAS __attribute__((address_space(3)))
typedef unsigned short bf16_t;
typedef short bf16x8 __attribute__((ext_vector_type(8)));
typedef float f32x4 __attribute__((ext_vector_type(4)));
typedef unsigned u32x4 __attribute__((ext_vector_type(4)));
constexpr int BM = 256, BK = 64, HALF = 128, HTB = HALF * BK * 2  , STAGE_BYTES = 8 * HTB, NXCD = 8, WGM = 8;

__host__ __device__ __forceinline__ int lds_byte(int r, int c) { const int st = (r >> 4) * 2 + (c >> 5), rr = r & 15, cc = c & 31, ob = rr * 64 + cc * 2; return st * 1024 + (ob ^ (((ob >> 9) & 1) << 5)); }
__host__ __device__ __forceinline__ void stage_rc(int b, int& R, int& C) { const int st = b / 1024, sb = b % 1024, swz = sb ^ (((sb >> 9) & 1) << 5); R = (st >> 1) * 16 + swz / 64; C = (st & 1) * 32 + (swz % 64) / 2; }
__host__ __device__ __forceinline__ int perm32(int rho) { const int n = rho >> 4, i = rho & 15; return 8 * (i >> 2) + 4 * n + (i & 3); }

struct Unit { int pm, pn, k0, nt, part; };
struct Gemm { const bf16_t* A; const bf16_t* Bt; int M, N, K; };

struct StaticOrder {
    int nM, nN, nwg, G, c, ntk;
    __host__ __device__ void init(int M, int N, int G_, int c_, int K_ = 2048) { nM = M / BM; nN = N / BM; nwg = nM * nN; G = G_; c = c_; ntk = K_ / BK; }
    __host__ __device__ bool next(int i, Unit& u) const {
        const long L = (long)i * G + c; if (L >= nwg) return false;
        int wgid = (int)L; { const int q = nwg / NXCD, r = nwg % NXCD, xcd = wgid % NXCD, off = wgid / NXCD; wgid = (xcd < r ? xcd * (q + 1) : r * (q + 1) + (xcd - r) * q) + off; }
        const int nig = WGM * nN, gid = wgid / nig, fm = gid * WGM, gsz = (nM - fm) < WGM ? (nM - fm) : WGM;
        u.pm = fm + ((wgid % nig) % gsz); u.pn = (wgid % nig) / gsz; u.k0 = 0; u.nt = ntk; u.part = 0; return true;
    }
    __device__ __forceinline__ void a_ready(const Unit&) const {}
    __device__ __forceinline__ void done(const Unit&) const {}
};
struct SplitOrder {
    int c, ntk, nsl;
    __host__ __device__ void init(int c_, int K_) { c = c_; ntk = K_ / BK; nsl = 8; }
    __host__ __device__ bool next(int i, Unit& u) const {
        if (i == 0) { const int wgid = (c % 8) * 32 + c / 8, w = wgid % 64; u.pm = (wgid / 64) * 8 + (w % 8); u.pn = w / 8; u.k0 = 0; u.nt = ntk; u.part = 0; return true; }
        if (i == 1 && c < 16 * nsl) { const int ts = c / nsl, sl = c % nsl; u.pm = 32 + (ts >> 3); u.pn = ts & 7; u.nt = ntk / nsl; u.k0 = sl * u.nt; u.part = 1 + sl; return true; }
        return false;
    }
    __device__ __forceinline__ void a_ready(const Unit&) const {}
    __device__ __forceinline__ void done(const Unit&) const {}
};

typedef float f32x2c_t __attribute__((ext_vector_type(2))); typedef __bf16 bf16x2c_t __attribute__((ext_vector_type(2)));
__device__ __forceinline__ unsigned cvt_pk_bf16(float lo, float hi) { const f32x2c_t v = {lo, hi}; const bf16x2c_t b = __builtin_convertvector(v, bf16x2c_t); return __builtin_bit_cast(unsigned, b); }
typedef float f32x2 __attribute__((ext_vector_type(2)));
typedef unsigned u32x2 __attribute__((ext_vector_type(2)));
constexpr int O_YP = 0, O_YS = 16777216, O_KP = 17825792, O_VP = 17858560, O_KS = 17891328, O_VS = 18415616, O_GV = 18939904, O_SP = 19464192, O_SS = 19726336;
constexpr int MROWS = 8704, MPR = 8192, DM = 2048;
__device__ __forceinline__ unsigned short f2bf1(float f) { unsigned u = __builtin_bit_cast(unsigned, f); return (unsigned short)((u + 0x7fffu + ((u >> 16) & 1u)) >> 16); }
__device__ __forceinline__ float gelu_tanh(float x) {
    const float uu = 0.7978845608028654f * (x + 0.044715f * x * x * x);
    const float e = __expf(2.f * uu);
    const float t = 1.f - 2.f * __builtin_amdgcn_rcpf(e + 1.f);
    return 0.5f * x * (1.f + t);
}
__device__ __forceinline__ float sigm(float x) { return __builtin_amdgcn_rcpf(1.f + __expf(-x)); }

__device__ __forceinline__ float xsum16(float s) { const auto r = __builtin_amdgcn_permlane16_swap(__builtin_bit_cast(unsigned, s), __builtin_bit_cast(unsigned, s), false, false); return __builtin_bit_cast(float, r[0]) + __builtin_bit_cast(float, r[1]); }
__device__ __forceinline__ float xsum32(float s) { const auto r = __builtin_amdgcn_permlane32_swap(__builtin_bit_cast(unsigned, s), __builtin_bit_cast(unsigned, s), false, false); return __builtin_bit_cast(float, r[0]) + __builtin_bit_cast(float, r[1]); }
__device__ __forceinline__ float xpart32(float v, bool upper) { const auto r = __builtin_amdgcn_permlane32_swap(__builtin_bit_cast(unsigned, v), __builtin_bit_cast(unsigned, v), false, false); return __builtin_bit_cast(float, upper ? r[0] : r[1]); }
__device__ __forceinline__ float row_rstd(const float* ssp, int row, int fq) {
    const float* p = ssp + (size_t)row * 32 + fq * 8;
    const f32x4 a = *(const f32x4*)p, b = *(const f32x4*)(p + 4);
    float t = ((a[0] + a[1]) + (a[2] + a[3])) + ((b[0] + b[1]) + (b[2] + b[3]));
    t += __shfl_xor(t, 16); t += __shfl_xor(t, 32);
    return rsqrtf(t * (1.f / 2048.f) + 1e-6f);
}
struct EpiInEven {
    static constexpr bool PERM = false, AFTER_DRAIN = false;
    const float* ss; const float* cs; bf16_t *Q, *Kp, *Ks, *Vtp, *Vts, *U; float* GVr; float* out;
    template <int KIND> __device__ __forceinline__ void body(const f32x4 (&acc)[2][2][4][2], const Unit& u, int wr, int wc, int fr, int fq) const {
        const int pn = u.pn;
        const float* ssk = ss; int frk = fr; asm volatile("" : "+v"(frk), "+v"(fq)); asm volatile("" : "+s"(wc), "+s"(wr));
        float rs8[8];
#pragma unroll
        for (int q = 0; q < 8; ++q) rs8[q] = row_rstd(ssk, u.pm * BM + (q >> 2) * HALF + wr * 64 + (q & 3) * 16 + frk, fq);
#pragma unroll
        for (int ai = 0; ai < 2; ++ai)
#pragma unroll
            for (int m = 0; m < 4; ++m) {
                const int row = u.pm * BM + ai * HALF + wr * 64 + m * 16 + frk;
                const float rstd = rs8[ai * 4 + m];
                const bool smp = row >= MPR; const int sb = (row - MPR) >> 5, st = (row - MPR) & 31;
#pragma unroll
                for (int bj = 0; bj < 2; ++bj)
#pragma unroll
                    for (int n = 0; n < 2; ++n) {
                        f32x4 v = acc[ai][bj][m][n] * rstd;
                        const int cl = bj * HALF + wc * 32 + n * 16 + fq * 4;
                        if (KIND <= 1) {
                            if (n == 0 && (wc & 1) == 0) {
                                f32x4 p; p[0] = __shfl_xor(v[0], 32); p[1] = __shfl_xor(v[1], 32); p[2] = __shfl_xor(v[2], 32); p[3] = __shfl_xor(v[3], 32);
                                const f32x4 c0 = *(const f32x4*)(cs + (size_t)row * 16 + (fq & 1) * 8), c1 = *(const f32x4*)(cs + (size_t)row * 16 + (fq & 1) * 8 + 4);
                                const float sg = (fq < 2) ? -1.f : 1.f;
                                v[0] = v[0] * c0[0] + sg * p[0] * c0[1]; v[1] = v[1] * c0[2] + sg * p[1] * c0[3];
                                v[2] = v[2] * c1[0] + sg * p[2] * c1[1]; v[3] = v[3] * c1[2] + sg * p[3] * c1[3];
                            }
                            if (KIND == 0) {
                                v = v * 0.125f; u32x2 w; w.x = cvt_pk_bf16(v[0], v[1]); w.y = cvt_pk_bf16(v[2], v[3]);
                                *(u32x2*)(Q + (size_t)row * 1024 + pn * 256 + cl) = w;
                            } else {
                                u32x2 w; w.x = cvt_pk_bf16(v[0], v[1]); w.y = cvt_pk_bf16(v[2], v[3]);
                                if (smp) { *(u32x2*)(Ks + ((size_t)(sb * 160 + 128 + st)) * 256 + cl) = w; *(f32x4*)(out + O_KS + ((size_t)(sb * 128 + 96 + st)) * 256 + cl) = v; }
                                else { *(u32x2*)(Kp + (size_t)row * 256 + cl) = w; if (row >= MPR - 128) *(f32x4*)(out + O_KP + (size_t)(row - (MPR - 128)) * 256 + cl) = v; }
                            }
                        } else if (KIND == 2) {
                            if (smp) { *(f32x4*)(out + O_VS + ((size_t)(sb * 128 + 96 + st)) * 256 + cl) = v;
#pragma unroll
                                for (int j = 0; j < 4; ++j) Vts[((size_t)(sb * 256 + cl + j)) * 160 + 128 + st] = f2bf1(v[j]); }
                            else { if (row >= MPR - 128) *(f32x4*)(out + O_VP + (size_t)(row - (MPR - 128)) * 256 + cl) = v;
#pragma unroll
                                for (int j = 0; j < 4; ++j) Vtp[(size_t)(cl + j) * MPR + row] = f2bf1(v[j]); }
                        } else if (KIND == 3) {
                            u32x2 w; w.x = cvt_pk_bf16(gelu_tanh(v[0]), gelu_tanh(v[1])); w.y = cvt_pk_bf16(gelu_tanh(v[2]), gelu_tanh(v[3]));
                            *(u32x2*)(U + (size_t)row * 1024 + (pn - 6) * 256 + cl) = w;
                        } else {
                            f32x4 g; g[0] = gelu_tanh(v[0]); g[1] = gelu_tanh(v[1]); g[2] = gelu_tanh(v[2]); g[3] = gelu_tanh(v[3]);
                            *(f32x4*)(GVr + (size_t)row * 1024 + (pn - 10) * 256 + cl) = g;
                        }
                        asm volatile("" ::: "memory");
                    }
            }
    }
    __device__ __forceinline__ void operator()(const f32x4 (&acc)[2][2][4][2], const Unit& u, int wr, int wc, int fr, int fq) const {
        const int pn = u.pn;
        if (pn < 4) body<0>(acc, u, wr, wc, fr, fq);
        else if (pn == 4) body<1>(acc, u, wr, wc, fr, fq);
        else if (pn == 5) body<2>(acc, u, wr, wc, fr, fq);
        else if (pn < 10) body<3>(acc, u, wr, wc, fr, fq);
        else body<4>(acc, u, wr, wc, fr, fq);
    }
};
template <bool FROMX> struct EpiRes {
    static constexpr bool PERM = false, AFTER_DRAIN = false;
    const float* xp; const float* xs; float* H; bf16_t* Hb; float* ssout; float* part;
    __device__ __forceinline__ void operator()(const f32x4 (&acc)[2][2][4][2], const Unit& u, int wr, int wc, int fr, int fq) const {
        asm volatile("" : "+v"(fr), "+v"(fq), "+s"(wc), "+s"(wr));
        if (u.part) {
#pragma unroll
            for (int ai = 0; ai < 2; ++ai)
#pragma unroll
                for (int m = 0; m < 4; ++m) {
                    float* hp = part + ((size_t)(u.part - 1) * 512 + (size_t)((u.pm - 32) * BM + ai * HALF + wr * 64 + m * 16 + fr)) * DM + u.pn * BM + wc * 32 + fq * 4;
#pragma unroll
                    for (int bj = 0; bj < 2; ++bj)
#pragma unroll
                        for (int n = 0; n < 2; ++n) *(f32x4*)(hp + bj * HALF + n * 16) = acc[ai][bj][m][n];
                    asm volatile("" ::: "memory");
                }
            return;
        }
        const int colb = u.pn * BM + wc * 32 + fq * 4;
        f32x4 bcur[4], bnxt[4];
        { const int row = u.pm * BM + wr * 64 + fr; const float* base = FROMX ? (row < MPR ? xp + (size_t)row * DM : xs + (size_t)(row - MPR) * DM) : H + (size_t)row * DM;
#pragma unroll
          for (int p = 0; p < 4; ++p) bcur[p] = *(const f32x4*)(base + colb + (p >> 1) * HALF + (p & 1) * 16); }
#pragma unroll
        for (int q = 0; q < 8; ++q) {
            const int ai = q >> 2, m = q & 3;
            const int row = u.pm * BM + ai * HALF + wr * 64 + m * 16 + fr;
            if (q < 7) { const int rown = u.pm * BM + ((q + 1) >> 2) * HALF + wr * 64 + ((q + 1) & 3) * 16 + fr;
                const float* basen = FROMX ? (rown < MPR ? xp + (size_t)rown * DM : xs + (size_t)(rown - MPR) * DM) : H + (size_t)rown * DM;
#pragma unroll
                for (int p = 0; p < 4; ++p) bnxt[p] = *(const f32x4*)(basen + colb + (p >> 1) * HALF + (p & 1) * 16); }
            float s = 0.f;
#pragma unroll
            for (int p = 0; p < 4; ++p) {
                const int bj = p >> 1, n = p & 1, col = colb + bj * HALF + n * 16;
                const f32x4 h = bcur[p] + acc[ai][bj][m][n];
                *(f32x4*)(H + (size_t)row * DM + col) = h;
                u32x2 w; w.x = cvt_pk_bf16(h[0], h[1]); w.y = cvt_pk_bf16(h[2], h[3]);
                *(u32x2*)(Hb + (size_t)row * DM + col) = w;
                s += (h[0] * h[0] + h[1] * h[1]) + (h[2] * h[2] + h[3] * h[3]);
            }
            s += __shfl_xor(s, 16); s += __shfl_xor(s, 32);
            if (fq == 0) ssout[(size_t)row * 32 + u.pn * 4 + wc] = s;
#pragma unroll
            for (int p = 0; p < 4; ++p) bcur[p] = bnxt[p];
        }
    }
};
struct EpiUp {
    static constexpr bool PERM = true, AFTER_DRAIN = false;
    const float* ss; bf16_t* HID;
    __device__ __forceinline__ void operator()(const f32x4 (&acc)[2][2][4][2], const Unit& u, int wr, int wc, int fr, int fq) const {
        asm volatile("" : "+v"(fr), "+v"(fq), "+s"(wc), "+s"(wr));
        float rs8[8];
#pragma unroll
        for (int q = 0; q < 8; ++q) rs8[q] = row_rstd(ss, u.pm * BM + (q >> 2) * HALF + wr * 64 + (q & 3) * 16 + fr, fq);
#pragma unroll
        for (int ai = 0; ai < 2; ++ai)
#pragma unroll
            for (int m = 0; m < 4; ++m) {
                const int row = u.pm * BM + ai * HALF + wr * 64 + m * 16 + fr;
                const float rstd = rs8[ai * 4 + m];
                bf16_t* rowp = HID + (size_t)row * 8192 + u.pn * BM + wc * 32 + 8 * fq;
#pragma unroll
                for (int bj = 0; bj < 2; ++bj) {
                    f32x4 v0 = acc[ai][bj][m][0] * rstd, v1 = acc[ai][bj][m][1] * rstd;
#pragma unroll
                    for (int j = 0; j < 4; ++j) { const float a = fmaxf(v0[j], 0.f), b = fmaxf(v1[j], 0.f); v0[j] = a * a; v1[j] = b * b; }
                    u32x4 w; w.x = cvt_pk_bf16(v0[0], v0[1]); w.y = cvt_pk_bf16(v0[2], v0[3]); w.z = cvt_pk_bf16(v1[0], v1[1]); w.w = cvt_pk_bf16(v1[2], v1[3]);
                    *(u32x4*)(rowp + bj * HALF) = w;
                }
            }
    }
};
struct EpiInOdd {
    static constexpr bool PERM = true, AFTER_DRAIN = false;
    const float* ss; const float* lbw; float* QH; float* FH; bf16_t* VH; bf16_t* GH;
    __device__ __forceinline__ void operator()(const f32x4 (&acc)[2][2][4][2], const Unit& u, int wr, int wc, int fr, int fq) const {
        const int sec = u.pn >> 3, pnl = u.pn & 7;
        asm volatile("" : "+v"(fr), "+v"(fq), "+s"(wc), "+s"(wr));
        float rs8[8];
#pragma unroll
        for (int q = 0; q < 8; ++q) rs8[q] = row_rstd(ss, u.pm * BM + (q >> 2) * HALF + wr * 64 + (q & 3) * 16 + fr, fq);
#pragma unroll
        for (int ai = 0; ai < 2; ++ai)
#pragma unroll
            for (int m = 0; m < 4; ++m) {
                const int row = u.pm * BM + ai * HALF + wr * 64 + m * 16 + fr;
                const float rstd = rs8[ai * 4 + m];
#pragma unroll
                for (int bj = 0; bj < 2; ++bj) {
                    f32x4 v0 = acc[ai][bj][m][0] * rstd, v1 = acc[ai][bj][m][1] * rstd;
                    const int col = pnl * BM + bj * HALF + wc * 32 + fq * 8;
                    if (sec == 0) {
#pragma unroll
                        for (int j = 0; j < 4; ++j) { v0[j] = v0[j] * sigm(v0[j]); v1[j] = v1[j] * sigm(v1[j]); }
                        *(f32x4*)(QH + (size_t)row * DM + col) = v0; *(f32x4*)(QH + (size_t)row * DM + col + 4) = v1;
                    } else if (sec == 1) {
                        const f32x4 l0a = *(const f32x4*)(lbw + col), l0b = *(const f32x4*)(lbw + col + 4), l1a = *(const f32x4*)(lbw + DM + col), l1b = *(const f32x4*)(lbw + DM + col + 4);
#pragma unroll
                        for (int j = 0; j < 4; ++j) { const float la = sigm(l1a[j] - l0a[j]), lb2 = sigm(l1b[j] - l0b[j]); v0[j] = la + (1.f - la) * sigm(v0[j]); v1[j] = lb2 + (1.f - lb2) * sigm(v1[j]); }
                        *(f32x4*)(FH + (size_t)row * DM + col) = v0; *(f32x4*)(FH + (size_t)row * DM + col + 4) = v1;
                    } else if (sec == 2) {
                        u32x4 w; w.x = cvt_pk_bf16(v0[0], v0[1]); w.y = cvt_pk_bf16(v0[2], v0[3]); w.z = cvt_pk_bf16(v1[0], v1[1]); w.w = cvt_pk_bf16(v1[2], v1[3]);
                        *(u32x4*)(VH + (size_t)row * DM + col) = w;
                    } else {
                        u32x4 w; w.x = cvt_pk_bf16(sigm(v0[0]), sigm(v0[1])); w.y = cvt_pk_bf16(sigm(v0[2]), sigm(v0[3])); w.z = cvt_pk_bf16(sigm(v1[0]), sigm(v1[1])); w.w = cvt_pk_bf16(sigm(v1[2]), sigm(v1[3]));
                        *(u32x4*)(GH + (size_t)row * DM + col) = w;
                    }
                }
            }
    }
};
template <class Epi, class Sched, bool ALIGN_EPI = false, bool SP2 = false>
__device__ __forceinline__ void gemm_phase(PG8_LAS unsigned char* lds, const Gemm g, const Sched& S, const Epi& E, const int tid) {
    const int wid = __builtin_amdgcn_readfirstlane(tid >> 6), lane = tid & 63, wr = wid >> 2, wc = wid & 3, fr = lane & 15, fq = lane >> 4;
    const int K = g.K;
    unsigned voffA[2], voffB[2];
#pragma unroll
    for (int i = 0; i < 2; ++i) { int R, C; stage_rc(tid * 16 + i * 8192, R, C); const int Rb = Epi::PERM ? ((R & ~31) + perm32(R & 31)) : R;
        voffA[i] = (unsigned)(R * K + C) * 2u; voffB[i] = (unsigned)(Rb * K + C) * 2u; }
    const size_t kstep = (size_t)(BK * 2);
    const size_t hstep = (size_t)HALF * K * 2;
    const size_t tstep = 2 * hstep;
    const unsigned ldsw = (unsigned)wid * 1024u;
    const int aoff = lds_byte(wr * 64 + fr, fq * 8), boff = lds_byte(wc * 32 + fr, fq * 8);
#define PG8_SA(b, h) (((b) * 2 + (h)) * HTB)
#define PG8_SB(b, h) ((4 + (b) * 2 + (h)) * HTB)
#define PG8_STAGE(bufoff, gbase, voff) do { _Pragma("unroll") for (int _i = 0; _i < 2; ++_i) \
        __builtin_amdgcn_global_load_lds((const unsigned*)((const char*)(gbase) + (voff)[_i]), (PG8_LAS unsigned*)(lds + (bufoff) + ldsw + _i * 8192), 16, 0, 0); } while (0)
#define PG8_LDA(dst, b, h) do { _Pragma("unroll") for (int m = 0; m < 4; ++m) _Pragma("unroll") for (int k = 0; k < 2; ++k) dst[m][k] = *(const PG8_LAS bf16x8*)(lds + PG8_SA(b, h) + aoff + m * 2048 + k * 1024); } while (0)
#define PG8_LDB(dst, b, h) do { _Pragma("unroll") for (int n = 0; n < 2; ++n) _Pragma("unroll") for (int k = 0; k < 2; ++k) dst[n][k] = *(const PG8_LAS bf16x8*)(lds + PG8_SB(b, h) + boff + n * 2048 + k * 1024); } while (0)
#define PG8_MMA(ai, bj, At, Bt) do { __builtin_amdgcn_s_setprio(1); _Pragma("unroll") for (int m = 0; m < 4; ++m) _Pragma("unroll") for (int n = 0; n < 2; ++n) _Pragma("unroll") for (int k = 0; k < 2; ++k) \
        acc[ai][bj][m][n] = __builtin_amdgcn_mfma_f32_16x16x32_bf16(Bt[n][k], At[m][k], acc[ai][bj][m][n], 0, 0, 0); __builtin_amdgcn_s_setprio(0); } while (0)
#define PG8_WAIT_V(n) asm volatile("s_waitcnt vmcnt(" #n ")" ::: "memory")
#define PG8_WAIT_L(n) asm volatile("s_waitcnt lgkmcnt(" #n ")" ::: "memory")
#define PG8_BAR __builtin_amdgcn_s_barrier()
#define PG8_SCHED __builtin_amdgcn_sched_barrier(0)
    Unit cur, nxt; int ui = 0;
    if (!S.next(0, cur)) return;
    f32x4 acc[2][2][4][2];
#pragma unroll
    for (int a = 0; a < 2; ++a)
#pragma unroll
        for (int b = 0; b < 2; ++b)
#pragma unroll
            for (int m = 0; m < 4; ++m)
#pragma unroll
                for (int n = 0; n < 2; ++n) acc[a][b][m][n] = (f32x4){0.f, 0.f, 0.f, 0.f};
    bf16x8 At[4][2], B0[2][2], B1[2][2];
    const char* cA = (const char*)g.A + (size_t)cur.pm * tstep + (size_t)cur.k0 * kstep; const char* cB = (const char*)g.Bt + (size_t)cur.pn * tstep + (size_t)cur.k0 * kstep;
    S.a_ready(cur);
    if constexpr (SP2) {
        PG8_STAGE(PG8_SB(0, 0), cB, voffB); PG8_STAGE(PG8_SB(0, 1), cB + hstep, voffB); PG8_STAGE(PG8_SA(0, 0), cA, voffA); PG8_STAGE(PG8_SA(0, 1), cA + hstep, voffA);
        if (wr == 1) PG8_BAR;
        PG8_WAIT_V(2); PG8_BAR;
        PG8_STAGE(PG8_SB(1, 0), cB + kstep, voffB); PG8_STAGE(PG8_SA(1, 0), cA + kstep, voffA); PG8_STAGE(PG8_SB(1, 1), cB + hstep + kstep, voffB);
        PG8_WAIT_V(6); PG8_BAR;
    } else {
        PG8_STAGE(PG8_SB(0, 0), cB, voffB); PG8_STAGE(PG8_SA(0, 0), cA, voffA); PG8_STAGE(PG8_SB(0, 1), cB + hstep, voffB); PG8_STAGE(PG8_SA(0, 1), cA + hstep, voffA);
        if (wr == 1) PG8_BAR;
        PG8_WAIT_V(4); PG8_BAR;
        PG8_STAGE(PG8_SB(1, 0), cB + kstep, voffB); PG8_STAGE(PG8_SA(1, 0), cA + kstep, voffA); PG8_STAGE(PG8_SB(1, 1), cB + hstep + kstep, voffB);
        PG8_WAIT_V(6); PG8_BAR;
    }
    for (;;) {
        const bool has_next = S.next(ui + 1, nxt);
        const char* nA = has_next ? (const char*)g.A + (size_t)nxt.pm * tstep + (size_t)nxt.k0 * kstep : cA; const char* nB = has_next ? (const char*)g.Bt + (size_t)nxt.pn * tstep + (size_t)nxt.k0 * kstep : cB;
        const int nt = cur.nt;
        for (int t = 0; t < nt; t += 2) {
            const bool last = (t == nt - 2);
            const char* a1 = cA + (size_t)(t + 1) * kstep;
            const char* a2 = last ? nA : cA + (size_t)(t + 2) * kstep; const char* b2 = last ? nB : cB + (size_t)(t + 2) * kstep;
            const char* a3 = a2 + kstep; const char* b3 = b2 + kstep;
            if (last && has_next) S.a_ready(nxt);
            if constexpr (SP2) {
            PG8_LDB(B0, 0, 0); PG8_LDB(B1, 0, 1); PG8_SCHED; PG8_LDA(At, 0, 0); PG8_STAGE(PG8_SA(1, 1), a1 + hstep, voffA);
            PG8_WAIT_V(8); PG8_WAIT_L(0); PG8_BAR; PG8_MMA(0, 0, At, B0); PG8_MMA(0, 1, At, B1); PG8_BAR; PG8_SCHED;
            PG8_LDA(At, 0, 1); PG8_STAGE(PG8_SB(0, 0), b2, voffB); PG8_STAGE(PG8_SB(0, 1), b2 + hstep, voffB); PG8_STAGE(PG8_SA(0, 0), a2, voffA);
            PG8_WAIT_V(8); PG8_WAIT_L(0); PG8_BAR; PG8_MMA(1, 0, At, B0); PG8_MMA(1, 1, At, B1); PG8_BAR; PG8_SCHED;
            PG8_LDB(B0, 1, 0); PG8_LDB(B1, 1, 1); PG8_SCHED; PG8_LDA(At, 1, 0); PG8_STAGE(PG8_SA(0, 1), a2 + hstep, voffA);
            PG8_WAIT_V(8); PG8_WAIT_L(0); PG8_BAR; PG8_MMA(0, 0, At, B0); PG8_MMA(0, 1, At, B1); PG8_BAR; PG8_SCHED;
            PG8_LDA(At, 1, 1); PG8_STAGE(PG8_SB(1, 0), b3, voffB); PG8_STAGE(PG8_SB(1, 1), b3 + hstep, voffB); PG8_STAGE(PG8_SA(1, 0), a3, voffA);
            PG8_WAIT_V(8); PG8_WAIT_L(0); PG8_BAR; PG8_MMA(1, 0, At, B0); PG8_MMA(1, 1, At, B1); PG8_BAR; PG8_SCHED;
            } else {
            PG8_LDB(B0, 0, 0); PG8_SCHED; PG8_LDA(At, 0, 0); PG8_STAGE(PG8_SA(1, 1), a1 + hstep, voffA);
            PG8_WAIT_L(8); PG8_BAR; PG8_WAIT_L(0); PG8_MMA(0, 0, At, B0); PG8_BAR; PG8_SCHED;
            PG8_LDB(B1, 0, 1); PG8_STAGE(PG8_SB(0, 0), b2, voffB);
            PG8_BAR; PG8_WAIT_L(0); PG8_MMA(0, 1, At, B1); PG8_BAR;
            PG8_LDA(At, 0, 1); PG8_STAGE(PG8_SA(0, 0), a2, voffA);
            PG8_BAR; PG8_WAIT_L(0); PG8_MMA(1, 0, At, B0); PG8_BAR; PG8_SCHED;
            PG8_STAGE(PG8_SB(0, 1), b2 + hstep, voffB);
            PG8_WAIT_V(6); PG8_BAR; PG8_MMA(1, 1, At, B1); PG8_BAR;
            PG8_LDB(B0, 1, 0); PG8_SCHED; PG8_LDA(At, 1, 0); PG8_STAGE(PG8_SA(0, 1), a2 + hstep, voffA);
            PG8_WAIT_L(8); PG8_BAR; PG8_WAIT_L(0); PG8_MMA(0, 0, At, B0); PG8_BAR; PG8_SCHED;
            PG8_LDB(B1, 1, 1); PG8_STAGE(PG8_SB(1, 0), b3, voffB);
            PG8_BAR; PG8_WAIT_L(0); PG8_MMA(0, 1, At, B1); PG8_BAR;
            PG8_LDA(At, 1, 1); PG8_STAGE(PG8_SA(1, 0), a3, voffA);
            PG8_BAR; PG8_WAIT_L(0); PG8_MMA(1, 0, At, B0); PG8_BAR; PG8_SCHED;
            PG8_STAGE(PG8_SB(1, 1), b3 + hstep, voffB);
            PG8_WAIT_V(6); PG8_BAR; PG8_MMA(1, 1, At, B1); PG8_BAR;
            }
        }
        if constexpr (ALIGN_EPI) { if (wr == 0) PG8_BAR; }
        if constexpr (!Epi::AFTER_DRAIN) { E(acc, cur, wr, wc, fr, fq); S.done(cur); }
        if (!has_next) break;
#pragma unroll
        for (int a = 0; a < 2; ++a)
#pragma unroll
            for (int b = 0; b < 2; ++b)
#pragma unroll
                for (int m = 0; m < 4; ++m)
#pragma unroll
                    for (int n = 0; n < 2; ++n) acc[a][b][m][n] = (f32x4){0.f, 0.f, 0.f, 0.f};
        cur = nxt; cA = nA; cB = nB; ++ui;
        if constexpr (ALIGN_EPI) { if (wr == 1) PG8_BAR; }
    }
    PG8_WAIT_V(0);
    if constexpr (!ALIGN_EPI) { if (wr == 0) PG8_BAR; }
    PG8_BAR;
    if constexpr (Epi::AFTER_DRAIN) { E.fused(acc, cur, wr, wc, fr, fq, lds, wid, lane); S.done(cur); }
#undef PG8_SA
#undef PG8_SB
#undef PG8_STAGE
#undef PG8_LDA
#undef PG8_LDB
#undef PG8_MMA
#undef PG8_WAIT_V
#undef PG8_WAIT_L
#undef PG8_BAR
#undef PG8_SCHED
}
}
#define LAS __attribute__((address_space(3)))
typedef unsigned short bf16;
typedef unsigned v4u __attribute__((ext_vector_type(4)));
typedef unsigned v2u __attribute__((ext_vector_type(2)));
typedef float f32x4 __attribute__((ext_vector_type(4)));
typedef float f32x2 __attribute__((ext_vector_type(2)));
typedef float f32x16 __attribute__((ext_vector_type(16)));
typedef short bf16x8 __attribute__((ext_vector_type(8)));
typedef short s16x4 __attribute__((ext_vector_type(4)));
using pg8::O_YP; using pg8::O_YS; using pg8::O_KP; using pg8::O_VP; using pg8::O_KS; using pg8::O_VS; using pg8::O_GV; using pg8::O_SP; using pg8::O_SS;
constexpr int M = 8704, MP = 8192, D = 2048, NIN_E = 3584, DFF = 8192, NWAVES = 8, NTHR = 512;
constexpr size_t MiB = 1u << 20;
constexpr size_t WS_SS = 464 * MiB;
constexpr size_t SSN = (size_t)8704 * 32;
constexpr size_t WS_CS = 1 * MiB;
constexpr size_t WS_W5 = 2 * MiB, WS_W6 = 34 * MiB, WS_WU1 = 42 * MiB, WS_WD1 = 74 * MiB;
constexpr size_t WS_W1 = 106 * MiB, WS_W2 = 120 * MiB, WS_WU0 = 128 * MiB, WS_WD0 = 160 * MiB;
constexpr size_t WS_BIG = 192 * MiB;
constexpr size_t WS_Q = WS_BIG, WS_KP = WS_BIG + 17 * MiB, WS_KS = WS_BIG + 21 * MiB, WS_VTP = WS_BIG + 23 * MiB, WS_VTS = WS_BIG + 27 * MiB, WS_U = WS_BIG + 29 * MiB, WS_GVR = WS_BIG + 46 * MiB;
constexpr size_t WS_QH = 106 * MiB, WS_FH = 174 * MiB, WS_VH = 242 * MiB, WS_GH = 276 * MiB;
constexpr size_t WS_H = 328 * MiB;
constexpr size_t WS_A1 = 396 * MiB;
constexpr size_t WS_A2 = 430 * MiB;
constexpr size_t WS_END = 470 * MiB;
constexpr size_t WS_SEG = WS_A1, WS_DEC = WS_A1 + 16 * MiB;
constexpr int LDS_BYTES = 147456;
constexpr int NPH = 16;

__device__ __forceinline__ unsigned f2bf(float f) { unsigned u = __builtin_bit_cast(unsigned, f); return (u + 0x7fffu + ((u >> 16) & 1u)) >> 16; }
__device__ __forceinline__ unsigned pk2(float lo, float hi) { return pg8::cvt_pk_bf16(lo, hi); }
__device__ __forceinline__ float bf2f(unsigned short b) { return __builtin_bit_cast(float, (unsigned)b << 16); }
__device__ __forceinline__ float wave_sum(float v) {
#pragma unroll
    for (int o = 1; o < 64; o <<= 1) v += __shfl_xor(v, o);
    return v;
}
struct Args { const float* in[20]; float* out; unsigned char* ws; int ph_lo, ph_hi; };

__device__ __forceinline__ void tr64_item(const float* __restrict__ W, int K, int N, bf16* WT, const float* __restrict__ g, LAS float* scr, int item, int lane) {
    const int nblk = N / 64, kb = item / nblk, nb = item % nblk, k0 = 64 * kb, n0 = 64 * nb;
    const int kr = lane >> 4, l4 = lane & 15;
    f32x4 v[16];
#pragma unroll
    for (int i = 0; i < 16; ++i) v[i] = __builtin_nontemporal_load((const f32x4*)(W + (size_t)(k0 + 4 * i + kr) * N + n0 + 4 * l4));
#pragma unroll
    for (int i = 0; i < 16; ++i) { const int k = 4 * i + kr; if (g) v[i] = v[i] * g[k0 + k];
        *(LAS f32x4*)(scr + k * 64 + ((4 * l4) ^ ((k >> 3) << 2))) = v[i]; }
    asm volatile("s_waitcnt lgkmcnt(0)" ::: "memory");
    const int c = lane & 7, nn = lane >> 3;
#pragma unroll
    for (int j = 0; j < 8; ++j) { const int n = nn + 8 * j; const LAS float* s = scr + (8 * c) * 64 + (n ^ (c << 2));
        v4u o; o.x = pk2(s[0 * 64], s[1 * 64]); o.y = pk2(s[2 * 64], s[3 * 64]); o.z = pk2(s[4 * 64], s[5 * 64]); o.w = pk2(s[6 * 64], s[7 * 64]);
        *(v4u*)(WT + (size_t)(n0 + n) * K + k0 + 8 * c) = o; }
    asm volatile("s_waitcnt lgkmcnt(0)" ::: "memory");
}
__device__ __forceinline__ void attn_wave(const bf16* Qp, const bf16* Kp, int kstride, const bf16* Vt, int vstride, int nkb, float sink, bf16* Op, int lane) {
    const int r = lane & 31, h = lane >> 5;
    bf16x8 qf[4];
#pragma unroll
    for (int s = 0; s < 4; ++s) qf[s] = *(const bf16x8*)(Qp + (size_t)r * 1024 + 16 * s + 8 * h);
    f32x16 S[6];
#pragma unroll
    for (int kb = 0; kb < 6; ++kb) {
        S[kb] = (f32x16){0.f,0.f,0.f,0.f,0.f,0.f,0.f,0.f,0.f,0.f,0.f,0.f,0.f,0.f,0.f,0.f};
        if (kb < nkb) {
#pragma unroll
            for (int s = 0; s < 4; ++s) { const bf16x8 kf = *(const bf16x8*)(Kp + (size_t)(kb * 32 + r) * kstride + 16 * s + 8 * h);
                S[kb] = __builtin_amdgcn_mfma_f32_32x32x16_bf16(kf, qf[s], S[kb], 0, 0, 0); }
        }
    }
    float mx = sink;
#pragma unroll
    for (int kb = 0; kb < 6; ++kb) if (kb < nkb) {
#pragma unroll
        for (int i = 0; i < 16; ++i) mx = fmaxf(mx, S[kb][i]); }
    mx = fmaxf(mx, __shfl_xor(mx, 32));
    float l = 0.f;
#pragma unroll
    for (int kb = 0; kb < 6; ++kb) if (kb < nkb) {
#pragma unroll
        for (int i = 0; i < 16; ++i) { const float p = __expf(S[kb][i] - mx); S[kb][i] = p; l += p; } }
    l += __shfl_xor(l, 32);
    l += __expf(sink - mx);
    f32x16 O[2];
    O[0] = (f32x16){0.f,0.f,0.f,0.f,0.f,0.f,0.f,0.f,0.f,0.f,0.f,0.f,0.f,0.f,0.f,0.f}; O[1] = O[0];
#pragma unroll
    for (int kb = 0; kb < 6; ++kb) if (kb < nkb) {
#pragma unroll
        for (int s = 0; s < 2; ++s) {
            v4u pw; pw.x = pk2(S[kb][8 * s + 0], S[kb][8 * s + 1]); pw.y = pk2(S[kb][8 * s + 2], S[kb][8 * s + 3]); pw.z = pk2(S[kb][8 * s + 4], S[kb][8 * s + 5]); pw.w = pk2(S[kb][8 * s + 6], S[kb][8 * s + 7]);
            const bf16x8 pf = __builtin_bit_cast(bf16x8, pw);
#pragma unroll
            for (int db = 0; db < 2; ++db) {
                const bf16* vp = Vt + (size_t)(db * 32 + r) * vstride + kb * 32 + 16 * s + 4 * h;
                const v2u lo = *(const v2u*)vp, hi = *(const v2u*)(vp + 8);
                v4u vw; vw.x = lo.x; vw.y = lo.y; vw.z = hi.x; vw.w = hi.y;
                O[db] = __builtin_amdgcn_mfma_f32_32x32x16_bf16(__builtin_bit_cast(bf16x8, vw), pf, O[db], 0, 0, 0);
            }
        }
    }
    const float il = 1.f / l;
#pragma unroll
    for (int db = 0; db < 2; ++db)
#pragma unroll
        for (int g4 = 0; g4 < 4; ++g4) {
            v2u w; w.x = pk2(O[db][4 * g4 + 0] * il, O[db][4 * g4 + 1] * il); w.y = pk2(O[db][4 * g4 + 2] * il, O[db][4 * g4 + 3] * il);
            *(v2u*)(Op + (size_t)r * 2048 + db * 32 + 8 * g4 + 4 * h) = w;
        }
}

__device__ __forceinline__ void gmlp_unit(unsigned char* lds, const float* GVr, const bf16* U, const float* gamma, const float* Wsp, const float* bias, bf16* AB, float* gvout, int row0, int nrows, int hg, int tid) {
    bf16* gvT = (bf16*)lds;
    const int lane = tid & 63, wave = tid >> 6;
    {
        const int q = tid >> 2, part = tid & 3;
        f32x4 v[8]; float s = 0.f;
        if (q < nrows) {
#pragma unroll
            for (int j = 0; j < 8; ++j) { v[j] = *(const f32x4*)(GVr + (size_t)(row0 + q) * 1024 + hg * 128 + part * 32 + 4 * j); s += (v[j][0] + v[j][1]) + (v[j][2] + v[j][3]); }
        } else {
#pragma unroll
            for (int j = 0; j < 8; ++j) v[j] = (f32x4){0.f, 0.f, 0.f, 0.f};
        }
        s += __shfl_xor(s, 1); s += __shfl_xor(s, 2);
        const float mu = s * (1.f / 128.f); float s2 = 0.f;
#pragma unroll
        for (int j = 0; j < 8; ++j) { v[j] = v[j] - mu; s2 += (v[j][0] * v[j][0] + v[j][1] * v[j][1]) + (v[j][2] * v[j][2] + v[j][3] * v[j][3]); }
        s2 += __shfl_xor(s2, 1); s2 += __shfl_xor(s2, 2);
        const float rstd = rsqrtf(s2 * (1.f / 128.f) + 1e-6f);
#pragma unroll
        for (int j = 0; j < 8; ++j) {
            const f32x4 gm = *(const f32x4*)(gamma + hg * 128 + part * 32 + 4 * j);
            f32x4 o = v[j] * rstd * gm;
            if (q >= nrows) o = (f32x4){0.f, 0.f, 0.f, 0.f};
            if (gvout && q < nrows) *(f32x4*)(gvout + ((size_t)q * 8 + hg) * 128 + part * 32 + 4 * j) = o;
#pragma unroll
            for (int e = 0; e < 4; ++e) gvT[(part * 32 + 4 * j + e) * 136 + q] = (bf16)f2bf(o[e]);
        }
    }
    __syncthreads();
    const int r = lane & 31, hh = lane >> 5;
    const int pb = wave >> 1;
    if (pb * 32 < nrows) {
        const int nks = (nrows == 32) ? 2 : (pb < 2 ? 4 : 8);
        f32x16 acc[2];
        acc[0] = (f32x16){0.f,0.f,0.f,0.f,0.f,0.f,0.f,0.f,0.f,0.f,0.f,0.f,0.f,0.f,0.f,0.f}; acc[1] = acc[0];
        for (int s = 0; s < nks; ++s) {
            const float* wp = Wsp + ((size_t)hg * 128 + pb * 32 + r) * 128 + 16 * s + 8 * hh;
            const f32x4 w0 = *(const f32x4*)wp, w1 = *(const f32x4*)(wp + 4);
            v4u aw; aw.x = pk2(w0[0], w0[1]); aw.y = pk2(w0[2], w0[3]); aw.z = pk2(w1[0], w1[1]); aw.w = pk2(w1[2], w1[3]);
            const bf16x8 af = __builtin_bit_cast(bf16x8, aw);
#pragma unroll
            for (int t = 0; t < 2; ++t) {
                const int db = (wave & 1) * 2 + t;
                const bf16x8 bfr = *(const bf16x8*)(gvT + (db * 32 + r) * 136 + 16 * s + 8 * hh);
                acc[t] = __builtin_amdgcn_mfma_f32_32x32x16_bf16(bfr, af, acc[t], 0, 0, 0);
            }
        }
        {
            const int p = pb * 32 + r; const float bs = bias[hg * 128 + p];
#pragma unroll
            for (int t = 0; t < 2; ++t)
#pragma unroll
                for (int g4 = 0; g4 < 4; ++g4) {
                    const int dcol = hg * 128 + ((wave & 1) * 2 + t) * 32 + 8 * g4 + 4 * hh;
                    const v2u uw = *(const v2u*)(U + (size_t)(row0 + p) * 1024 + dcol);
                    v2u ow; ow.x = pk2(bf2f((unsigned short)(uw.x & 0xffff)) * (acc[t][4 * g4 + 0] + bs), bf2f((unsigned short)(uw.x >> 16)) * (acc[t][4 * g4 + 1] + bs));
                    ow.y = pk2(bf2f((unsigned short)(uw.y & 0xffff)) * (acc[t][4 * g4 + 2] + bs), bf2f((unsigned short)(uw.y >> 16)) * (acc[t][4 * g4 + 3] + bs));
                    *(v2u*)(AB + (size_t)(row0 + p) * 2048 + 1024 + dcol) = ow;
                }
        }
    }
    __syncthreads();
}

template <bool OUT, bool DECAY>
__device__ __forceinline__ void hgrn_unit(unsigned char* lds, const float* QH, const float* FH, const bf16* VH, const bf16* GH, const float* gon, bf16* Oo,
                                          int hd, int row0, int L, int init, const float* sin, const float* SEG, const float* DEC, int gseg, float* sout, float* decout, int tid) {
    float* qs = (float*)lds;
    float* fs = qs + 2 * 2048;
    float* vs = fs + 2 * 2048;
    float* op = vs + 2 * 2048;
    const int lane = tid & 63, w = tid >> 6, e = (w & 1) * 64 + lane, dq = w >> 1, d0 = dq * 32;
    f32x2 S[16];
    if (init == 1) {
#pragma unroll
        for (int i = 0; i < 16; ++i) { S[i].x = sin[(size_t)(d0 + 2 * i) * 128 + e]; S[i].y = sin[(size_t)(d0 + 2 * i + 1) * 128 + e]; }
    } else {
#pragma unroll
        for (int i = 0; i < 16; ++i) S[i] = (f32x2){0.f, 0.f};
        if (init == 2) {
            for (int g = 0; g < gseg; ++g) {
                const float* Lp = SEG + ((size_t)(hd * 16 + g) * 128 + d0) * 128 + e; const float* Dp = DEC + (size_t)(hd * 16 + g) * 128 + d0;
#pragma unroll
                for (int i = 0; i < 16; ++i) { S[i].x = Dp[2 * i] * S[i].x + Lp[(size_t)(2 * i) * 128]; S[i].y = Dp[2 * i + 1] * S[i].y + Lp[(size_t)(2 * i + 1) * 128]; }
            }
        }
    }
    float dec = 1.f;
    const int tt = tid >> 5, c4 = (tid & 31) * 4;
    const int nb = L >> 4;
    f32x4 rq, rf; v2u rv;
    {
        const size_t off = (size_t)(row0 + tt) * 2048 + hd * 128 + c4;
        if (OUT) rq = *(const f32x4*)(QH + off);
        rf = *(const f32x4*)(FH + off); rv = *(const v2u*)(VH + off);
        if (OUT) *(f32x4*)(qs + tt * 128 + c4) = rq;
        *(f32x4*)(fs + tt * 128 + c4) = rf;
        *(f32x4*)(vs + tt * 128 + c4) = (f32x4){bf2f((unsigned short)(rv.x & 0xffff)), bf2f((unsigned short)(rv.x >> 16)), bf2f((unsigned short)(rv.y & 0xffff)), bf2f((unsigned short)(rv.y >> 16))};
    }
    __syncthreads();
    for (int b = 0; b < nb; ++b) {
        const int buf = b & 1;
        if (b + 1 < nb) {
            const size_t off = (size_t)(row0 + (b + 1) * 16 + tt) * 2048 + hd * 128 + c4;
            if (OUT) rq = *(const f32x4*)(QH + off);
            rf = *(const f32x4*)(FH + off); rv = *(const v2u*)(VH + off);
        }
        const float* qb = qs + buf * 2048 + d0; const float* fb = fs + buf * 2048 + d0; const float* vb = vs + buf * 2048 + e;
#pragma unroll 2
        for (int t = 0; t < 16; ++t) {
            const float v = vb[t * 128]; const f32x2 v2 = (f32x2){v, v};
            f32x2 o2 = (f32x2){0.f, 0.f};
#pragma unroll
            for (int i = 0; i < 8; ++i) {
                const f32x4 f4 = *(const f32x4*)(fb + t * 128 + 4 * i);
                S[2 * i] = (f32x2){f4[0], f4[1]} * (S[2 * i] - v2) + v2;
                S[2 * i + 1] = (f32x2){f4[2], f4[3]} * (S[2 * i + 1] - v2) + v2;
                if (OUT) { const f32x4 q4 = *(const f32x4*)(qb + t * 128 + 4 * i); o2 += (f32x2){q4[0], q4[1]} * S[2 * i]; o2 += (f32x2){q4[2], q4[3]} * S[2 * i + 1]; }
            }
            if (OUT) op[((buf * 16 + t) * 4 + dq) * 128 + e] = o2.x + o2.y;
        }
        if (DECAY) { if (tid < 128) {
#pragma unroll
            for (int t = 0; t < 16; ++t) dec *= fs[buf * 2048 + t * 128 + tid]; } }
        if (b + 1 < nb) {
            const int nbuf = buf ^ 1;
            if (OUT) *(f32x4*)(qs + nbuf * 2048 + tt * 128 + c4) = rq;
            *(f32x4*)(fs + nbuf * 2048 + tt * 128 + c4) = rf;
            *(f32x4*)(vs + nbuf * 2048 + tt * 128 + c4) = (f32x4){bf2f((unsigned short)(rv.x & 0xffff)), bf2f((unsigned short)(rv.x >> 16)), bf2f((unsigned short)(rv.y & 0xffff)), bf2f((unsigned short)(rv.y >> 16))};
        }
        __syncthreads();
        if (OUT) {
            const float* ob = op + (buf * 16 + tt) * 512 + c4;
            f32x4 o = *(const f32x4*)ob + *(const f32x4*)(ob + 128) + *(const f32x4*)(ob + 256) + *(const f32x4*)(ob + 384);
            float sq = (o[0] * o[0] + o[1] * o[1]) + (o[2] * o[2] + o[3] * o[3]);
#pragma unroll
            for (int x = 1; x < 32; x <<= 1) sq += __shfl_xor(sq, x);
            const float rms = rsqrtf(sq * (1.f / 128.f) + 1e-6f);
            const size_t off = (size_t)(row0 + b * 16 + tt) * 2048 + hd * 128 + c4;
            const v2u gw = *(const v2u*)(GH + off); const f32x4 gn = *(const f32x4*)(gon + hd * 128 + c4);
            const float r0 = o[0] * rms * gn[0] * bf2f((unsigned short)(gw.x & 0xffff)), r1 = o[1] * rms * gn[1] * bf2f((unsigned short)(gw.x >> 16));
            const float r2 = o[2] * rms * gn[2] * bf2f((unsigned short)(gw.y & 0xffff)), r3 = o[3] * rms * gn[3] * bf2f((unsigned short)(gw.y >> 16));
            v2u ow; ow.x = pk2(r0, r1); ow.y = pk2(r2, r3);
            *(v2u*)(Oo + off) = ow;
        }
    }
    if (sout) {
#pragma unroll
        for (int i = 0; i < 16; ++i) { sout[(size_t)(d0 + 2 * i) * 128 + e] = S[i].x; sout[(size_t)(d0 + 2 * i + 1) * 128 + e] = S[i].y; }
    }
    if (DECAY) { if (decout && tid < 128) decout[tid] = dec; }
    __syncthreads();
}
#define XB_TMO      128
#define XB_XCNT(j)  (256  + 64 * (j))
#define XB_XSUB(j)  (1280 + 64 * (j))
#define XB_XGEN(j)  (2304 + 64 * (j))
#define XB_TOP      3328
#define XB_TOPGEN   3392
#define XCD_BAR_WORDS 3456
#define XB_SPIN_CAP (1u << 18)

__device__ __forceinline__ unsigned xb_ld(unsigned* p)              { return __hip_atomic_load(p, __ATOMIC_RELAXED, __HIP_MEMORY_SCOPE_AGENT); }
__device__ __forceinline__ unsigned xb_add(unsigned* p, unsigned v) { return __hip_atomic_fetch_add(p, v, __ATOMIC_RELAXED, __HIP_MEMORY_SCOPE_AGENT); }
__device__ __forceinline__ unsigned xb_xcc_id() { return (unsigned)__builtin_amdgcn_s_getreg((3 << 11) | 20) & 0xFu; }
#define XB_SPIN(cond, bar) do { unsigned _sp = 0; while (cond) { __builtin_amdgcn_s_sleep(1); \
    if ((++_sp & 255u) == 0u) { if (xb_ld(&(bar)[XB_TMO])) break; if (_sp > XB_SPIN_CAP) { atomicAdd(&(bar)[XB_TMO], 1u); break; } } } } while (0)

struct XcdBarrier {
    unsigned* bar; unsigned x;
    volatile LAS unsigned* st;
};

__device__ __forceinline__ XcdBarrier xcd_barrier_post(unsigned* bar, volatile LAS unsigned* st) {
    XcdBarrier b; b.bar = bar; b.x = xb_xcc_id(); b.st = st;
    if (threadIdx.x == 0) (void)xb_add(&bar[XB_XCNT(b.x)], 1u);
    return b;
}
__device__ __forceinline__ void xcd_barrier_complete(unsigned* bar, unsigned x, unsigned& nloc, unsigned& nx) {
    const unsigned G = gridDim.x * gridDim.y * gridDim.z;
    unsigned sum, cnt, mine, sp = 0u;
    for (;;) {
        sum = 0u; cnt = 0u; mine = 0u;
#pragma unroll
        for (unsigned j = 0; j < 16; ++j) { const unsigned c = xb_ld(&bar[XB_XCNT(j)]); sum += c; cnt += (c > 0u) ? 1u : 0u; mine = (j == x) ? c : mine; }
        if (sum == G) break;
        __builtin_amdgcn_s_sleep(1);
        if ((++sp & 255u) == 0u) { if (xb_ld(&bar[XB_TMO])) break; if (sp > XB_SPIN_CAP) { atomicAdd(&bar[XB_TMO], 1u); break; } }
    }
    nloc = mine > 0u ? mine : 1u; nx = cnt > 0u ? cnt : 1u;
}

__device__ __forceinline__ void xcd_barrier(const XcdBarrier& b) {
    asm volatile("s_waitcnt vmcnt(0)" ::: "memory");
    __syncthreads();
    if (threadIdx.x == 0) {
        unsigned* bar = b.bar;
        __builtin_amdgcn_s_waitcnt(0);
        unsigned nloc = b.st[0], nx = b.st[1];
        if (nloc == 0u) { xcd_barrier_complete(bar, b.x, nloc, nx); b.st[0] = nloc; b.st[1] = nx; }
        const unsigned old = xb_add(&bar[XB_XSUB(b.x)], 1u);
        const unsigned gen = old / nloc;
        if (old + 1u == (gen + 1u) * nloc) {
            __builtin_amdgcn_fence(__ATOMIC_RELEASE, "agent");
            asm volatile("s_waitcnt vmcnt(0)" ::: "memory");
            const unsigned og = xb_add(&bar[XB_TOP], 1u);
            const unsigned tg = og / nx;
            if (og + 1u == (tg + 1u) * nx) xb_add(&bar[XB_TOPGEN], 1u);
            else XB_SPIN(xb_ld(&bar[XB_TOPGEN]) == tg, bar);
            __builtin_amdgcn_fence(__ATOMIC_ACQUIRE, "agent");
            xb_add(&bar[XB_XGEN(b.x)], 1u);
            asm volatile("s_waitcnt vmcnt(0)" ::: "memory");
        } else {
            XB_SPIN(xb_ld(&bar[XB_XGEN(b.x)]) == gen, bar);
            __builtin_amdgcn_fence(__ATOMIC_ACQUIRE, "agent");
            asm volatile("s_waitcnt vmcnt(0)" ::: "memory");
        }
    }
    __syncthreads();
}
constexpr int HG_QH = 0, HG_KT = 8704, HG_KHT = 17408, HG_VT = 27648, HG_D = 37888, HG_PART = 38400, HG_OST = 40448;
__device__ __forceinline__ bf16x8 pack8(const f32x16& x, int o) {
    v4u w; w.x = pg8::cvt_pk_bf16(x[o + 0], x[o + 1]); w.y = pg8::cvt_pk_bf16(x[o + 2], x[o + 3]); w.z = pg8::cvt_pk_bf16(x[o + 4], x[o + 5]); w.w = pg8::cvt_pk_bf16(x[o + 6], x[o + 7]);
    return __builtin_bit_cast(bf16x8, w);
}
template <bool OUT>
__device__ __forceinline__ void hg_unit(unsigned char* lds, const float* QH, const float* FH, const bf16* VH, const bf16* GH, const float* gon, bf16* Oo,
                                        int hd, int row0, int nch, int init, const float* sin, const float* SEG, const float* DEC, int gseg, float* sout, float* decout, int tid, float* zflag = nullptr) {
    bf16* Qh = (bf16*)(lds + HG_QH); bf16* Kt = (bf16*)(lds + HG_KT); bf16* KhT = (bf16*)(lds + HG_KHT); bf16* VT = (bf16*)(lds + HG_VT);
    float* Dv = (float*)(lds + HG_D); float* Pp = (float*)(lds + HG_PART); float* Ost = (float*)(lds + HG_OST);
    const int lane = tid & 63, w = __builtin_amdgcn_readfirstlane(tid >> 6), r = lane & 31, hh = lane >> 5;
    const int d = tid & 127, tq = __builtin_amdgcn_readfirstlane(tid >> 7);
    const f32x16 Z16 = (f32x16){0.f,0.f,0.f,0.f,0.f,0.f,0.f,0.f,0.f,0.f,0.f,0.f,0.f,0.f,0.f,0.f};
    f32x16 S[4];
#pragma unroll
    for (int db = 0; db < 4; ++db) S[db] = Z16;
    if (w < 4) {
        if (init == 1) {
#pragma unroll
            for (int db = 0; db < 4; ++db)
#pragma unroll
                for (int i = 0; i < 16; ++i) S[db][i] = sin[(size_t)(db * 32 + (i & 3) + 8 * (i >> 2) + 4 * hh) * 128 + w * 32 + r];
        }
    }
    float dec = 1.f;
    float pf[8], pq[8]; unsigned short pv[8];
    {
        const size_t off = (size_t)(row0 + tq * 8) * 2048 + hd * 128 + d;
#pragma unroll
        for (int j = 0; j < 8; ++j) { pf[j] = FH[off + (size_t)j * 2048]; pv[j] = VH[off + (size_t)j * 2048]; if (OUT) pq[j] = QH[off + (size_t)j * 2048]; }
    }
    for (int c = 0; c < nch; ++c) {
        v4u gw = (v4u){0u, 0u, 0u, 0u};
        if (OUT) gw = *(const v4u*)(GH + (size_t)(row0 + c * 32 + (tid >> 4)) * 2048 + hd * 128 + (tid & 15) * 8);
        float A[8]; float run = 1.f;
#pragma unroll
        for (int j = 0; j < 8; ++j) { run *= pf[j]; A[j] = run; }
        Pp[tq * 128 + d] = run;
        __syncthreads();
        const float p0 = Pp[d], p1 = Pp[128 + d], p2 = Pp[256 + d], p3 = Pp[384 + d];
        const float offp = tq == 0 ? 1.f : tq == 1 ? p0 : tq == 2 ? p0 * p1 : p0 * p1 * p2;
        const float tot = (p0 * p1) * (p2 * p3);
#pragma unroll
        for (int j = 0; j < 8; ++j) {
            const int t = tq * 8 + j; const float a = A[j] * offp, ia = __builtin_amdgcn_rcpf(a), k = 1.f - pf[j];
            if (OUT) Qh[t * 136 + d] = (bf16)f2bf(pq[j] * a);
            if (OUT) Kt[t * 136 + d] = (bf16)f2bf(k * ia);
            KhT[d * 40 + t] = (bf16)f2bf(k * tot * ia);
            VT[d * 40 + t] = pv[j];
        }
        if (tq == 0) { Dv[d] = tot; if (!OUT) dec *= tot; }
        if (c + 1 < nch) {
            const size_t off = (size_t)(row0 + (c + 1) * 32 + tq * 8) * 2048 + hd * 128 + d;
#pragma unroll
            for (int j = 0; j < 8; ++j) { pf[j] = FH[off + (size_t)j * 2048]; pv[j] = VH[off + (size_t)j * 2048]; if (OUT) pq[j] = QH[off + (size_t)j * 2048]; }
        }
        __syncthreads();
        if (w < 4) {
            if (OUT) {
                f32x16 P = Z16;
#pragma unroll
                for (int kk = 0; kk < 8; ++kk) {
                    const bf16x8 a = *(const bf16x8*)(Kt + r * 136 + 16 * kk + 8 * hh), b = *(const bf16x8*)(Qh + r * 136 + 16 * kk + 8 * hh);
                    P = __builtin_amdgcn_mfma_f32_32x32x16_bf16(a, b, P, 0, 0, 0);
                }
#pragma unroll
                for (int i = 0; i < 16; ++i) { const int s = (i & 3) + 8 * (i >> 2) + 4 * hh; if (s > r) P[i] = 0.f; }
                f32x16 o = Z16;
#pragma unroll
                for (int db = 0; db < 4; ++db)
#pragma unroll
                    for (int kk = 0; kk < 2; ++kk) {
                        const bf16* qp = Qh + r * 136 + db * 32 + 16 * kk + 4 * hh;
                        const v2u lo = *(const v2u*)qp, hi = *(const v2u*)(qp + 8);
                        v4u bw; bw.x = lo.x; bw.y = lo.y; bw.z = hi.x; bw.w = hi.y;
                        o = __builtin_amdgcn_mfma_f32_32x32x16_bf16(pack8(S[db], 8 * kk), __builtin_bit_cast(bf16x8, bw), o, 0, 0, 0);
                    }
#pragma unroll
                for (int kk = 0; kk < 2; ++kk) {
                    const bf16* vp = VT + (w * 32 + r) * 40 + 16 * kk + 4 * hh;
                    const v2u lo = *(const v2u*)vp, hi = *(const v2u*)(vp + 8);
                    v4u aw; aw.x = lo.x; aw.y = lo.y; aw.z = hi.x; aw.w = hi.y;
                    o = __builtin_amdgcn_mfma_f32_32x32x16_bf16(__builtin_bit_cast(bf16x8, aw), pack8(P, 8 * kk), o, 0, 0, 0);
                }
#pragma unroll
                for (int g4 = 0; g4 < 4; ++g4) *(f32x4*)(Ost + r * 132 + w * 32 + 8 * g4 + 4 * hh) = (f32x4){o[4 * g4], o[4 * g4 + 1], o[4 * g4 + 2], o[4 * g4 + 3]};
            }
#pragma unroll
            for (int db = 0; db < 4; ++db) {
#pragma unroll
                for (int g4 = 0; g4 < 4; ++g4) { const f32x4 dv = *(const f32x4*)(Dv + db * 32 + 8 * g4 + 4 * hh);
#pragma unroll
                    for (int j = 0; j < 4; ++j) S[db][4 * g4 + j] *= dv[j]; }
#pragma unroll
                for (int kk = 0; kk < 2; ++kk) {
                    const bf16x8 a = *(const bf16x8*)(KhT + (db * 32 + r) * 40 + 16 * kk + 8 * hh), b = *(const bf16x8*)(VT + (w * 32 + r) * 40 + 16 * kk + 8 * hh);
                    S[db] = __builtin_amdgcn_mfma_f32_32x32x16_bf16(a, b, S[db], 0, 0, 0);
                }
            }
        }
        if (OUT) {
            __syncthreads();
            const int t = tid >> 4, e8 = (tid & 15) * 8;
            const f32x4 o0 = *(const f32x4*)(Ost + t * 132 + e8), o1 = *(const f32x4*)(Ost + t * 132 + e8 + 4);
            float sq = ((o0[0] * o0[0] + o0[1] * o0[1]) + (o0[2] * o0[2] + o0[3] * o0[3])) + ((o1[0] * o1[0] + o1[1] * o1[1]) + (o1[2] * o1[2] + o1[3] * o1[3]));
#pragma unroll
            for (int x = 1; x < 16; x <<= 1) sq += __shfl_xor(sq, x);
            const float rms = rsqrtf(sq * (1.f / 128.f) + 1e-6f);
            const size_t off = (size_t)(row0 + c * 32 + t) * 2048 + hd * 128 + e8;
            const f32x4 g0 = *(const f32x4*)(gon + hd * 128 + e8), g1 = *(const f32x4*)(gon + hd * 128 + e8 + 4);
            v4u ow;
            ow.x = pk2(o0[0] * rms * g0[0] * bf2f((unsigned short)(gw.x & 0xffff)), o0[1] * rms * g0[1] * bf2f((unsigned short)(gw.x >> 16)));
            ow.y = pk2(o0[2] * rms * g0[2] * bf2f((unsigned short)(gw.y & 0xffff)), o0[3] * rms * g0[3] * bf2f((unsigned short)(gw.y >> 16)));
            ow.z = pk2(o1[0] * rms * g1[0] * bf2f((unsigned short)(gw.z & 0xffff)), o1[1] * rms * g1[1] * bf2f((unsigned short)(gw.z >> 16)));
            ow.w = pk2(o1[2] * rms * g1[2] * bf2f((unsigned short)(gw.w & 0xffff)), o1[3] * rms * g1[3] * bf2f((unsigned short)(gw.w >> 16)));
            *(v4u*)(Oo + off) = ow;
        }
    }
    if (sout && w < 4) {
#pragma unroll
        for (int db = 0; db < 4; ++db)
#pragma unroll
            for (int i = 0; i < 16; ++i) sout[(size_t)(db * 32 + (i & 3) + 8 * (i >> 2) + 4 * hh) * 128 + w * 32 + r] = S[db][i];
    }
    if (!OUT) {
        if (decout && tid < 128) decout[tid] = dec;
        const int anynz = __syncthreads_or(tid < 128 && dec > 0.f);
        if (zflag && tid == 0) *zflag = anynz ? 0.f : 1.f;
    }
    __syncthreads();
}
#ifndef DBG_A2PTR
#define DBG_A2PTR A2
#endif
#ifndef SEQ_LO
#define SEQ_LO 0xbad98e76d54d3210ull
#define SEQ_HI 0xcull
#define SEQ_N 17
#endif
#ifndef DBG_SSI
#define DBG_SSI 4
#endif
#ifndef PHMASK
#define PHMASK 0xffff
#endif
#define PHEN(k) (((PHMASK) >> (k)) & 1)
#ifndef MK_PER_PHASE
#define MK_PER_PHASE 0
#endif
#define CAS __attribute__((address_space(4)))
#define INP(i) (*(const float* const CAS*)(kp + 8 * (i)))
#define xp INP(0)
#define xs INP(1)
#define ss ((float*)(ws + WS_SS))
#define cs ((float*)(ws + WS_CS))
#define A1 ((bf16*)(ws + WS_A1))
#define A2 ((bf16*)(ws + WS_A2))
#define H ((float*)(ws + WS_H))
#define HID ((bf16*)(ws + WS_BIG))
#define Qb ((bf16*)(ws + WS_Q))
#define Kpb ((bf16*)(ws + WS_KP))
#define Ksb ((bf16*)(ws + WS_KS))
#define Vtp ((bf16*)(ws + WS_VTP))
#define Vts ((bf16*)(ws + WS_VTS))
#define Ub ((bf16*)(ws + WS_U))
#define GVr ((float*)(ws + WS_GVR))
#define QH ((float*)(ws + WS_QH))
#define FH ((float*)(ws + WS_FH))
#define VH ((bf16*)(ws + WS_VH))
#define GH ((bf16*)(ws + WS_GH))
#define SEG ((float*)(ws + WS_SEG))
#define DEC ((float*)(ws + WS_DEC))

#define CONV_L1(j_) do { int r_ = (j_); \
    if (r_ < 4096) { tr64_item(INP(14), 2048, 8192, (bf16*)(ws + WS_W5), INP(5) + 2048, scr, r_, lane); break; } r_ -= 4096; \
    if (r_ < 1024) { tr64_item(INP(15), 2048, 2048, (bf16*)(ws + WS_W6), nullptr, scr, r_, lane); break; } r_ -= 1024; \
    if (r_ < 4096) { tr64_item(INP(18) + (size_t)2048 * 8192, 2048, 8192, (bf16*)(ws + WS_WU1), INP(6) + 2048, scr, r_, lane); break; } r_ -= 4096; \
    tr64_item(INP(19) + (size_t)2048 * 8192, 8192, 2048, (bf16*)(ws + WS_WD1), nullptr, scr, r_, lane); } while (0)
#define CONV_RANGE(j0_, j1_, w0_, nw_) do { LAS float* scr = (LAS float*)(lds3 + wave * 16384); \
    for (int j__ = (j0_) + (w0_) * NWAVES + wave; j__ < (j1_); j__ += (nw_) * NWAVES) CONV_L1(j__); } while (0)
__global__ void __launch_bounds__(NTHR, 2) mk_fwd(Args a) {
    extern __shared__ __attribute__((aligned(16))) unsigned char lds[];
    const int G = gridDim.x, bid = blockIdx.x;
    cg::grid_group grid = cg::this_grid();
    volatile LAS unsigned* xb_misc = (volatile LAS unsigned*)((LAS unsigned char*)lds + 131072 + 320);
    if (threadIdx.x < 32) xb_misc[threadIdx.x] = 0u;
    __syncthreads();
    XcdBarrier xbar = xcd_barrier_post((unsigned*)a.ws, xb_misc + 8);

    int nfin = 0;
    for (int st = a.ph_lo; st < a.ph_hi; ++st) {
        const int ph = (int)(((st < 16 ? (unsigned long long)SEQ_LO >> (4 * st) : (unsigned long long)SEQ_HI >> (4 * (st - 16)))) & 15ull);
        int tid = threadIdx.x;
        const CAS unsigned char* kp = (const CAS unsigned char*)__builtin_amdgcn_kernarg_segment_ptr();
        asm volatile("" : "+v"(tid)); asm volatile("" : "+s"(kp));
        unsigned char* ws = *(unsigned char* const CAS*)(kp + 168); float* out = *(float* const CAS*)(kp + 160);
        const int lane = tid & 63, wave = __builtin_amdgcn_readfirstlane(tid >> 6);
        LAS unsigned char* lds3 = (LAS unsigned char*)lds;
        if (ph == 0 && PHEN(0)) {
            LAS float* scr = (LAS float*)(lds3 + wave * 16384);
            const int gw = bid * NWAVES + wave, NGW = G * NWAVES;
            constexpr int J_1 = 32 * 56, J_2 = 32 * 32, J_U = 32 * 128, J_D = 128 * 32;
            for (int it = gw; it < J_1 + J_2 + J_U + J_D; it += NGW) {
                int r = it;
                if (r < J_1) { tr64_item(INP(8), 2048, 3584, (bf16*)(ws + WS_W1), INP(5), scr, r, lane); continue; } r -= J_1;
                if (r < J_2) { tr64_item(INP(9), 2048, 2048, (bf16*)(ws + WS_W2), nullptr, scr, r, lane); continue; } r -= J_2;
                if (r < J_U) { tr64_item(INP(18), 2048, 8192, (bf16*)(ws + WS_WU0), INP(6), scr, r, lane); continue; } r -= J_U;
                tr64_item(INP(19), 8192, 2048, (bf16*)(ws + WS_WD0), nullptr, scr, r, lane);
            }
            CONV_RANGE(0, 2046, bid, G); CONV_RANGE(12572, 13312, bid, G);
            for (int m = gw; m < M; m += NGW) {
                const float* xr = m < MP ? xp + (size_t)m * D : xs + (size_t)(m - MP) * D;
                f32x4 v[8]; float s = 0.f;
#pragma unroll
                for (int j = 0; j < 8; ++j) { v[j] = __builtin_nontemporal_load((const f32x4*)(xr + 4 * lane + 256 * j)); s += (v[j][0] * v[j][0] + v[j][1] * v[j][1]) + (v[j][2] * v[j][2] + v[j][3] * v[j][3]); }
                s = wave_sum(s);
#pragma unroll
                for (int j = 0; j < 8; ++j) { v2u w; w.x = pk2(v[j][0], v[j][1]); w.y = pk2(v[j][2], v[j][3]); *(v2u*)(A1 + (size_t)m * D + 4 * lane + 256 * j) = w;
                    if (m >= MP) *(f32x4*)(H + (size_t)m * D + 4 * lane + 256 * j) = v[j]; }
                if (lane < 32) ss[(size_t)m * 32 + lane] = lane == 0 ? s : 0.f;
            }
            const int gt = bid * NTHR + tid, NGT = G * NTHR;
            for (int idx = gt; idx < M * 8; idx += NGT) {
                const int m = idx >> 3, i = idx & 7;
                const int pos = m < MP ? m : 2048 + ((m - MP) & 31);
                const float inv = i == 0 ? 1.f : i == 1 ? 1.939227432e-01f : i == 2 ? 3.760603070e-02f : i == 3 ? 7.292664610e-03f : i == 4 ? 1.414213562e-03f : i == 5 ? 2.742481884e-04f : i == 6 ? 5.318295734e-05f : 1.031338525e-05f;
                const float ang = (float)pos * inv;
                const float th = ang * 1.591549367e-01f, te = __builtin_fmaf(ang, 1.591549367e-01f, -th) + ang * 6.420638243e-09f;
                const float fr_ = (th - __builtin_rintf(th)) + te;
                cs[2 * idx] = __builtin_amdgcn_cosf(fr_); cs[2 * idx + 1] = __builtin_amdgcn_sinf(fr_);
            }
            const float* ck = INP(2); const float* cv = INP(3);
            for (int idx = gt; idx < 16 * 128 * 256; idx += NGT) {
                const int b = idx >> 15, rem = idx & 32767, j = rem >> 8, c = rem & 255;
                const float kv = ck[idx], vv = cv[idx];
                Ksb[(size_t)b * 40960 + rem] = (bf16)f2bf(kv);
                Vts[((size_t)b * 256 + c) * 160 + j] = (bf16)f2bf(vv);
                if (j >= 32) { out[O_KS + ((size_t)b * 128 + j - 32) * 256 + c] = kv; out[O_VS + ((size_t)b * 128 + j - 32) * 256 + c] = vv; }
            }
        } else if (ph == 1 && PHEN(1)) {
            pg8::Gemm g{A1, (const bf16*)(ws + WS_W1), M, NIN_E, D}; pg8::StaticOrder S; S.init(M, NIN_E, G, bid);
            pg8::EpiInEven E{ss, cs, Qb, Kpb, Ksb, Vtp, Vts, Ub, GVr, out};
            pg8::gemm_phase<pg8::EpiInEven, pg8::StaticOrder, true, true>(lds3, g, S, E, tid);
        } else if (ph == 2 && PHEN(2)) {
            for (int u = bid; u < 1216; u += G) {
                if (u < 576) {
                    bf16* Ks = (bf16*)lds; bf16* Vs = (bf16*)(lds + 27648);
                    const bf16* Kg; const bf16* Vg; int vstr, nkb;
                    if (u < 512) { const int c = u >> 2, kvh = u & 3, kc0 = c > 2 ? c - 2 : 0; nkb = (c - kc0 + 1) * 2;
                        Kg = Kpb + (size_t)(kc0 * 64) * 256 + kvh * 64; Vg = Vtp + (size_t)(kvh * 64) * 8192 + kc0 * 64; vstr = 8192; }
                    else { const int su = u - 512, b = su >> 2, kvh = su & 3; nkb = 5;
                        Kg = Ksb + (size_t)b * 40960 + kvh * 64; Vg = Vts + ((size_t)b * 256 + kvh * 64) * 160; vstr = 160; }
                    const int nkeys = nkb * 32, cpr = nkeys >> 3;
                    for (int p = tid; p < nkeys * 8; p += NTHR) { const int row = p >> 3, ch = p & 7; *(v4u*)(Ks + row * 72 + ch * 8) = *(const v4u*)(Kg + (size_t)row * 256 + ch * 8); }
                    for (int p = tid; p < 64 * cpr; p += NTHR) { const int dd = p / cpr, ch = p - dd * cpr; *(v4u*)(Vs + dd * 200 + ch * 8) = *(const v4u*)(Vg + (size_t)dd * vstr + ch * 8); }
                    __syncthreads();
                    if (u < 512) { const int c = u >> 2, kvh = u & 3, hq = kvh * 4 + (wave >> 1), tok0 = c * 64 + (wave & 1) * 32;
                        attn_wave(Qb + (size_t)tok0 * 1024 + hq * 64, Ks, 72, Vs, 200, nkb, INP(10)[hq], A2 + (size_t)tok0 * 2048 + hq * 64, lane);
                    } else if (wave < 4) { const int su = u - 512, b = su >> 2, kvh = su & 3, hq = kvh * 4 + wave;
                        attn_wave(Qb + (size_t)(MP + b * 32) * 1024 + hq * 64, Ks, 72, Vs, 200, nkb, INP(10)[hq], A2 + (size_t)(MP + b * 32) * 2048 + hq * 64, lane); }
                    __syncthreads();
                } else if (u < 1088) {
                    const int gu = u - 576;
                    gmlp_unit(lds, GVr, Ub, INP(11), INP(12), INP(13), A2, nullptr, (gu >> 3) * 128, 128, gu & 7, tid);
                } else {
                    const int gu = u - 1088, b = gu >> 3;
                    gmlp_unit(lds, GVr, Ub, INP(11), INP(12), INP(13), A2, out + O_GV + (size_t)b * 32 * 1024, MP + b * 32, 32, gu & 7, tid);
                }
            }
        } else if (ph == 3 && PHEN(3)) {
            pg8::Gemm g{A2, (const bf16*)(ws + WS_W2), M, D, D}; pg8::SplitOrder S; S.init(bid, D);
            pg8::EpiRes<true> E{xp, xs, H, A1, ss + SSN, (float*)(ws + WS_BIG)};
            pg8::gemm_phase<pg8::EpiRes<true>, pg8::SplitOrder, true, true>(lds3, g, S, E, tid);
        } else if ((ph == 4 || ph == 10) && PHEN(ph)) {
#ifdef DBG_HIDFILL
            { const int gt = bid * NTHR + tid, NGT = G * NTHR;
              for (size_t i = gt; i < (size_t)M * DFF / 2; i += NGT) { const unsigned a_ = (unsigned)((i * 37u) & 255u); ((unsigned*)HID)[i] = pk2((float)a_ * (1.f / 256.f), (float)(255u - a_) * (1.f / 512.f)); } }
            if (false)
#endif
            {
            pg8::Gemm g{A1, (const bf16*)(ws + (ph == 4 ? WS_WU0 : WS_WU1)), M, DFF, D}; pg8::StaticOrder S; S.init(M, DFF, G, bid);
            pg8::EpiUp E{ss + (ph == 4 ? SSN : 3 * SSN), HID};
            pg8::gemm_phase<pg8::EpiUp, pg8::StaticOrder, true, true>(lds3, g, S, E, tid);
            }
            if (bid >= 64) {
                if (ph == 4) CONV_RANGE(2046, 5120, bid - 64, 192); else CONV_RANGE(9498, 12572, bid - 64, 192);
            }
        } else if ((ph == 5 || ph == 9 || ph == 11) && PHEN(ph)) {
            const bf16* Aop = ph == 9 ? A2 : HID; const bf16* Bop = (const bf16*)(ws + (ph == 5 ? WS_WD0 : ph == 9 ? WS_W6 : WS_WD1));
            pg8::Gemm g{Aop, Bop, M, D, ph == 9 ? D : DFF}; pg8::SplitOrder S; S.init(bid, ph == 9 ? D : DFF);
#ifndef DBG_P5X
#define DBG_P5X false
#endif
            pg8::EpiRes<DBG_P5X> E{xp, xs, H, A1, ss + (ph == 5 ? 2 * SSN : ph == 9 ? 3 * SSN : 4 * SSN), (float*)(ws + (ph == 9 ? WS_BIG : WS_A2))};
            pg8::gemm_phase<pg8::EpiRes<DBG_P5X>, pg8::SplitOrder, true, true>(lds3, g, S, E, tid);
            if (bid >= 128) { if (ph == 5) CONV_RANGE(5120, 6156, bid - 128, 128); else if (ph == 9) CONV_RANGE(9230, 9498, bid - 128, 128); }
        } else if (ph == 6 && PHEN(6)) {
            pg8::Gemm g{A1, (const bf16*)(ws + WS_W5), M, DFF, D}; pg8::StaticOrder S; S.init(M, DFF, G, bid);
            pg8::EpiInOdd E{ss + 2 * SSN, INP(16), QH, FH, VH, GH};
            pg8::gemm_phase<pg8::EpiInOdd, pg8::StaticOrder, true, true>(lds3, g, S, E, tid);
            if (bid >= 64) CONV_RANGE(6156, 9230, bid - 64, 192);
        } else if (ph == 7 && PHEN(7)) {
            for (int u = bid; u < 240; u += G) { const int hd = u / 15, g = u % 15;
                hg_unit<false>(lds, QH, FH, VH, GH, INP(17), A2, hd, g * 512, 16, 0, nullptr, SEG, DEC, 0, SEG + (size_t)(hd * 16 + g) * 16384, DEC + (size_t)(hd * 16 + g) * 128, tid, DEC + 32768 + hd * 16 + g); }
        } else if (ph == 14 && PHEN(14)) {
            const int gt = bid * NTHR + tid, NGT = G * NTHR;
            for (int el = gt; el < 16 * 16384; el += NGT) {
                const int hd = el >> 14, de = el & 16383, dd = de >> 7;
                float L[15], Dg[15];
#pragma unroll
                for (int g = 0; g < 15; ++g) { L[g] = SEG[(size_t)(hd * 16 + g) * 16384 + de]; Dg[g] = DEC[(size_t)(hd * 16 + g) * 128 + dd]; }
                float acc = 0.f;
#pragma unroll
                for (int g = 0; g < 15; ++g) { acc = Dg[g] * acc + L[g]; SEG[(size_t)(hd * 16 + g) * 16384 + de] = acc; }
            }
        } else if (ph == 8 && PHEN(8)) {
            for (int u = bid; u < 512; u += G) {
                if (u < 256) { const int hd = u >> 4, g = u & 15;
                    hg_unit<true>(lds, QH, FH, VH, GH, INP(17), A2, hd, g * 512, 16, g ? 1 : 0, SEG + (size_t)(hd * 16 + (g ? g - 1 : 0)) * 16384, SEG, DEC, g, g == 15 ? out + O_SP + (size_t)hd * 16384 : nullptr, nullptr, tid);
                } else { const int su = u - 256, b = su >> 4, hd = su & 15;
                    hg_unit<true>(lds, QH, FH, VH, GH, INP(17), A2, hd, MP + b * 32, 1, 1, INP(4) + (size_t)(b * 16 + hd) * 16384, SEG, DEC, 0, out + O_SS + (size_t)(b * 16 + hd) * 16384, nullptr, tid); }
            }
        } else if (ph == 13 && PHEN(13)) {
            const int ssi = ++nfin;
            const float* part = (const float*)(ws + ((ssi & 1) == 0 ? WS_A2 : WS_BIG));
            const int gw = bid * NWAVES + wave, NGW = G * NWAVES;
            for (int it = gw; it < 512 * 4; it += NGW) {
                const int rs = it >> 2, qd = it & 3, m = MP + rs; const size_t co = (size_t)qd * 512 + 4 * lane;
                f32x4 h0 = *(const f32x4*)(H + (size_t)m * D + co), h1 = *(const f32x4*)(H + (size_t)m * D + co + 256);
#pragma unroll
                for (int sl = 0; sl < 8; ++sl) { const float* pp = part + ((size_t)sl * 512 + rs) * D + co; h0 += __builtin_nontemporal_load((const f32x4*)pp); h1 += __builtin_nontemporal_load((const f32x4*)(pp + 256)); }
                *(f32x4*)(H + (size_t)m * D + co) = h0; *(f32x4*)(H + (size_t)m * D + co + 256) = h1;
                v2u w; w.x = pk2(h0[0], h0[1]); w.y = pk2(h0[2], h0[3]); *(v2u*)(A1 + (size_t)m * D + co) = w;
                w.x = pk2(h1[0], h1[1]); w.y = pk2(h1[2], h1[3]); *(v2u*)(A1 + (size_t)m * D + co + 256) = w;
                float sq = ((h0[0] * h0[0] + h0[1] * h0[1]) + (h0[2] * h0[2] + h0[3] * h0[3])) + ((h1[0] * h1[0] + h1[1] * h1[1]) + (h1[2] * h1[2] + h1[3] * h1[3]));
                sq = wave_sum(sq);
                if (lane < 8) ss[(size_t)ssi * SSN + (size_t)m * 32 + qd * 8 + lane] = lane == 0 ? sq : 0.f;
            }
        } else if (ph == 12 && PHEN(12)) {
            const int gw = bid * NWAVES + wave, NGW = G * NWAVES;
            for (int m = gw; m < M; m += NGW) {
                f32x4 hv[8]; float sq = 0.f;
#ifdef DBG_DUMPQH
#pragma unroll
                for (int j = 0; j < 8; ++j) *(f32x4*)(out + (size_t)m * D + 4 * lane + 256 * j) = *(const f32x4*)(DBG_DUMPQH + (size_t)m * D + 4 * lane + 256 * j);
                continue;
#endif
#ifdef DBG_DUMPA2
                if (DBG_DUMPA2 == 2 && (m >= MP || (m & 511) < 64)) continue;
                if (DBG_DUMPA2 == 3 && m < MP) continue;
#pragma unroll
                for (int j = 0; j < 8; ++j) { const v2u w = *(const v2u*)(DBG_A2PTR + (size_t)m * D + 4 * lane + 256 * j);
                    *(f32x4*)(out + (size_t)m * D + 4 * lane + 256 * j) = (f32x4){bf2f((unsigned short)(w.x & 0xffff)), bf2f((unsigned short)(w.x >> 16)), bf2f((unsigned short)(w.y & 0xffff)), bf2f((unsigned short)(w.y >> 16))}; }
                continue;
#endif
#pragma unroll
                for (int j = 0; j < 8; ++j) { hv[j] = __builtin_nontemporal_load((const f32x4*)(H + (size_t)m * D + 4 * lane + 256 * j));
                    if (m >= MP) {
#pragma unroll
                        for (int sl = 0; sl < 8; ++sl) hv[j] += __builtin_nontemporal_load((const f32x4*)((const float*)(ws + WS_A2) + ((size_t)sl * 512 + (m - MP)) * D + 4 * lane + 256 * j)); } sq += (hv[j][0] * hv[j][0] + hv[j][1] * hv[j][1]) + (hv[j][2] * hv[j][2] + hv[j][3] * hv[j][3]); }
                const float rstd = rsqrtf(wave_sum(sq) * (1.f / 2048.f) + 1e-6f);
#pragma unroll
                for (int j = 0; j < 8; ++j) { const f32x4 gn = *(const f32x4*)(INP(7) + 4 * lane + 256 * j);
                    __builtin_nontemporal_store(hv[j] * rstd * gn, (f32x4*)(out + (size_t)m * D + 4 * lane + 256 * j)); }
            }
        }
        if (st + 1 < a.ph_hi) { if (a.ph_lo < 0) grid.sync(); else xcd_barrier(xbar); }
    }
#ifdef EXTRA_SYNC
    for (int i = 0; i < EXTRA_SYNC; ++i) xcd_barrier(xbar);
#endif
}

#undef xp
#undef xs
#undef ss
#undef cs
#undef A1
#undef A2
#undef H
#undef HID
#undef Qb
#undef Kpb
#undef Ksb
#undef Vtp
#undef Vts
#undef Ub
#undef GVr
#undef QH
#undef FH
#undef VH
#undef GH
#undef SEG
#undef DEC
#undef CONV_L1
#undef CONV_RANGE
extern "C" void kernel_launch(void* const* d_in, const int* in_sizes, int n_in, void* d_out, int out_size, void* d_ws, size_t ws_size, hipStream_t stream) {
    static int grid = 0;
    if (grid == 0) {
        if (n_in != 20 || ws_size < WS_END) { fprintf(stderr, "kernel_launch: unexpected n_in %d / ws %zu\n", n_in, ws_size); grid = -1; return; }
        int dev = 0, cus = 0, per_cu = 0;
        (void)hipGetDevice(&dev); (void)hipDeviceGetAttribute(&cus, hipDeviceAttributeMultiprocessorCount, dev);
        if (hipFuncSetAttribute((const void*)mk_fwd, hipFuncAttributeMaxDynamicSharedMemorySize, LDS_BYTES) != hipSuccess) { fprintf(stderr, "kernel_launch: hipFuncSetAttribute failed\n"); grid = -1; return; }
        if (hipOccupancyMaxActiveBlocksPerMultiprocessor(&per_cu, (const void*)mk_fwd, NTHR, LDS_BYTES) != hipSuccess || per_cu < 1) { fprintf(stderr, "kernel_launch: occupancy query says %d\n", per_cu); per_cu = 1; }
        (void)hipGetLastError();
        grid = cus * 1;
        if (grid <= 0) grid = 256;
    }
    if (grid < 0) return;
    (void)hipMemsetAsync(d_ws, 0, 65536, stream);
    Args a{};
    for (int i = 0; i < 20; ++i) a.in[i] = (const float*)d_in[i];
    a.out = (float*)d_out; a.ws = (unsigned char*)d_ws;
#ifdef DBG_FILL
    (void)hipMemsetAsync(d_out, 0, (size_t)23920640 * 4, stream);
#endif
#if MK_PER_PHASE
    for (int ph = 0; ph < NPH; ++ph) { a.ph_lo = ph; a.ph_hi = ph + 1; hipLaunchKernelGGL(mk_fwd, dim3(grid), dim3(NTHR), LDS_BYTES, stream, a); }
#else
    a.ph_lo = 0; a.ph_hi = SEQ_N;
    void* args[] = {&a};
    hipError_t e = hipLaunchCooperativeKernel((const void*)mk_fwd, dim3(grid), dim3(NTHR), args, LDS_BYTES, stream);
    if (e != hipSuccess) fprintf(stderr, "cooperative launch failed: %s (grid %d)\n", hipGetErrorString(e), grid);
#endif
}
```

```cpp
#include <hip/hip_runtime.h>
#include <hip/hip_cooperative_groups.h>
#include <cstdio>
#include <cstdint>
namespace cg = cooperative_groups;
namespace pg8 {
#define PG8_LAS __attribute__((address_space(3)))
typedef unsigned short bf16_t;
typedef short bf16x8 __attribute__((ext_vector_type(8)));
typedef float f32x4 __attribute__((ext_vector_type(4)));
typedef unsigned u32x4 __attribute__((ext_vector_type(4)));
constexpr int BM = 256, BK = 64, HALF = 128, HTB = HALF * BK * 2  , STAGE_BYTES = 8 * HTB, NXCD = 8, WGM = 8;

__host__ __device__ __forceinline__ int lds_byte(int r, int c) { const int st = (r >> 4) * 2 + (c >> 5), rr = r & 15, cc = c & 31, ob = rr * 64 + cc * 2; return st * 1024 + (ob ^ (((ob >> 9) & 1) << 5)); }
__host__ __device__ __forceinline__ void stage_rc(int b, int& R, int& C) { const int st = b / 1024, sb = b % 1024, swz = sb ^ (((sb >> 9) & 1) << 5); R = (st >> 1) * 16 + swz / 64; C = (st & 1) * 32 + (swz % 64) / 2; }
__host__ __device__ __forceinline__ int perm32(int rho) { const int n = rho >> 4, i = rho & 15; return 8 * (i >> 2) + 4 * n + (i & 3); }

struct Unit { int pm, pn, k0, nt, part; };
struct Gemm { const bf16_t* A; const bf16_t* Bt; int M, N, K; };

struct StaticOrder {
    int nM, nN, nwg, G, c, ntk;
    __host__ __device__ void init(int M, int N, int G_, int c_, int K_ = 2048) { nM = M / BM; nN = N / BM; nwg = nM * nN; G = G_; c = c_; ntk = K_ / BK; }
    __host__ __device__ bool next(int i, Unit& u) const {
        const long L = (long)i * G + c; if (L >= nwg) return false;
        int wgid = (int)L; { const int q = nwg / NXCD, r = nwg % NXCD, xcd = wgid % NXCD, off = wgid / NXCD; wgid = (xcd < r ? xcd * (q + 1) : r * (q + 1) + (xcd - r) * q) + off; }
        const int nig = WGM * nN, gid = wgid / nig, fm = gid * WGM, gsz = (nM - fm) < WGM ? (nM - fm) : WGM;
        u.pm = fm + ((wgid % nig) % gsz); u.pn = (wgid % nig) / gsz; u.k0 = 0; u.nt = ntk; u.part = 0; return true;
    }
    __device__ __forceinline__ void a_ready(const Unit&) const {}
    __device__ __forceinline__ void done(const Unit&) const {}
};
struct SplitOrder {
    int c, ntk, nsl;
    __host__ __device__ void init(int c_, int K_) { c = c_; ntk = K_ / BK; nsl = 8; }
    __host__ __device__ bool next(int i, Unit& u) const {
        if (i == 0) { const int wgid = (c % 8) * 32 + c / 8, w = wgid % 64; u.pm = (wgid / 64) * 8 + (w % 8); u.pn = w / 8; u.k0 = 0; u.nt = ntk; u.part = 0; return true; }
        if (i == 1 && c < 16 * nsl) { const int ts = c / nsl, sl = c % nsl; u.pm = 32 + (ts >> 3); u.pn = ts & 7; u.nt = ntk / nsl; u.k0 = sl * u.nt; u.part = 1 + sl; return true; }
        return false;
    }
    __device__ __forceinline__ void a_ready(const Unit&) const {}
    __device__ __forceinline__ void done(const Unit&) const {}
};

typedef float f32x2c_t __attribute__((ext_vector_type(2))); typedef __bf16 bf16x2c_t __attribute__((ext_vector_type(2)));
__device__ __forceinline__ unsigned cvt_pk_bf16(float lo, float hi) { const f32x2c_t v = {lo, hi}; const bf16x2c_t b = __builtin_convertvector(v, bf16x2c_t); return __builtin_bit_cast(unsigned, b); }
typedef float f32x2 __attribute__((ext_vector_type(2)));
typedef unsigned u32x2 __attribute__((ext_vector_type(2)));
constexpr int O_YP = 0, O_YS = 16777216, O_KP = 17825792, O_VP = 17858560, O_KS = 17891328, O_VS = 18415616, O_GV = 18939904, O_SP = 19464192, O_SS = 19726336;
constexpr int MROWS = 8704, MPR = 8192, DM = 2048;
__device__ __forceinline__ unsigned short f2bf1(float f) { unsigned u = __builtin_bit_cast(unsigned, f); return (unsigned short)((u + 0x7fffu + ((u >> 16) & 1u)) >> 16); }
__device__ __forceinline__ float gelu_tanh(float x) {
    const float uu = 0.7978845608028654f * (x + 0.044715f * x * x * x);
    const float e = __expf(2.f * uu);
    const float t = 1.f - 2.f * __builtin_amdgcn_rcpf(e + 1.f);
    return 0.5f * x * (1.f + t);
}
__device__ __forceinline__ float sigm(float x) { return __builtin_amdgcn_rcpf(1.f + __expf(-x)); }

__device__ __forceinline__ float xsum16(float s) { const auto r = __builtin_amdgcn_permlane16_swap(__builtin_bit_cast(unsigned, s), __builtin_bit_cast(unsigned, s), false, false); return __builtin_bit_cast(float, r[0]) + __builtin_bit_cast(float, r[1]); }
__device__ __forceinline__ float xsum32(float s) { const auto r = __builtin_amdgcn_permlane32_swap(__builtin_bit_cast(unsigned, s), __builtin_bit_cast(unsigned, s), false, false); return __builtin_bit_cast(float, r[0]) + __builtin_bit_cast(float, r[1]); }
__device__ __forceinline__ float xpart32(float v, bool upper) { const auto r = __builtin_amdgcn_permlane32_swap(__builtin_bit_cast(unsigned, v), __builtin_bit_cast(unsigned, v), false, false); return __builtin_bit_cast(float, upper ? r[0] : r[1]); }
__device__ __forceinline__ float row_rstd(const float* ssp, int row, int fq) {
    const float* p = ssp + (size_t)row * 32 + fq * 8;
    const f32x4 a = *(const f32x4*)p, b = *(const f32x4*)(p + 4);
    float t = ((a[0] + a[1]) + (a[2] + a[3])) + ((b[0] + b[1]) + (b[2] + b[3]));
    t += __shfl_xor(t, 16); t += __shfl_xor(t, 32);
    return rsqrtf(t * (1.f / 2048.f) + 1e-6f);
}
struct EpiInEven {
    static constexpr bool PERM = false, AFTER_DRAIN = false;
    const float* ss; const float* cs; bf16_t *Q, *Kp, *Ks, *Vtp, *Vts, *U; float* GVr; float* out;
    template <int KIND> __device__ __forceinline__ void body(const f32x4 (&acc)[2][2][4][2], const Unit& u, int wr, int wc, int fr, int fq) const {
        const int pn = u.pn;
        const float* ssk = ss; int frk = fr; asm volatile("" : "+v"(frk), "+v"(fq)); asm volatile("" : "+s"(wc), "+s"(wr));
        float rs8[8];
#pragma unroll
        for (int q = 0; q < 8; ++q) rs8[q] = row_rstd(ssk, u.pm * BM + (q >> 2) * HALF + wr * 64 + (q & 3) * 16 + frk, fq);
#pragma unroll
        for (int ai = 0; ai < 2; ++ai)
#pragma unroll
            for (int m = 0; m < 4; ++m) {
                const int row = u.pm * BM + ai * HALF + wr * 64 + m * 16 + frk;
                const float rstd = rs8[ai * 4 + m];
                const bool smp = row >= MPR; const int sb = (row - MPR) >> 5, st = (row - MPR) & 31;
#pragma unroll
                for (int bj = 0; bj < 2; ++bj)
#pragma unroll
                    for (int n = 0; n < 2; ++n) {
                        f32x4 v = acc[ai][bj][m][n] * rstd;
                        const int cl = bj * HALF + wc * 32 + n * 16 + fq * 4;
                        if (KIND <= 1) {
                            if (n == 0 && (wc & 1) == 0) {
                                f32x4 p; p[0] = __shfl_xor(v[0], 32); p[1] = __shfl_xor(v[1], 32); p[2] = __shfl_xor(v[2], 32); p[3] = __shfl_xor(v[3], 32);
                                const f32x4 c0 = *(const f32x4*)(cs + (size_t)row * 16 + (fq & 1) * 8), c1 = *(const f32x4*)(cs + (size_t)row * 16 + (fq & 1) * 8 + 4);
                                const float sg = (fq < 2) ? -1.f : 1.f;
                                v[0] = v[0] * c0[0] + sg * p[0] * c0[1]; v[1] = v[1] * c0[2] + sg * p[1] * c0[3];
                                v[2] = v[2] * c1[0] + sg * p[2] * c1[1]; v[3] = v[3] * c1[2] + sg * p[3] * c1[3];
                            }
                            if (KIND == 0) {
                                v = v * 0.125f; u32x2 w; w.x = cvt_pk_bf16(v[0], v[1]); w.y = cvt_pk_bf16(v[2], v[3]);
                                *(u32x2*)(Q + (size_t)row * 1024 + pn * 256 + cl) = w;
                            } else {
                                u32x2 w; w.x = cvt_pk_bf16(v[0], v[1]); w.y = cvt_pk_bf16(v[2], v[3]);
                                if (smp) { *(u32x2*)(Ks + ((size_t)(sb * 160 + 128 + st)) * 256 + cl) = w; *(f32x4*)(out + O_KS + ((size_t)(sb * 128 + 96 + st)) * 256 + cl) = v; }
                                else { *(u32x2*)(Kp + (size_t)row * 256 + cl) = w; if (row >= MPR - 128) *(f32x4*)(out + O_KP + (size_t)(row - (MPR - 128)) * 256 + cl) = v; }
                            }
                        } else if (KIND == 2) {
                            if (smp) { *(f32x4*)(out + O_VS + ((size_t)(sb * 128 + 96 + st)) * 256 + cl) = v;
#pragma unroll
                                for (int j = 0; j < 4; ++j) Vts[((size_t)(sb * 256 + cl + j)) * 160 + 128 + st] = f2bf1(v[j]); }
                            else { if (row >= MPR - 128) *(f32x4*)(out + O_VP + (size_t)(row - (MPR - 128)) * 256 + cl) = v;
#pragma unroll
                                for (int j = 0; j < 4; ++j) Vtp[(size_t)(cl + j) * MPR + row] = f2bf1(v[j]); }
                        } else if (KIND == 3) {
                            u32x2 w; w.x = cvt_pk_bf16(gelu_tanh(v[0]), gelu_tanh(v[1])); w.y = cvt_pk_bf16(gelu_tanh(v[2]), gelu_tanh(v[3]));
                            *(u32x2*)(U + (size_t)row * 1024 + (pn - 6) * 256 + cl) = w;
                        } else {
                            f32x4 g; g[0] = gelu_tanh(v[0]); g[1] = gelu_tanh(v[1]); g[2] = gelu_tanh(v[2]); g[3] = gelu_tanh(v[3]);
                            *(f32x4*)(GVr + (size_t)row * 1024 + (pn - 10) * 256 + cl) = g;
                        }
                        asm volatile("" ::: "memory");
                    }
            }
    }
    __device__ __forceinline__ void operator()(const f32x4 (&acc)[2][2][4][2], const Unit& u, int wr, int wc, int fr, int fq) const {
        const int pn = u.pn;
        if (pn < 4) body<0>(acc, u, wr, wc, fr, fq);
        else if (pn == 4) body<1>(acc, u, wr, wc, fr, fq);
        else if (pn == 5) body<2>(acc, u, wr, wc, fr, fq);
        else if (pn < 10) body<3>(acc, u, wr, wc, fr, fq);
        else body<4>(acc, u, wr, wc, fr, fq);
    }
};
template <bool FROMX> struct EpiRes {
    static constexpr bool PERM = false, AFTER_DRAIN = false;
    const float* xp; const float* xs; float* H; bf16_t* Hb; float* ssout; float* part;
    __device__ __forceinline__ void operator()(const f32x4 (&acc)[2][2][4][2], const Unit& u, int wr, int wc, int fr, int fq) const {
        asm volatile("" : "+v"(fr), "+v"(fq), "+s"(wc), "+s"(wr));
        if (u.part) {
#pragma unroll
            for (int ai = 0; ai < 2; ++ai)
#pragma unroll
                for (int m = 0; m < 4; ++m) {
                    float* hp = part + ((size_t)(u.part - 1) * 512 + (size_t)((u.pm - 32) * BM + ai * HALF + wr * 64 + m * 16 + fr)) * DM + u.pn * BM + wc * 32 + fq * 4;
#pragma unroll
                    for (int bj = 0; bj < 2; ++bj)
#pragma unroll
                        for (int n = 0; n < 2; ++n) *(f32x4*)(hp + bj * HALF + n * 16) = acc[ai][bj][m][n];
                    asm volatile("" ::: "memory");
                }
            return;
        }
        const int colb = u.pn * BM + wc * 32 + fq * 4;
        f32x4 bcur[4], bnxt[4];
        { const int row = u.pm * BM + wr * 64 + fr; const float* base = FROMX ? (row < MPR ? xp + (size_t)row * DM : xs + (size_t)(row - MPR) * DM) : H + (size_t)row * DM;
#pragma unroll
          for (int p = 0; p < 4; ++p) bcur[p] = *(const f32x4*)(base + colb + (p >> 1) * HALF + (p & 1) * 16); }
#pragma unroll
        for (int q = 0; q < 8; ++q) {
            const int ai = q >> 2, m = q & 3;
            const int row = u.pm * BM + ai * HALF + wr * 64 + m * 16 + fr;
            if (q < 7) { const int rown = u.pm * BM + ((q + 1) >> 2) * HALF + wr * 64 + ((q + 1) & 3) * 16 + fr;
                const float* basen = FROMX ? (rown < MPR ? xp + (size_t)rown * DM : xs + (size_t)(rown - MPR) * DM) : H + (size_t)rown * DM;
#pragma unroll
                for (int p = 0; p < 4; ++p) bnxt[p] = *(const f32x4*)(basen + colb + (p >> 1) * HALF + (p & 1) * 16); }
            float s = 0.f;
#pragma unroll
            for (int p = 0; p < 4; ++p) {
                const int bj = p >> 1, n = p & 1, col = colb + bj * HALF + n * 16;
                const f32x4 h = bcur[p] + acc[ai][bj][m][n];
                *(f32x4*)(H + (size_t)row * DM + col) = h;
                u32x2 w; w.x = cvt_pk_bf16(h[0], h[1]); w.y = cvt_pk_bf16(h[2], h[3]);
                *(u32x2*)(Hb + (size_t)row * DM + col) = w;
                s += (h[0] * h[0] + h[1] * h[1]) + (h[2] * h[2] + h[3] * h[3]);
            }
            s += __shfl_xor(s, 16); s += __shfl_xor(s, 32);
            if (fq == 0) ssout[(size_t)row * 32 + u.pn * 4 + wc] = s;
#pragma unroll
            for (int p = 0; p < 4; ++p) bcur[p] = bnxt[p];
        }
    }
};
struct EpiUp {
    static constexpr bool PERM = true, AFTER_DRAIN = false;
    const float* ss; bf16_t* HID;
    __device__ __forceinline__ void operator()(const f32x4 (&acc)[2][2][4][2], const Unit& u, int wr, int wc, int fr, int fq) const {
        asm volatile("" : "+v"(fr), "+v"(fq), "+s"(wc), "+s"(wr));
        float rs8[8];
#pragma unroll
        for (int q = 0; q < 8; ++q) rs8[q] = row_rstd(ss, u.pm * BM + (q >> 2) * HALF + wr * 64 + (q & 3) * 16 + fr, fq);
#pragma unroll
        for (int ai = 0; ai < 2; ++ai)
#pragma unroll
            for (int m = 0; m < 4; ++m) {
                const int row = u.pm * BM + ai * HALF + wr * 64 + m * 16 + fr;
                const float rstd = rs8[ai * 4 + m];
                bf16_t* rowp = HID + (size_t)row * 8192 + u.pn * BM + wc * 32 + 8 * fq;
#pragma unroll
                for (int bj = 0; bj < 2; ++bj) {
                    f32x4 v0 = acc[ai][bj][m][0] * rstd, v1 = acc[ai][bj][m][1] * rstd;
#pragma unroll
                    for (int j = 0; j < 4; ++j) { const float a = fmaxf(v0[j], 0.f), b = fmaxf(v1[j], 0.f); v0[j] = a * a; v1[j] = b * b; }
                    u32x4 w; w.x = cvt_pk_bf16(v0[0], v0[1]); w.y = cvt_pk_bf16(v0[2], v0[3]); w.z = cvt_pk_bf16(v1[0], v1[1]); w.w = cvt_pk_bf16(v1[2], v1[3]);
                    *(u32x4*)(rowp + bj * HALF) = w;
                }
            }
    }
};
struct EpiInOdd {
    static constexpr bool PERM = true, AFTER_DRAIN = false;
    const float* ss; const float* lbw; float* QH; float* FH; bf16_t* VH; bf16_t* GH;
    __device__ __forceinline__ void operator()(const f32x4 (&acc)[2][2][4][2], const Unit& u, int wr, int wc, int fr, int fq) const {
        const int sec = u.pn >> 3, pnl = u.pn & 7;
        asm volatile("" : "+v"(fr), "+v"(fq), "+s"(wc), "+s"(wr));
        float rs8[8];
#pragma unroll
        for (int q = 0; q < 8; ++q) rs8[q] = row_rstd(ss, u.pm * BM + (q >> 2) * HALF + wr * 64 + (q & 3) * 16 + fr, fq);
#pragma unroll
        for (int ai = 0; ai < 2; ++ai)
#pragma unroll
            for (int m = 0; m < 4; ++m) {
                const int row = u.pm * BM + ai * HALF + wr * 64 + m * 16 + fr;
                const float rstd = rs8[ai * 4 + m];
#pragma unroll
                for (int bj = 0; bj < 2; ++bj) {
                    f32x4 v0 = acc[ai][bj][m][0] * rstd, v1 = acc[ai][bj][m][1] * rstd;
                    const int col = pnl * BM + bj * HALF + wc * 32 + fq * 8;
                    if (sec == 0) {
#pragma unroll
                        for (int j = 0; j < 4; ++j) { v0[j] = v0[j] * sigm(v0[j]); v1[j] = v1[j] * sigm(v1[j]); }
                        *(f32x4*)(QH + (size_t)row * DM + col) = v0; *(f32x4*)(QH + (size_t)row * DM + col + 4) = v1;
                    } else if (sec == 1) {
                        const f32x4 l0a = *(const f32x4*)(lbw + col), l0b = *(const f32x4*)(lbw + col + 4), l1a = *(const f32x4*)(lbw + DM + col), l1b = *(const f32x4*)(lbw + DM + col + 4);
#pragma unroll
                        for (int j = 0; j < 4; ++j) { const float la = sigm(l1a[j] - l0a[j]), lb2 = sigm(l1b[j] - l0b[j]); v0[j] = la + (1.f - la) * sigm(v0[j]); v1[j] = lb2 + (1.f - lb2) * sigm(v1[j]); }
                        *(f32x4*)(FH + (size_t)row * DM + col) = v0; *(f32x4*)(FH + (size_t)row * DM + col + 4) = v1;
                    } else if (sec == 2) {
                        u32x4 w; w.x = cvt_pk_bf16(v0[0], v0[1]); w.y = cvt_pk_bf16(v0[2], v0[3]); w.z = cvt_pk_bf16(v1[0], v1[1]); w.w = cvt_pk_bf16(v1[2], v1[3]);
                        *(u32x4*)(VH + (size_t)row * DM + col) = w;
                    } else {
                        u32x4 w; w.x = cvt_pk_bf16(sigm(v0[0]), sigm(v0[1])); w.y = cvt_pk_bf16(sigm(v0[2]), sigm(v0[3])); w.z = cvt_pk_bf16(sigm(v1[0]), sigm(v1[1])); w.w = cvt_pk_bf16(sigm(v1[2]), sigm(v1[3]));
                        *(u32x4*)(GH + (size_t)row * DM + col) = w;
                    }
                }
            }
    }
};
template <class Epi, class Sched, bool ALIGN_EPI = false, bool SP2 = false>
__device__ __forceinline__ void gemm_phase(PG8_LAS unsigned char* lds, const Gemm g, const Sched& S, const Epi& E, const int tid) {
    const int wid = __builtin_amdgcn_readfirstlane(tid >> 6), lane = tid & 63, wr = wid >> 2, wc = wid & 3, fr = lane & 15, fq = lane >> 4;
    const int K = g.K;
    unsigned voffA[2], voffB[2];
#pragma unroll
    for (int i = 0; i < 2; ++i) { int R, C; stage_rc(tid * 16 + i * 8192, R, C); const int Rb = Epi::PERM ? ((R & ~31) + perm32(R & 31)) : R;
        voffA[i] = (unsigned)(R * K + C) * 2u; voffB[i] = (unsigned)(Rb * K + C) * 2u; }
    const size_t kstep = (size_t)(BK * 2);
    const size_t hstep = (size_t)HALF * K * 2;
    const size_t tstep = 2 * hstep;
    const unsigned ldsw = (unsigned)wid * 1024u;
    const int aoff = lds_byte(wr * 64 + fr, fq * 8), boff = lds_byte(wc * 32 + fr, fq * 8);
#define PG8_SA(b, h) (((b) * 2 + (h)) * HTB)
#define PG8_SB(b, h) ((4 + (b) * 2 + (h)) * HTB)
#define PG8_STAGE(bufoff, gbase, voff) do { _Pragma("unroll") for (int _i = 0; _i < 2; ++_i) \
        __builtin_amdgcn_global_load_lds((const unsigned*)((const char*)(gbase) + (voff)[_i]), (PG8_LAS unsigned*)(lds + (bufoff) + ldsw + _i * 8192), 16, 0, 0); } while (0)
#define PG8_LDA(dst, b, h) do { _Pragma("unroll") for (int m = 0; m < 4; ++m) _Pragma("unroll") for (int k = 0; k < 2; ++k) dst[m][k] = *(const PG8_LAS bf16x8*)(lds + PG8_SA(b, h) + aoff + m * 2048 + k * 1024); } while (0)
#define PG8_LDB(dst, b, h) do { _Pragma("unroll") for (int n = 0; n < 2; ++n) _Pragma("unroll") for (int k = 0; k < 2; ++k) dst[n][k] = *(const PG8_LAS bf16x8*)(lds + PG8_SB(b, h) + boff + n * 2048 + k * 1024); } while (0)
#define PG8_MMA(ai, bj, At, Bt) do { __builtin_amdgcn_s_setprio(1); _Pragma("unroll") for (int m = 0; m < 4; ++m) _Pragma("unroll") for (int n = 0; n < 2; ++n) _Pragma("unroll") for (int k = 0; k < 2; ++k) \
        acc[ai][bj][m][n] = __builtin_amdgcn_mfma_f32_16x16x32_bf16(Bt[n][k], At[m][k], acc[ai][bj][m][n], 0, 0, 0); __builtin_amdgcn_s_setprio(0); } while (0)
#define PG8_WAIT_V(n) asm volatile("s_waitcnt vmcnt(" #n ")" ::: "memory")
#define PG8_WAIT_L(n) asm volatile("s_waitcnt lgkmcnt(" #n ")" ::: "memory")
#define PG8_BAR __builtin_amdgcn_s_barrier()
#define PG8_SCHED __builtin_amdgcn_sched_barrier(0)
    Unit cur, nxt; int ui = 0;
    if (!S.next(0, cur)) return;
    f32x4 acc[2][2][4][2];
#pragma unroll
    for (int a = 0; a < 2; ++a)
#pragma unroll
        for (int b = 0; b < 2; ++b)
#pragma unroll
            for (int m = 0; m < 4; ++m)
#pragma unroll
                for (int n = 0; n < 2; ++n) acc[a][b][m][n] = (f32x4){0.f, 0.f, 0.f, 0.f};
    bf16x8 At[4][2], B0[2][2], B1[2][2];
    const char* cA = (const char*)g.A + (size_t)cur.pm * tstep + (size_t)cur.k0 * kstep; const char* cB = (const char*)g.Bt + (size_t)cur.pn * tstep + (size_t)cur.k0 * kstep;
    S.a_ready(cur);
    if constexpr (SP2) {
        PG8_STAGE(PG8_SB(0, 0), cB, voffB); PG8_STAGE(PG8_SB(0, 1), cB + hstep, voffB); PG8_STAGE(PG8_SA(0, 0), cA, voffA); PG8_STAGE(PG8_SA(0, 1), cA + hstep, voffA);
        if (wr == 1) PG8_BAR;
        PG8_WAIT_V(2); PG8_BAR;
        PG8_STAGE(PG8_SB(1, 0), cB + kstep, voffB); PG8_STAGE(PG8_SA(1, 0), cA + kstep, voffA); PG8_STAGE(PG8_SB(1, 1), cB + hstep + kstep, voffB);
        PG8_WAIT_V(6); PG8_BAR;
    } else {
        PG8_STAGE(PG8_SB(0, 0), cB, voffB); PG8_STAGE(PG8_SA(0, 0), cA, voffA); PG8_STAGE(PG8_SB(0, 1), cB + hstep, voffB); PG8_STAGE(PG8_SA(0, 1), cA + hstep, voffA);
        if (wr == 1) PG8_BAR;
        PG8_WAIT_V(4); PG8_BAR;
        PG8_STAGE(PG8_SB(1, 0), cB + kstep, voffB); PG8_STAGE(PG8_SA(1, 0), cA + kstep, voffA); PG8_STAGE(PG8_SB(1, 1), cB + hstep + kstep, voffB);
        PG8_WAIT_V(6); PG8_BAR;
    }
    for (;;) {
        const bool has_next = S.next(ui + 1, nxt);
        const char* nA = has_next ? (const char*)g.A + (size_t)nxt.pm * tstep + (size_t)nxt.k0 * kstep : cA; const char* nB = has_next ? (const char*)g.Bt + (size_t)nxt.pn * tstep + (size_t)nxt.k0 * kstep : cB;
        const int nt = cur.nt;
        for (int t = 0; t < nt; t += 2) {
            const bool last = (t == nt - 2);
            const char* a1 = cA + (size_t)(t + 1) * kstep;
            const char* a2 = last ? nA : cA + (size_t)(t + 2) * kstep; const char* b2 = last ? nB : cB + (size_t)(t + 2) * kstep;
            const char* a3 = a2 + kstep; const char* b3 = b2 + kstep;
            if (last && has_next) S.a_ready(nxt);
            if constexpr (SP2) {
            PG8_LDB(B0, 0, 0); PG8_LDB(B1, 0, 1); PG8_SCHED; PG8_LDA(At, 0, 0); PG8_STAGE(PG8_SA(1, 1), a1 + hstep, voffA);
            PG8_WAIT_V(8); PG8_WAIT_L(0); PG8_BAR; PG8_MMA(0, 0, At, B0); PG8_MMA(0, 1, At, B1); PG8_BAR; PG8_SCHED;
            PG8_LDA(At, 0, 1); PG8_STAGE(PG8_SB(0, 0), b2, voffB); PG8_STAGE(PG8_SB(0, 1), b2 + hstep, voffB); PG8_STAGE(PG8_SA(0, 0), a2, voffA);
            PG8_WAIT_V(8); PG8_WAIT_L(0); PG8_BAR; PG8_MMA(1, 0, At, B0); PG8_MMA(1, 1, At, B1); PG8_BAR; PG8_SCHED;
            PG8_LDB(B0, 1, 0); PG8_LDB(B1, 1, 1); PG8_SCHED; PG8_LDA(At, 1, 0); PG8_STAGE(PG8_SA(0, 1), a2 + hstep, voffA);
            PG8_WAIT_V(8); PG8_WAIT_L(0); PG8_BAR; PG8_MMA(0, 0, At, B0); PG8_MMA(0, 1, At, B1); PG8_BAR; PG8_SCHED;
            PG8_LDA(At, 1, 1); PG8_STAGE(PG8_SB(1, 0), b3, voffB); PG8_STAGE(PG8_SB(1, 1), b3 + hstep, voffB); PG8_STAGE(PG8_SA(1, 0), a3, voffA);
            PG8_WAIT_V(8); PG8_WAIT_L(0); PG8_BAR; PG8_MMA(1, 0, At, B0); PG8_MMA(1, 1, At, B1); PG8_BAR; PG8_SCHED;
            } else {
            PG8_LDB(B0, 0, 0); PG8_SCHED; PG8_LDA(At, 0, 0); PG8_STAGE(PG8_SA(1, 1), a1 + hstep, voffA);
            PG8_WAIT_L(8); PG8_BAR; PG8_WAIT_L(0); PG8_MMA(0, 0, At, B0); PG8_BAR; PG8_SCHED;
            PG8_LDB(B1, 0, 1); PG8_STAGE(PG8_SB(0, 0), b2, voffB);
            PG8_BAR; PG8_WAIT_L(0); PG8_MMA(0, 1, At, B1); PG8_BAR;
            PG8_LDA(At, 0, 1); PG8_STAGE(PG8_SA(0, 0), a2, voffA);
            PG8_BAR; PG8_WAIT_L(0); PG8_MMA(1, 0, At, B0); PG8_BAR; PG8_SCHED;
            PG8_STAGE(PG8_SB(0, 1), b2 + hstep, voffB);
            PG8_WAIT_V(6); PG8_BAR; PG8_MMA(1, 1, At, B1); PG8_BAR;
            PG8_LDB(B0, 1, 0); PG8_SCHED; PG8_LDA(At, 1, 0); PG8_STAGE(PG8_SA(0, 1), a2 + hstep, voffA);
            PG8_WAIT_L(8); PG8_BAR; PG8_WAIT_L(0); PG8_MMA(0, 0, At, B0); PG8_BAR; PG8_SCHED;
            PG8_LDB(B1, 1, 1); PG8_STAGE(PG8_SB(1, 0), b3, voffB);
            PG8_BAR; PG8_WAIT_L(0); PG8_MMA(0, 1, At, B1); PG8_BAR;
            PG8_LDA(At, 1, 1); PG8_STAGE(PG8_SA(1, 0), a3, voffA);
            PG8_BAR; PG8_WAIT_L(0); PG8_MMA(1, 0, At, B0); PG8_BAR; PG8_SCHED;
            PG8_STAGE(PG8_SB(1, 1), b3 + hstep, voffB);
            PG8_WAIT_V(6); PG8_BAR; PG8_MMA(1, 1, At, B1); PG8_BAR;
            }
        }
        if constexpr (ALIGN_EPI) { if (wr == 0) PG8_BAR; }
        if constexpr (!Epi::AFTER_DRAIN) { E(acc, cur, wr, wc, fr, fq); S.done(cur); }
        if (!has_next) break;
#pragma unroll
        for (int a = 0; a < 2; ++a)
#pragma unroll
            for (int b = 0; b < 2; ++b)
#pragma unroll
                for (int m = 0; m < 4; ++m)
#pragma unroll
                    for (int n = 0; n < 2; ++n) acc[a][b][m][n] = (f32x4){0.f, 0.f, 0.f, 0.f};
        cur = nxt; cA = nA; cB = nB; ++ui;
        if constexpr (ALIGN_EPI) { if (wr == 1) PG8_BAR; }
    }
    PG8_WAIT_V(0);
    if constexpr (!ALIGN_EPI) { if (wr == 0) PG8_BAR; }
    PG8_BAR;
    if constexpr (Epi::AFTER_DRAIN) { E.fused(acc, cur, wr, wc, fr, fq, lds, wid, lane); S.done(cur); }
#undef PG8_SA
#undef PG8_SB
#undef PG8_STAGE
#undef PG8_LDA
#undef PG8_LDB
#undef PG8_MMA
#undef PG8_WAIT_V
#undef PG8_WAIT_L
#undef PG8_BAR
#undef PG8_SCHED
}
}
#define LAS __attribute__((address_space(3)))
typedef unsigned short bf16;
typedef unsigned v4u __attribute__((ext_vector_type(4)));
typedef unsigned v2u __attribute__((ext_vector_type(2)));
typedef float f32x4 __attribute__((ext_vector_type(4)));
typedef float f32x2 __attribute__((ext_vector_type(2)));
typedef float f32x16 __attribute__((ext_vector_type(16)));
typedef short bf16x8 __attribute__((ext_vector_type(8)));
typedef short s16x4 __attribute__((ext_vector_type(4)));
using pg8::O_YP; using pg8::O_YS; using pg8::O_KP; using pg8::O_VP; using pg8::O_KS; using pg8::O_VS; using pg8::O_GV; using pg8::O_SP; using pg8::O_SS;
constexpr int M = 8704, MP = 8192, D = 2048, NIN_E = 3584, DFF = 8192, NWAVES = 8, NTHR = 512;
constexpr size_t MiB = 1u << 20;
constexpr size_t WS_SS = 464 * MiB;
constexpr size_t SSN = (size_t)8704 * 32;
constexpr size_t WS_CS = 1 * MiB;
constexpr size_t WS_W5 = 2 * MiB, WS_W6 = 34 * MiB, WS_WU1 = 42 * MiB, WS_WD1 = 74 * MiB;
constexpr size_t WS_W1 = 106 * MiB, WS_W2 = 120 * MiB, WS_WU0 = 128 * MiB, WS_WD0 = 160 * MiB;
constexpr size_t WS_BIG = 192 * MiB;
constexpr size_t WS_Q = WS_BIG, WS_KP = WS_BIG + 17 * MiB, WS_KS = WS_BIG + 21 * MiB, WS_VTP = WS_BIG + 23 * MiB, WS_VTS = WS_BIG + 27 * MiB, WS_U = WS_BIG + 29 * MiB, WS_GVR = WS_BIG + 46 * MiB;
constexpr size_t WS_QH = 106 * MiB, WS_FH = 174 * MiB, WS_VH = 242 * MiB, WS_GH = 276 * MiB;
constexpr size_t WS_H = 328 * MiB;
constexpr size_t WS_A1 = 396 * MiB;
constexpr size_t WS_A2 = 430 * MiB;
constexpr size_t WS_END = 470 * MiB;
constexpr size_t WS_SEG = WS_A1, WS_DEC = WS_A1 + 16 * MiB;
constexpr int LDS_BYTES = 147456;
constexpr int NPH = 16;

__device__ __forceinline__ unsigned f2bf(float f) { unsigned u = __builtin_bit_cast(unsigned, f); return (u + 0x7fffu + ((u >> 16) & 1u)) >> 16; }
__device__ __forceinline__ unsigned pk2(float lo, float hi) { return pg8::cvt_pk_bf16(lo, hi); }
__device__ __forceinline__ float bf2f(unsigned short b) { return __builtin_bit_cast(float, (unsigned)b << 16); }
__device__ __forceinline__ float wave_sum(float v) {
#pragma unroll
    for (int o = 1; o < 64; o <<= 1) v += __shfl_xor(v, o);
    return v;
}
struct Args { const float* in[20]; float* out; unsigned char* ws; int ph_lo, ph_hi; };

__device__ __forceinline__ void tr64_item(const float* __restrict__ W, int K, int N, bf16* WT, const float* __restrict__ g, LAS float* scr, int item, int lane) {
    const int nblk = N / 64, kb = item / nblk, nb = item % nblk, k0 = 64 * kb, n0 = 64 * nb;
    const int kr = lane >> 4, l4 = lane & 15;
    f32x4 v[16];
#pragma unroll
    for (int i = 0; i < 16; ++i) v[i] = __builtin_nontemporal_load((const f32x4*)(W + (size_t)(k0 + 4 * i + kr) * N + n0 + 4 * l4));
#pragma unroll
    for (int i = 0; i < 16; ++i) { const int k = 4 * i + kr; if (g) v[i] = v[i] * g[k0 + k];
        *(LAS f32x4*)(scr + k * 64 + ((4 * l4) ^ ((k >> 3) << 2))) = v[i]; }
    asm volatile("s_waitcnt lgkmcnt(0)" ::: "memory");
    const int c = lane & 7, nn = lane >> 3;
#pragma unroll
    for (int j = 0; j < 8; ++j) { const int n = nn + 8 * j; const LAS float* s = scr + (8 * c) * 64 + (n ^ (c << 2));
        v4u o; o.x = pk2(s[0 * 64], s[1 * 64]); o.y = pk2(s[2 * 64], s[3 * 64]); o.z = pk2(s[4 * 64], s[5 * 64]); o.w = pk2(s[6 * 64], s[7 * 64]);
        *(v4u*)(WT + (size_t)(n0 + n) * K + k0 + 8 * c) = o; }
    asm volatile("s_waitcnt lgkmcnt(0)" ::: "memory");
}
__device__ __forceinline__ void attn_wave(const bf16* Qp, const bf16* Kp, int kstride, const bf16* Vt, int vstride, int nkb, float sink, bf16* Op, int lane) {
    const int r = lane & 31, h = lane >> 5;
    bf16x8 qf[4];
#pragma unroll
    for (int s = 0; s < 4; ++s) qf[s] = *(const bf16x8*)(Qp + (size_t)r * 1024 + 16 * s + 8 * h);
    f32x16 S[6];
#pragma unroll
    for (int kb = 0; kb < 6; ++kb) {
        S[kb] = (f32x16){0.f,0.f,0.f,0.f,0.f,0.f,0.f,0.f,0.f,0.f,0.f,0.f,0.f,0.f,0.f,0.f};
        if (kb < nkb) {
#pragma unroll
            for (int s = 0; s < 4; ++s) { const bf16x8 kf = *(const bf16x8*)(Kp + (size_t)(kb * 32 + r) * kstride + 16 * s + 8 * h);
                S[kb] = __builtin_amdgcn_mfma_f32_32x32x16_bf16(kf, qf[s], S[kb], 0, 0, 0); }
        }
    }
    float mx = sink;
#pragma unroll
    for (int kb = 0; kb < 6; ++kb) if (kb < nkb) {
#pragma unroll
        for (int i = 0; i < 16; ++i) mx = fmaxf(mx, S[kb][i]); }
    mx = fmaxf(mx, __shfl_xor(mx, 32));
    float l = 0.f;
#pragma unroll
    for (int kb = 0; kb < 6; ++kb) if (kb < nkb) {
#pragma unroll
        for (int i = 0; i < 16; ++i) { const float p = __expf(S[kb][i] - mx); S[kb][i] = p; l += p; } }
    l += __shfl_xor(l, 32);
    l += __expf(sink - mx);
    f32x16 O[2];
    O[0] = (f32x16){0.f,0.f,0.f,0.f,0.f,0.f,0.f,0.f,0.f,0.f,0.f,0.f,0.f,0.f,0.f,0.f}; O[1] = O[0];
#pragma unroll
    for (int kb = 0; kb < 6; ++kb) if (kb < nkb) {
#pragma unroll
        for (int s = 0; s < 2; ++s) {
            v4u pw; pw.x = pk2(S[kb][8 * s + 0], S[kb][8 * s + 1]); pw.y = pk2(S[kb][8 * s + 2], S[kb][8 * s + 3]); pw.z = pk2(S[kb][8 * s + 4], S[kb][8 * s + 5]); pw.w = pk2(S[kb][8 * s + 6], S[kb][8 * s + 7]);
            const bf16x8 pf = __builtin_bit_cast(bf16x8, pw);
#pragma unroll
            for (int db = 0; db < 2; ++db) {
                const bf16* vp = Vt + (size_t)(db * 32 + r) * vstride + kb * 32 + 16 * s + 4 * h;
                const v2u lo = *(const v2u*)vp, hi = *(const v2u*)(vp + 8);
                v4u vw; vw.x = lo.x; vw.y = lo.y; vw.z = hi.x; vw.w = hi.y;
                O[db] = __builtin_amdgcn_mfma_f32_32x32x16_bf16(__builtin_bit_cast(bf16x8, vw), pf, O[db], 0, 0, 0);
            }
        }
    }
    const float il = 1.f / l;
#pragma unroll
    for (int db = 0; db < 2; ++db)
#pragma unroll
        for (int g4 = 0; g4 < 4; ++g4) {
            v2u w; w.x = pk2(O[db][4 * g4 + 0] * il, O[db][4 * g4 + 1] * il); w.y = pk2(O[db][4 * g4 + 2] * il, O[db][4 * g4 + 3] * il);
            *(v2u*)(Op + (size_t)r * 2048 + db * 32 + 8 * g4 + 4 * h) = w;
        }
}

__device__ __forceinline__ void gmlp_unit(unsigned char* lds, const float* GVr, const bf16* U, const float* gamma, const float* Wsp, const float* bias, bf16* AB, float* gvout, int row0, int nrows, int hg, int tid) {
    bf16* gvT = (bf16*)lds;
    const int lane = tid & 63, wave = tid >> 6;
    {
        const int q = tid >> 2, part = tid & 3;
        f32x4 v[8]; float s = 0.f;
        if (q < nrows) {
#pragma unroll
            for (int j = 0; j < 8; ++j) { v[j] = *(const f32x4*)(GVr + (size_t)(row0 + q) * 1024 + hg * 128 + part * 32 + 4 * j); s += (v[j][0] + v[j][1]) + (v[j][2] + v[j][3]); }
        } else {
#pragma unroll
            for (int j = 0; j < 8; ++j) v[j] = (f32x4){0.f, 0.f, 0.f, 0.f};
        }
        s += __shfl_xor(s, 1); s += __shfl_xor(s, 2);
        const float mu = s * (1.f / 128.f); float s2 = 0.f;
#pragma unroll
        for (int j = 0; j < 8; ++j) { v[j] = v[j] - mu; s2 += (v[j][0] * v[j][0] + v[j][1] * v[j][1]) + (v[j][2] * v[j][2] + v[j][3] * v[j][3]); }
        s2 += __shfl_xor(s2, 1); s2 += __shfl_xor(s2, 2);
        const float rstd = rsqrtf(s2 * (1.f / 128.f) + 1e-6f);
#pragma unroll
        for (int j = 0; j < 8; ++j) {
            const f32x4 gm = *(const f32x4*)(gamma + hg * 128 + part * 32 + 4 * j);
            f32x4 o = v[j] * rstd * gm;
            if (q >= nrows) o = (f32x4){0.f, 0.f, 0.f, 0.f};
            if (gvout && q < nrows) *(f32x4*)(gvout + ((size_t)q * 8 + hg) * 128 + part * 32 + 4 * j) = o;
#pragma unroll
            for (int e = 0; e < 4; ++e) gvT[(part * 32 + 4 * j + e) * 136 + q] = (bf16)f2bf(o[e]);
        }
    }
    __syncthreads();
    const int r = lane & 31, hh = lane >> 5;
    const int pb = wave >> 1;
    if (pb * 32 < nrows) {
        const int nks = (nrows == 32) ? 2 : (pb < 2 ? 4 : 8);
        f32x16 acc[2];
        acc[0] = (f32x16){0.f,0.f,0.f,0.f,0.f,0.f,0.f,0.f,0.f,0.f,0.f,0.f,0.f,0.f,0.f,0.f}; acc[1] = acc[0];
        for (int s = 0; s < nks; ++s) {
            const float* wp = Wsp + ((size_t)hg * 128 + pb * 32 + r) * 128 + 16 * s + 8 * hh;
            const f32x4 w0 = *(const f32x4*)wp, w1 = *(const f32x4*)(wp + 4);
            v4u aw; aw.x = pk2(w0[0], w0[1]); aw.y = pk2(w0[2], w0[3]); aw.z = pk2(w1[0], w1[1]); aw.w = pk2(w1[2], w1[3]);
            const bf16x8 af = __builtin_bit_cast(bf16x8, aw);
#pragma unroll
            for (int t = 0; t < 2; ++t) {
                const int db = (wave & 1) * 2 + t;
                const bf16x8 bfr = *(const bf16x8*)(gvT + (db * 32 + r) * 136 + 16 * s + 8 * hh);
                acc[t] = __builtin_amdgcn_mfma_f32_32x32x16_bf16(bfr, af, acc[t], 0, 0, 0);
            }
        }
        {
            const int p = pb * 32 + r; const float bs = bias[hg * 128 + p];
#pragma unroll
            for (int t = 0; t < 2; ++t)
#pragma unroll
                for (int g4 = 0; g4 < 4; ++g4) {
                    const int dcol = hg * 128 + ((wave & 1) * 2 + t) * 32 + 8 * g4 + 4 * hh;
                    const v2u uw = *(const v2u*)(U + (size_t)(row0 + p) * 1024 + dcol);
                    v2u ow; ow.x = pk2(bf2f((unsigned short)(uw.x & 0xffff)) * (acc[t][4 * g4 + 0] + bs), bf2f((unsigned short)(uw.x >> 16)) * (acc[t][4 * g4 + 1] + bs));
                    ow.y = pk2(bf2f((unsigned short)(uw.y & 0xffff)) * (acc[t][4 * g4 + 2] + bs), bf2f((unsigned short)(uw.y >> 16)) * (acc[t][4 * g4 + 3] + bs));
                    *(v2u*)(AB + (size_t)(row0 + p) * 2048 + 1024 + dcol) = ow;
                }
        }
    }
    __syncthreads();
}

template <bool OUT, bool DECAY>
__device__ __forceinline__ void hgrn_unit(unsigned char* lds, const float* QH, const float* FH, const bf16* VH, const bf16* GH, const float* gon, bf16* Oo,
                                          int hd, int row0, int L, int init, const float* sin, const float* SEG, const float* DEC, int gseg, float* sout, float* decout, int tid) {
    float* qs = (float*)lds;
    float* fs = qs + 2 * 2048;
    float* vs = fs + 2 * 2048;
    float* op = vs + 2 * 2048;
    const int lane = tid & 63, w = tid >> 6, e = (w & 1) * 64 + lane, dq = w >> 1, d0 = dq * 32;
    f32x2 S[16];
    if (init == 1) {
#pragma unroll
        for (int i = 0; i < 16; ++i) { S[i].x = sin[(size_t)(d0 + 2 * i) * 128 + e]; S[i].y = sin[(size_t)(d0 + 2 * i + 1) * 128 + e]; }
    } else {
#pragma unroll
        for (int i = 0; i < 16; ++i) S[i] = (f32x2){0.f, 0.f};
        if (init == 2) {
            for (int g = 0; g < gseg; ++g) {
                const float* Lp = SEG + ((size_t)(hd * 16 + g) * 128 + d0) * 128 + e; const float* Dp = DEC + (size_t)(hd * 16 + g) * 128 + d0;
#pragma unroll
                for (int i = 0; i < 16; ++i) { S[i].x = Dp[2 * i] * S[i].x + Lp[(size_t)(2 * i) * 128]; S[i].y = Dp[2 * i + 1] * S[i].y + Lp[(size_t)(2 * i + 1) * 128]; }
            }
        }
    }
    float dec = 1.f;
    const int tt = tid >> 5, c4 = (tid & 31) * 4;
    const int nb = L >> 4;
    f32x4 rq, rf; v2u rv;
    {
        const size_t off = (size_t)(row0 + tt) * 2048 + hd * 128 + c4;
        if (OUT) rq = *(const f32x4*)(QH + off);
        rf = *(const f32x4*)(FH + off); rv = *(const v2u*)(VH + off);
        if (OUT) *(f32x4*)(qs + tt * 128 + c4) = rq;
        *(f32x4*)(fs + tt * 128 + c4) = rf;
        *(f32x4*)(vs + tt * 128 + c4) = (f32x4){bf2f((unsigned short)(rv.x & 0xffff)), bf2f((unsigned short)(rv.x >> 16)), bf2f((unsigned short)(rv.y & 0xffff)), bf2f((unsigned short)(rv.y >> 16))};
    }
    __syncthreads();
    for (int b = 0; b < nb; ++b) {
        const int buf = b & 1;
        if (b + 1 < nb) {
            const size_t off = (size_t)(row0 + (b + 1) * 16 + tt) * 2048 + hd * 128 + c4;
            if (OUT) rq = *(const f32x4*)(QH + off);
            rf = *(const f32x4*)(FH + off); rv = *(const v2u*)(VH + off);
        }
        const float* qb = qs + buf * 2048 + d0; const float* fb = fs + buf * 2048 + d0; const float* vb = vs + buf * 2048 + e;
#pragma unroll 2
        for (int t = 0; t < 16; ++t) {
            const float v = vb[t * 128]; const f32x2 v2 = (f32x2){v, v};
            f32x2 o2 = (f32x2){0.f, 0.f};
#pragma unroll
            for (int i = 0; i < 8; ++i) {
                const f32x4 f4 = *(const f32x4*)(fb + t * 128 + 4 * i);
                S[2 * i] = (f32x2){f4[0], f4[1]} * (S[2 * i] - v2) + v2;
                S[2 * i + 1] = (f32x2){f4[2], f4[3]} * (S[2 * i + 1] - v2) + v2;
                if (OUT) { const f32x4 q4 = *(const f32x4*)(qb + t * 128 + 4 * i); o2 += (f32x2){q4[0], q4[1]} * S[2 * i]; o2 += (f32x2){q4[2], q4[3]} * S[2 * i + 1]; }
            }
            if (OUT) op[((buf * 16 + t) * 4 + dq) * 128 + e] = o2.x + o2.y;
        }
        if (DECAY) { if (tid < 128) {
#pragma unroll
            for (int t = 0; t < 16; ++t) dec *= fs[buf * 2048 + t * 128 + tid]; } }
        if (b + 1 < nb) {
            const int nbuf = buf ^ 1;
            if (OUT) *(f32x4*)(qs + nbuf * 2048 + tt * 128 + c4) = rq;
            *(f32x4*)(fs + nbuf * 2048 + tt * 128 + c4) = rf;
            *(f32x4*)(vs + nbuf * 2048 + tt * 128 + c4) = (f32x4){bf2f((unsigned short)(rv.x & 0xffff)), bf2f((unsigned short)(rv.x >> 16)), bf2f((unsigned short)(rv.y & 0xffff)), bf2f((unsigned short)(rv.y >> 16))};
        }
        __syncthreads();
        if (OUT) {
            const float* ob = op + (buf * 16 + tt) * 512 + c4;
            f32x4 o = *(const f32x4*)ob + *(const f32x4*)(ob + 128) + *(const f32x4*)(ob + 256) + *(const f32x4*)(ob + 384);
            float sq = (o[0] * o[0] + o[1] * o[1]) + (o[2] * o[2] + o[3] * o[3]);
#pragma unroll
            for (int x = 1; x < 32; x <<= 1) sq += __shfl_xor(sq, x);
            const float rms = rsqrtf(sq * (1.f / 128.f) + 1e-6f);
            const size_t off = (size_t)(row0 + b * 16 + tt) * 2048 + hd * 128 + c4;
            const v2u gw = *(const v2u*)(GH + off); const f32x4 gn = *(const f32x4*)(gon + hd * 128 + c4);
            const float r0 = o[0] * rms * gn[0] * bf2f((unsigned short)(gw.x & 0xffff)), r1 = o[1] * rms * gn[1] * bf2f((unsigned short)(gw.x >> 16));
            const float r2 = o[2] * rms * gn[2] * bf2f((unsigned short)(gw.y & 0xffff)), r3 = o[3] * rms * gn[3] * bf2f((unsigned short)(gw.y >> 16));
            v2u ow; ow.x = pk2(r0, r1); ow.y = pk2(r2, r3);
            *(v2u*)(Oo + off) = ow;
        }
    }
    if (sout) {
#pragma unroll
        for (int i = 0; i < 16; ++i) { sout[(size_t)(d0 + 2 * i) * 128 + e] = S[i].x; sout[(size_t)(d0 + 2 * i + 1) * 128 + e] = S[i].y; }
    }
    if (DECAY) { if (decout && tid < 128) decout[tid] = dec; }
    __syncthreads();
}
#define XB_TMO      128
#define XB_XCNT(j)  (256  + 64 * (j))
#define XB_XSUB(j)  (1280 + 64 * (j))
#define XB_XGEN(j)  (2304 + 64 * (j))
#define XB_TOP      3328
#define XB_TOPGEN   3392
#define XCD_BAR_WORDS 3456
#define XB_SPIN_CAP (1u << 18)

__device__ __forceinline__ unsigned xb_ld(unsigned* p)              { return __hip_atomic_load(p, __ATOMIC_RELAXED, __HIP_MEMORY_SCOPE_AGENT); }
__device__ __forceinline__ unsigned xb_add(unsigned* p, unsigned v) { return __hip_atomic_fetch_add(p, v, __ATOMIC_RELAXED, __HIP_MEMORY_SCOPE_AGENT); }
__device__ __forceinline__ unsigned xb_xcc_id() { return (unsigned)__builtin_amdgcn_s_getreg((3 << 11) | 20) & 0xFu; }
#define XB_SPIN(cond, bar) do { unsigned _sp = 0; while (cond) { __builtin_amdgcn_s_sleep(1); \
    if ((++_sp & 255u) == 0u) { if (xb_ld(&(bar)[XB_TMO])) break; if (_sp > XB_SPIN_CAP) { atomicAdd(&(bar)[XB_TMO], 1u); break; } } } } while (0)

struct XcdBarrier {
    unsigned* bar; unsigned x;
    volatile LAS unsigned* st;
};

__device__ __forceinline__ XcdBarrier xcd_barrier_post(unsigned* bar, volatile LAS unsigned* st) {
    XcdBarrier b; b.bar = bar; b.x = xb_xcc_id(); b.st = st;
    if (threadIdx.x == 0) (void)xb_add(&bar[XB_XCNT(b.x)], 1u);
    return b;
}
__device__ __forceinline__ void xcd_barrier_complete(unsigned* bar, unsigned x, unsigned& nloc, unsigned& nx) {
    const unsigned G = gridDim.x * gridDim.y * gridDim.z;
    unsigned sum, cnt, mine, sp = 0u;
    for (;;) {
        sum = 0u; cnt = 0u; mine = 0u;
#pragma unroll
        for (unsigned j = 0; j < 16; ++j) { const unsigned c = xb_ld(&bar[XB_XCNT(j)]); sum += c; cnt += (c > 0u) ? 1u : 0u; mine = (j == x) ? c : mine; }
        if (sum == G) break;
        __builtin_amdgcn_s_sleep(1);
        if ((++sp & 255u) == 0u) { if (xb_ld(&bar[XB_TMO])) break; if (sp > XB_SPIN_CAP) { atomicAdd(&bar[XB_TMO], 1u); break; } }
    }
    nloc = mine > 0u ? mine : 1u; nx = cnt > 0u ? cnt : 1u;
}

__device__ __forceinline__ void xcd_barrier(const XcdBarrier& b) {
    asm volatile("s_waitcnt vmcnt(0)" ::: "memory");
    __syncthreads();
    if (threadIdx.x == 0) {
        unsigned* bar = b.bar;
        __builtin_amdgcn_s_waitcnt(0);
        unsigned nloc = b.st[0], nx = b.st[1];
        if (nloc == 0u) { xcd_barrier_complete(bar, b.x, nloc, nx); b.st[0] = nloc; b.st[1] = nx; }
        const unsigned old = xb_add(&bar[XB_XSUB(b.x)], 1u);
        const unsigned gen = old / nloc;
        if (old + 1u == (gen + 1u) * nloc) {
            __builtin_amdgcn_fence(__ATOMIC_RELEASE, "agent");
            asm volatile("s_waitcnt vmcnt(0)" ::: "memory");
            const unsigned og = xb_add(&bar[XB_TOP], 1u);
            const unsigned tg = og / nx;
            if (og + 1u == (tg + 1u) * nx) xb_add(&bar[XB_TOPGEN], 1u);
            else XB_SPIN(xb_ld(&bar[XB_TOPGEN]) == tg, bar);
            __builtin_amdgcn_fence(__ATOMIC_ACQUIRE, "agent");
            xb_add(&bar[XB_XGEN(b.x)], 1u);
            asm volatile("s_waitcnt vmcnt(0)" ::: "memory");
        } else {
            XB_SPIN(xb_ld(&bar[XB_XGEN(b.x)]) == gen, bar);
            __builtin_amdgcn_fence(__ATOMIC_ACQUIRE, "agent");
            asm volatile("s_waitcnt vmcnt(0)" ::: "memory");
        }
    }
    __syncthreads();
}
constexpr int HG_QH = 0, HG_KT = 8704, HG_KHT = 17408, HG_VT = 27648, HG_D = 37888, HG_PART = 38400, HG_OST = 40448;
__device__ __forceinline__ bf16x8 pack8(const f32x16& x, int o) {
    v4u w; w.x = pg8::cvt_pk_bf16(x[o + 0], x[o + 1]); w.y = pg8::cvt_pk_bf16(x[o + 2], x[o + 3]); w.z = pg8::cvt_pk_bf16(x[o + 4], x[o + 5]); w.w = pg8::cvt_pk_bf16(x[o + 6], x[o + 7]);
    return __builtin_bit_cast(bf16x8, w);
}
template <bool OUT>
__device__ __forceinline__ void hg_unit(unsigned char* lds, const float* QH, const float* FH, const bf16* VH, const bf16* GH, const float* gon, bf16* Oo,
                                        int hd, int row0, int nch, int init, const float* sin, const float* SEG, const float* DEC, int gseg, float* sout, float* decout, int tid, float* zflag = nullptr) {
    bf16* Qh = (bf16*)(lds + HG_QH); bf16* Kt = (bf16*)(lds + HG_KT); bf16* KhT = (bf16*)(lds + HG_KHT); bf16* VT = (bf16*)(lds + HG_VT);
    float* Dv = (float*)(lds + HG_D); float* Pp = (float*)(lds + HG_PART); float* Ost = (float*)(lds + HG_OST);
    const int lane = tid & 63, w = __builtin_amdgcn_readfirstlane(tid >> 6), r = lane & 31, hh = lane >> 5;
    const int d = tid & 127, tq = __builtin_amdgcn_readfirstlane(tid >> 7);
    const f32x16 Z16 = (f32x16){0.f,0.f,0.f,0.f,0.f,0.f,0.f,0.f,0.f,0.f,0.f,0.f,0.f,0.f,0.f,0.f};
    f32x16 S[4];
#pragma unroll
    for (int db = 0; db < 4; ++db) S[db] = Z16;
    if (w < 4) {
        if (init == 1) {
#pragma unroll
            for (int db = 0; db < 4; ++db)
#pragma unroll
                for (int i = 0; i < 16; ++i) S[db][i] = sin[(size_t)(db * 32 + (i & 3) + 8 * (i >> 2) + 4 * hh) * 128 + w * 32 + r];
        }
    }
    float dec = 1.f;
    float pf[8], pq[8]; unsigned short pv[8];
    {
        const size_t off = (size_t)(row0 + tq * 8) * 2048 + hd * 128 + d;
#pragma unroll
        for (int j = 0; j < 8; ++j) { pf[j] = FH[off + (size_t)j * 2048]; pv[j] = VH[off + (size_t)j * 2048]; if (OUT) pq[j] = QH[off + (size_t)j * 2048]; }
    }
    for (int c = 0; c < nch; ++c) {
        v4u gw = (v4u){0u, 0u, 0u, 0u};
        if (OUT) gw = *(const v4u*)(GH + (size_t)(row0 + c * 32 + (tid >> 4)) * 2048 + hd * 128 + (tid & 15) * 8);
        float A[8]; float run = 1.f;
#pragma unroll
        for (int j = 0; j < 8; ++j) { run *= pf[j]; A[j] = run; }
        Pp[tq * 128 + d] = run;
        __syncthreads();
        const float p0 = Pp[d], p1 = Pp[128 + d], p2 = Pp[256 + d], p3 = Pp[384 + d];
        const float offp = tq == 0 ? 1.f : tq == 1 ? p0 : tq == 2 ? p0 * p1 : p0 * p1 * p2;
        const float tot = (p0 * p1) * (p2 * p3);
#pragma unroll
        for (int j = 0; j < 8; ++j) {
            const int t = tq * 8 + j; const float a = A[j] * offp, ia = __builtin_amdgcn_rcpf(a), k = 1.f - pf[j];
            if (OUT) Qh[t * 136 + d] = (bf16)f2bf(pq[j] * a);
            if (OUT) Kt[t * 136 + d] = (bf16)f2bf(k * ia);
            KhT[d * 40 + t] = (bf16)f2bf(k * tot * ia);
            VT[d * 40 + t] = pv[j];
        }
        if (tq == 0) { Dv[d] = tot; if (!OUT) dec *= tot; }
        if (c + 1 < nch) {
            const size_t off = (size_t)(row0 + (c + 1) * 32 + tq * 8) * 2048 + hd * 128 + d;
#pragma unroll
            for (int j = 0; j < 8; ++j) { pf[j] = FH[off + (size_t)j * 2048]; pv[j] = VH[off + (size_t)j * 2048]; if (OUT) pq[j] = QH[off + (size_t)j * 2048]; }
        }
        __syncthreads();
        if (w < 4) {
            if (OUT) {
                f32x16 P = Z16;
#pragma unroll
                for (int kk = 0; kk < 8; ++kk) {
                    const bf16x8 a = *(const bf16x8*)(Kt + r * 136 + 16 * kk + 8 * hh), b = *(const bf16x8*)(Qh + r * 136 + 16 * kk + 8 * hh);
                    P = __builtin_amdgcn_mfma_f32_32x32x16_bf16(a, b, P, 0, 0, 0);
                }
#pragma unroll
                for (int i = 0; i < 16; ++i) { const int s = (i & 3) + 8 * (i >> 2) + 4 * hh; if (s > r) P[i] = 0.f; }
                f32x16 o = Z16;
#pragma unroll
                for (int db = 0; db < 4; ++db)
#pragma unroll
                    for (int kk = 0; kk < 2; ++kk) {
                        const bf16* qp = Qh + r * 136 + db * 32 + 16 * kk + 4 * hh;
                        const v2u lo = *(const v2u*)qp, hi = *(const v2u*)(qp + 8);
                        v4u bw; bw.x = lo.x; bw.y = lo.y; bw.z = hi.x; bw.w = hi.y;
                        o = __builtin_amdgcn_mfma_f32_32x32x16_bf16(pack8(S[db], 8 * kk), __builtin_bit_cast(bf16x8, bw), o, 0, 0, 0);
                    }
#pragma unroll
                for (int kk = 0; kk < 2; ++kk) {
                    const bf16* vp = VT + (w * 32 + r) * 40 + 16 * kk + 4 * hh;
                    const v2u lo = *(const v2u*)vp, hi = *(const v2u*)(vp + 8);
                    v4u aw; aw.x = lo.x; aw.y = lo.y; aw.z = hi.x; aw.w = hi.y;
                    o = __builtin_amdgcn_mfma_f32_32x32x16_bf16(__builtin_bit_cast(bf16x8, aw), pack8(P, 8 * kk), o, 0, 0, 0);
                }
#pragma unroll
                for (int g4 = 0; g4 < 4; ++g4) *(f32x4*)(Ost + r * 132 + w * 32 + 8 * g4 + 4 * hh) = (f32x4){o[4 * g4], o[4 * g4 + 1], o[4 * g4 + 2], o[4 * g4 + 3]};
            }
#pragma unroll
            for (int db = 0; db < 4; ++db) {
#pragma unroll
                for (int g4 = 0; g4 < 4; ++g4) { const f32x4 dv = *(const f32x4*)(Dv + db * 32 + 8 * g4 + 4 * hh);
#pragma unroll
                    for (int j = 0; j < 4; ++j) S[db][4 * g4 + j] *= dv[j]; }
#pragma unroll
                for (int kk = 0; kk < 2; ++kk) {
                    const bf16x8 a = *(const bf16x8*)(KhT + (db * 32 + r) * 40 + 16 * kk + 8 * hh), b = *(const bf16x8*)(VT + (w * 32 + r) * 40 + 16 * kk + 8 * hh);
                    S[db] = __builtin_amdgcn_mfma_f32_32x32x16_bf16(a, b, S[db], 0, 0, 0);
                }
            }
        }
        if (OUT) {
            __syncthreads();
            const int t = tid >> 4, e8 = (tid & 15) * 8;
            const f32x4 o0 = *(const f32x4*)(Ost + t * 132 + e8), o1 = *(const f32x4*)(Ost + t * 132 + e8 + 4);
            float sq = ((o0[0] * o0[0] + o0[1] * o0[1]) + (o0[2] * o0[2] + o0[3] * o0[3])) + ((o1[0] * o1[0] + o1[1] * o1[1]) + (o1[2] * o1[2] + o1[3] * o1[3]));
#pragma unroll
            for (int x = 1; x < 16; x <<= 1) sq += __shfl_xor(sq, x);
            const float rms = rsqrtf(sq * (1.f / 128.f) + 1e-6f);
            const size_t off = (size_t)(row0 + c * 32 + t) * 2048 + hd * 128 + e8;
            const f32x4 g0 = *(const f32x4*)(gon + hd * 128 + e8), g1 = *(const f32x4*)(gon + hd * 128 + e8 + 4);
            v4u ow;
            ow.x = pk2(o0[0] * rms * g0[0] * bf2f((unsigned short)(gw.x & 0xffff)), o0[1] * rms * g0[1] * bf2f((unsigned short)(gw.x >> 16)));
            ow.y = pk2(o0[2] * rms * g0[2] * bf2f((unsigned short)(gw.y & 0xffff)), o0[3] * rms * g0[3] * bf2f((unsigned short)(gw.y >> 16)));
            ow.z = pk2(o1[0] * rms * g1[0] * bf2f((unsigned short)(gw.z & 0xffff)), o1[1] * rms * g1[1] * bf2f((unsigned short)(gw.z >> 16)));
            ow.w = pk2(o1[2] * rms * g1[2] * bf2f((unsigned short)(gw.w & 0xffff)), o1[3] * rms * g1[3] * bf2f((unsigned short)(gw.w >> 16)));
            *(v4u*)(Oo + off) = ow;
        }
    }
    if (sout && w < 4) {
#pragma unroll
        for (int db = 0; db < 4; ++db)
#pragma unroll
            for (int i = 0; i < 16; ++i) sout[(size_t)(db * 32 + (i & 3) + 8 * (i >> 2) + 4 * hh) * 128 + w * 32 + r] = S[db][i];
    }
    if (!OUT) {
        if (decout && tid < 128) decout[tid] = dec;
        const int anynz = __syncthreads_or(tid < 128 && dec > 0.f);
        if (zflag && tid == 0) *zflag = anynz ? 0.f : 1.f;
    }
    __syncthreads();
}
#ifndef DBG_A2PTR
#define DBG_A2PTR A2
#endif
#ifndef SEQ_LO
#define SEQ_LO 0xbad98e76d54d3210ull
#define SEQ_HI 0xcull
#define SEQ_N 17
#endif
#ifndef DBG_SSI
#define DBG_SSI 4
#endif
#ifndef PHMASK
#define PHMASK 0xffff
#endif
#define PHEN(k) (((PHMASK) >> (k)) & 1)
#ifndef MK_PER_PHASE
#define MK_PER_PHASE 0
#endif
#define CAS __attribute__((address_space(4)))
#define INP(i) (*(const float* const CAS*)(kp + 8 * (i)))
#define xp INP(0)
#define xs INP(1)
#define ss ((float*)(ws + WS_SS))
#define cs ((float*)(ws + WS_CS))
#define A1 ((bf16*)(ws + WS_A1))
#define A2 ((bf16*)(ws + WS_A2))
#define H ((float*)(ws + WS_H))
#define HID ((bf16*)(ws + WS_BIG))
#define Qb ((bf16*)(ws + WS_Q))
#define Kpb ((bf16*)(ws + WS_KP))
#define Ksb ((bf16*)(ws + WS_KS))
#define Vtp ((bf16*)(ws + WS_VTP))
#define Vts ((bf16*)(ws + WS_VTS))
#define Ub ((bf16*)(ws + WS_U))
#define GVr ((float*)(ws + WS_GVR))
#define QH ((float*)(ws + WS_QH))
#define FH ((float*)(ws + WS_FH))
#define VH ((bf16*)(ws + WS_VH))
#define GH ((bf16*)(ws + WS_GH))
#define SEG ((float*)(ws + WS_SEG))
#define DEC ((float*)(ws + WS_DEC))

#define CONV_L1(j_) do { int r_ = (j_); \
    if (r_ < 4096) { tr64_item(INP(14), 2048, 8192, (bf16*)(ws + WS_W5), INP(5) + 2048, scr, r_, lane); break; } r_ -= 4096; \
    if (r_ < 1024) { tr64_item(INP(15), 2048, 2048, (bf16*)(ws + WS_W6), nullptr, scr, r_, lane); break; } r_ -= 1024; \
    if (r_ < 4096) { tr64_item(INP(18) + (size_t)2048 * 8192, 2048, 8192, (bf16*)(ws + WS_WU1), INP(6) + 2048, scr, r_, lane); break; } r_ -= 4096; \
    tr64_item(INP(19) + (size_t)2048 * 8192, 8192, 2048, (bf16*)(ws + WS_WD1), nullptr, scr, r_, lane); } while (0)
#define CONV_RANGE(j0_, j1_, w0_, nw_) do { LAS float* scr = (LAS float*)(lds3 + wave * 16384); \
    for (int j__ = (j0_) + (w0_) * NWAVES + wave; j__ < (j1_); j__ += (nw_) * NWAVES) CONV_L1(j__); } while (0)
__global__ void __launch_bounds__(NTHR, 2) mk_fwd(Args a) {
    extern __shared__ __attribute__((aligned(16))) unsigned char lds[];
    const int G = gridDim.x, bid = blockIdx.x;
    cg::grid_group grid = cg::this_grid();
    volatile LAS unsigned* xb_misc = (volatile LAS unsigned*)((LAS unsigned char*)lds + 131072 + 320);
    if (threadIdx.x < 32) xb_misc[threadIdx.x] = 0u;
    __syncthreads();
    XcdBarrier xbar = xcd_barrier_post((unsigned*)a.ws, xb_misc + 8);

    int nfin = 0;
    for (int st = a.ph_lo; st < a.ph_hi; ++st) {
        const int ph = (int)(((st < 16 ? (unsigned long long)SEQ_LO >> (4 * st) : (unsigned long long)SEQ_HI >> (4 * (st - 16)))) & 15ull);
        int tid = threadIdx.x;
        const CAS unsigned char* kp = (const CAS unsigned char*)__builtin_amdgcn_kernarg_segment_ptr();
        asm volatile("" : "+v"(tid)); asm volatile("" : "+s"(kp));
        unsigned char* ws = *(unsigned char* const CAS*)(kp + 168); float* out = *(float* const CAS*)(kp + 160);
        const int lane = tid & 63, wave = __builtin_amdgcn_readfirstlane(tid >> 6);
        LAS unsigned char* lds3 = (LAS unsigned char*)lds;
        if (ph == 0 && PHEN(0)) {
            LAS float* scr = (LAS float*)(lds3 + wave * 16384);
            const int gw = bid * NWAVES + wave, NGW = G * NWAVES;
            constexpr int J_1 = 32 * 56, J_2 = 32 * 32, J_U = 32 * 128, J_D = 128 * 32;
            for (int it = gw; it < J_1 + J_2 + J_U + J_D; it += NGW) {
                int r = it;
                if (r < J_1) { tr64_item(INP(8), 2048, 3584, (bf16*)(ws + WS_W1), INP(5), scr, r, lane); continue; } r -= J_1;
                if (r < J_2) { tr64_item(INP(9), 2048, 2048, (bf16*)(ws + WS_W2), nullptr, scr, r, lane); continue; } r -= J_2;
                if (r < J_U) { tr64_item(INP(18), 2048, 8192, (bf16*)(ws + WS_WU0), INP(6), scr, r, lane); continue; } r -= J_U;
                tr64_item(INP(19), 8192, 2048, (bf16*)(ws + WS_WD0), nullptr, scr, r, lane);
            }
            CONV_RANGE(0, 2046, bid, G); CONV_RANGE(12572, 13312, bid, G);
            for (int m = gw; m < M; m += NGW) {
                const float* xr = m < MP ? xp + (size_t)m * D : xs + (size_t)(m - MP) * D;
                f32x4 v[8]; float s = 0.f;
#pragma unroll
                for (int j = 0; j < 8; ++j) { v[j] = __builtin_nontemporal_load((const f32x4*)(xr + 4 * lane + 256 * j)); s += (v[j][0] * v[j][0] + v[j][1] * v[j][1]) + (v[j][2] * v[j][2] + v[j][3] * v[j][3]); }
                s = wave_sum(s);
#pragma unroll
                for (int j = 0; j < 8; ++j) { v2u w; w.x = pk2(v[j][0], v[j][1]); w.y = pk2(v[j][2], v[j][3]); *(v2u*)(A1 + (size_t)m * D + 4 * lane + 256 * j) = w;
                    if (m >= MP) *(f32x4*)(H + (size_t)m * D + 4 * lane + 256 * j) = v[j]; }
                if (lane < 32) ss[(size_t)m * 32 + lane] = lane == 0 ? s : 0.f;
            }
            const int gt = bid * NTHR + tid, NGT = G * NTHR;
            for (int idx = gt; idx < M * 8; idx += NGT) {
                const int m = idx >> 3, i = idx & 7;
                const int pos = m < MP ? m : 2048 + ((m - MP) & 31);
                const float inv = i == 0 ? 1.f : i == 1 ? 1.939227432e-01f : i == 2 ? 3.760603070e-02f : i == 3 ? 7.292664610e-03f : i == 4 ? 1.414213562e-03f : i == 5 ? 2.742481884e-04f : i == 6 ? 5.318295734e-05f : 1.031338525e-05f;
                const float ang = (float)pos * inv;
                const float th = ang * 1.591549367e-01f, te = __builtin_fmaf(ang, 1.591549367e-01f, -th) + ang * 6.420638243e-09f;
                const float fr_ = (th - __builtin_rintf(th)) + te;
                cs[2 * idx] = __builtin_amdgcn_cosf(fr_); cs[2 * idx + 1] = __builtin_amdgcn_sinf(fr_);
            }
            const float* ck = INP(2); const float* cv = INP(3);
            for (int idx = gt; idx < 16 * 128 * 256; idx += NGT) {
                const int b = idx >> 15, rem = idx & 32767, j = rem >> 8, c = rem & 255;
                const float kv = ck[idx], vv = cv[idx];
                Ksb[(size_t)b * 40960 + rem] = (bf16)f2bf(kv);
                Vts[((size_t)b * 256 + c) * 160 + j] = (bf16)f2bf(vv);
                if (j >= 32) { out[O_KS + ((size_t)b * 128 + j - 32) * 256 + c] = kv; out[O_VS + ((size_t)b * 128 + j - 32) * 256 + c] = vv; }
            }
        } else if (ph == 1 && PHEN(1)) {
            pg8::Gemm g{A1, (const bf16*)(ws + WS_W1), M, NIN_E, D}; pg8::StaticOrder S; S.init(M, NIN_E, G, bid);
            pg8::EpiInEven E{ss, cs, Qb, Kpb, Ksb, Vtp, Vts, Ub, GVr, out};
            pg8::gemm_phase<pg8::EpiInEven, pg8::StaticOrder, true, true>(lds3, g, S, E, tid);
        } else if (ph == 2 && PHEN(2)) {
            const int vb = (G & 7) == 0 ? (bid & 7) * (G >> 3) + (bid >> 3) : bid;
            for (int w_ = vb; w_ < 1216; w_ += G) {
                const int u = w_ < 512 ? w_ : w_ < 1024 ? w_ + 64 : w_ < 1088 ? w_ - 512 : w_;
                if (u < 576) {
                    bf16* Ks = (bf16*)lds; bf16* Vs = (bf16*)(lds + 27648);
                    const bf16* Kg; const bf16* Vg; int vstr, nkb;
                    if (u < 512) { const int c = u >> 2, kvh = u & 3, kc0 = c > 2 ? c - 2 : 0; nkb = (c - kc0 + 1) * 2;
                        Kg = Kpb + (size_t)(kc0 * 64) * 256 + kvh * 64; Vg = Vtp + (size_t)(kvh * 64) * 8192 + kc0 * 64; vstr = 8192; }
                    else { const int su = u - 512, b = su >> 2, kvh = su & 3; nkb = 5;
                        Kg = Ksb + (size_t)b * 40960 + kvh * 64; Vg = Vts + ((size_t)b * 256 + kvh * 64) * 160; vstr = 160; }
                    const int nkeys = nkb * 32, cpr = nkeys >> 3;
                    for (int p = tid; p < nkeys * 8; p += NTHR) { const int row = p >> 3, ch = p & 7; *(v4u*)(Ks + row * 72 + ch * 8) = *(const v4u*)(Kg + (size_t)row * 256 + ch * 8); }
                    for (int p = tid; p < 64 * cpr; p += NTHR) { const int dd = p / cpr, ch = p - dd * cpr; *(v4u*)(Vs + dd * 200 + ch * 8) = *(const v4u*)(Vg + (size_t)dd * vstr + ch * 8); }
                    __syncthreads();
                    if (u < 512) { const int c = u >> 2, kvh = u & 3, hq = kvh * 4 + (wave >> 1), tok0 = c * 64 + (wave & 1) * 32;
                        attn_wave(Qb + (size_t)tok0 * 1024 + hq * 64, Ks, 72, Vs, 200, nkb, INP(10)[hq], A2 + (size_t)tok0 * 2048 + hq * 64, lane);
                    } else if (wave < 4) { const int su = u - 512, b = su >> 2, kvh = su & 3, hq = kvh * 4 + wave;
                        attn_wave(Qb + (size_t)(MP + b * 32) * 1024 + hq * 64, Ks, 72, Vs, 200, nkb, INP(10)[hq], A2 + (size_t)(MP + b * 32) * 2048 + hq * 64, lane); }
                    __syncthreads();
                } else if (u < 1088) {
                    const int gu = u - 576;
                    gmlp_unit(lds, GVr, Ub, INP(11), INP(12), INP(13), A2, nullptr, (gu >> 3) * 128, 128, gu & 7, tid);
                } else {
                    const int gu = u - 1088, b = gu >> 3;
                    gmlp_unit(lds, GVr, Ub, INP(11), INP(12), INP(13), A2, out + O_GV + (size_t)b * 32 * 1024, MP + b * 32, 32, gu & 7, tid);
                }
            }
        } else if (ph == 3 && PHEN(3)) {
            pg8::Gemm g{A2, (const bf16*)(ws + WS_W2), M, D, D}; pg8::SplitOrder S; S.init(bid, D);
            pg8::EpiRes<true> E{xp, xs, H, A1, ss + SSN, (float*)(ws + WS_BIG)};
            pg8::gemm_phase<pg8::EpiRes<true>, pg8::SplitOrder, true, true>(lds3, g, S, E, tid);
        } else if ((ph == 4 || ph == 10) && PHEN(ph)) {
#ifdef DBG_HIDFILL
            { const int gt = bid * NTHR + tid, NGT = G * NTHR;
              for (size_t i = gt; i < (size_t)M * DFF / 2; i += NGT) { const unsigned a_ = (unsigned)((i * 37u) & 255u); ((unsigned*)HID)[i] = pk2((float)a_ * (1.f / 256.f), (float)(255u - a_) * (1.f / 512.f)); } }
            if (false)
#endif
            {
            pg8::Gemm g{A1, (const bf16*)(ws + (ph == 4 ? WS_WU0 : WS_WU1)), M, DFF, D}; pg8::StaticOrder S; S.init(M, DFF, G, bid);
            pg8::EpiUp E{ss + (ph == 4 ? SSN : 3 * SSN), HID};
            pg8::gemm_phase<pg8::EpiUp, pg8::StaticOrder, true, true>(lds3, g, S, E, tid);
            }
            if (bid >= 64) {
                if (ph == 4) CONV_RANGE(2046, 5120, bid - 64, 192); else CONV_RANGE(9498, 12572, bid - 64, 192);
            }
        } else if ((ph == 5 || ph == 9 || ph == 11) && PHEN(ph)) {
            const bf16* Aop = ph == 9 ? A2 : HID; const bf16* Bop = (const bf16*)(ws + (ph == 5 ? WS_WD0 : ph == 9 ? WS_W6 : WS_WD1));
            pg8::Gemm g{Aop, Bop, M, D, ph == 9 ? D : DFF}; pg8::SplitOrder S; S.init(bid, ph == 9 ? D : DFF);
#ifndef DBG_P5X
#define DBG_P5X false
#endif
            pg8::EpiRes<DBG_P5X> E{xp, xs, H, A1, ss + (ph == 5 ? 2 * SSN : ph == 9 ? 3 * SSN : 4 * SSN), (float*)(ws + (ph == 9 ? WS_BIG : WS_A2))};
            pg8::gemm_phase<pg8::EpiRes<DBG_P5X>, pg8::SplitOrder, true, true>(lds3, g, S, E, tid);
            if (bid >= 128) { if (ph == 5) CONV_RANGE(5120, 6156, bid - 128, 128); else if (ph == 9) CONV_RANGE(9230, 9498, bid - 128, 128); }
        } else if (ph == 6 && PHEN(6)) {
            pg8::Gemm g{A1, (const bf16*)(ws + WS_W5), M, DFF, D}; pg8::StaticOrder S; S.init(M, DFF, G, bid);
            pg8::EpiInOdd E{ss + 2 * SSN, INP(16), QH, FH, VH, GH};
            pg8::gemm_phase<pg8::EpiInOdd, pg8::StaticOrder, true, true>(lds3, g, S, E, tid);
            if (bid >= 64) CONV_RANGE(6156, 9230, bid - 64, 192);
        } else if (ph == 7 && PHEN(7)) {
            for (int u = bid; u < 240; u += G) { const int hd = u / 15, g = u % 15;
                hg_unit<false>(lds, QH, FH, VH, GH, INP(17), A2, hd, g * 512, 16, 0, nullptr, SEG, DEC, 0, SEG + (size_t)(hd * 16 + g) * 16384, DEC + (size_t)(hd * 16 + g) * 128, tid, DEC + 32768 + hd * 16 + g); }
        } else if (ph == 14 && PHEN(14)) {
            const int gt = bid * NTHR + tid, NGT = G * NTHR;
            for (int el = gt; el < 16 * 16384; el += NGT) {
                const int hd = el >> 14, de = el & 16383, dd = de >> 7;
                float L[15], Dg[15];
#pragma unroll
                for (int g = 0; g < 15; ++g) { L[g] = SEG[(size_t)(hd * 16 + g) * 16384 + de]; Dg[g] = DEC[(size_t)(hd * 16 + g) * 128 + dd]; }
                float acc = 0.f;
#pragma unroll
                for (int g = 0; g < 15; ++g) { acc = Dg[g] * acc + L[g]; SEG[(size_t)(hd * 16 + g) * 16384 + de] = acc; }
            }
        } else if (ph == 8 && PHEN(8)) {
            for (int u = bid; u < 512; u += G) {
                if (u < 256) { const int hd = u >> 4, g = u & 15;
                    hg_unit<true>(lds, QH, FH, VH, GH, INP(17), A2, hd, g * 512, 16, g ? 1 : 0, SEG + (size_t)(hd * 16 + (g ? g - 1 : 0)) * 16384, SEG, DEC, g, g == 15 ? out + O_SP + (size_t)hd * 16384 : nullptr, nullptr, tid);
                } else { const int su = u - 256, b = su >> 4, hd = su & 15;
                    hg_unit<true>(lds, QH, FH, VH, GH, INP(17), A2, hd, MP + b * 32, 1, 1, INP(4) + (size_t)(b * 16 + hd) * 16384, SEG, DEC, 0, out + O_SS + (size_t)(b * 16 + hd) * 16384, nullptr, tid); }
            }
        } else if (ph == 13 && PHEN(13)) {
            const int ssi = ++nfin;
            const float* part = (const float*)(ws + ((ssi & 1) == 0 ? WS_A2 : WS_BIG));
            const int gw = bid * NWAVES + wave, NGW = G * NWAVES;
            for (int it = gw; it < 512 * 4; it += NGW) {
                const int rs = it >> 2, qd = it & 3, m = MP + rs; const size_t co = (size_t)qd * 512 + 4 * lane;
                f32x4 h0 = *(const f32x4*)(H + (size_t)m * D + co), h1 = *(const f32x4*)(H + (size_t)m * D + co + 256);
#pragma unroll
                for (int sl = 0; sl < 8; ++sl) { const float* pp = part + ((size_t)sl * 512 + rs) * D + co; h0 += __builtin_nontemporal_load((const f32x4*)pp); h1 += __builtin_nontemporal_load((const f32x4*)(pp + 256)); }
                *(f32x4*)(H + (size_t)m * D + co) = h0; *(f32x4*)(H + (size_t)m * D + co + 256) = h1;
                v2u w; w.x = pk2(h0[0], h0[1]); w.y = pk2(h0[2], h0[3]); *(v2u*)(A1 + (size_t)m * D + co) = w;
                w.x = pk2(h1[0], h1[1]); w.y = pk2(h1[2], h1[3]); *(v2u*)(A1 + (size_t)m * D + co + 256) = w;
                float sq = ((h0[0] * h0[0] + h0[1] * h0[1]) + (h0[2] * h0[2] + h0[3] * h0[3])) + ((h1[0] * h1[0] + h1[1] * h1[1]) + (h1[2] * h1[2] + h1[3] * h1[3]));
                sq = wave_sum(sq);
                if (lane < 8) ss[(size_t)ssi * SSN + (size_t)m * 32 + qd * 8 + lane] = lane == 0 ? sq : 0.f;
            }
        } else if (ph == 12 && PHEN(12)) {
            const int gw = bid * NWAVES + wave, NGW = G * NWAVES;
            for (int m = gw; m < M; m += NGW) {
                f32x4 hv[8]; float sq = 0.f;
#ifdef DBG_DUMPQH
#pragma unroll
                for (int j = 0; j < 8; ++j) *(f32x4*)(out + (size_t)m * D + 4 * lane + 256 * j) = *(const f32x4*)(DBG_DUMPQH + (size_t)m * D + 4 * lane + 256 * j);
                continue;
#endif
#ifdef DBG_DUMPA2
                if (DBG_DUMPA2 == 2 && (m >= MP || (m & 511) < 64)) continue;
                if (DBG_DUMPA2 == 3 && m < MP) continue;
#pragma unroll
                for (int j = 0; j < 8; ++j) { const v2u w = *(const v2u*)(DBG_A2PTR + (size_t)m * D + 4 * lane + 256 * j);
                    *(f32x4*)(out + (size_t)m * D + 4 * lane + 256 * j) = (f32x4){bf2f((unsigned short)(w.x & 0xffff)), bf2f((unsigned short)(w.x >> 16)), bf2f((unsigned short)(w.y & 0xffff)), bf2f((unsigned short)(w.y >> 16))}; }
                continue;
#endif
#pragma unroll
                for (int j = 0; j < 8; ++j) { hv[j] = __builtin_nontemporal_load((const f32x4*)(H + (size_t)m * D + 4 * lane + 256 * j));
                    if (m >= MP) {
#pragma unroll
                        for (int sl = 0; sl < 8; ++sl) hv[j] += __builtin_nontemporal_load((const f32x4*)((const float*)(ws + WS_A2) + ((size_t)sl * 512 + (m - MP)) * D + 4 * lane + 256 * j)); } sq += (hv[j][0] * hv[j][0] + hv[j][1] * hv[j][1]) + (hv[j][2] * hv[j][2] + hv[j][3] * hv[j][3]); }
                const float rstd = rsqrtf(wave_sum(sq) * (1.f / 2048.f) + 1e-6f);
#pragma unroll
                for (int j = 0; j < 8; ++j) { const f32x4 gn = *(const f32x4*)(INP(7) + 4 * lane + 256 * j);
                    __builtin_nontemporal_store(hv[j] * rstd * gn, (f32x4*)(out + (size_t)m * D + 4 * lane + 256 * j)); }
            }
        }
        if (st + 1 < a.ph_hi) { if (a.ph_lo < 0) grid.sync(); else xcd_barrier(xbar); }
    }
#ifdef EXTRA_SYNC
    for (int i = 0; i < EXTRA_SYNC; ++i) xcd_barrier(xbar);
#endif
}

#undef xp
#undef xs
#undef ss
#undef cs
#undef A1
#undef A2
#undef H
#undef HID
#undef Qb
#undef Kpb
#undef Ksb
#undef Vtp
#undef Vts
#undef Ub
#undef GVr
#undef QH
#undef FH
#undef VH
#undef GH
#undef SEG
#undef DEC
#undef CONV_L1
#undef CONV_RANGE
extern "C" void kernel_launch(void* const* d_in, const int* in_sizes, int n_in, void* d_out, int out_size, void* d_ws, size_t ws_size, hipStream_t stream) {
    static int grid = 0;
    if (grid == 0) {
        if (n_in != 20 || ws_size < WS_END) { fprintf(stderr, "kernel_launch: unexpected n_in %d / ws %zu\n", n_in, ws_size); grid = -1; return; }
        int dev = 0, cus = 0, per_cu = 0;
        (void)hipGetDevice(&dev); (void)hipDeviceGetAttribute(&cus, hipDeviceAttributeMultiprocessorCount, dev);
        if (hipFuncSetAttribute((const void*)mk_fwd, hipFuncAttributeMaxDynamicSharedMemorySize, LDS_BYTES) != hipSuccess) { fprintf(stderr, "kernel_launch: hipFuncSetAttribute failed\n"); grid = -1; return; }
        if (hipOccupancyMaxActiveBlocksPerMultiprocessor(&per_cu, (const void*)mk_fwd, NTHR, LDS_BYTES) != hipSuccess || per_cu < 1) { fprintf(stderr, "kernel_launch: occupancy query says %d\n", per_cu); per_cu = 1; }
        (void)hipGetLastError();
        grid = cus * 1;
        if (grid <= 0) grid = 256;
    }
    if (grid < 0) return;
    (void)hipMemsetAsync(d_ws, 0, 65536, stream);
    Args a{};
    for (int i = 0; i < 20; ++i) a.in[i] = (const float*)d_in[i];
    a.out = (float*)d_out; a.ws = (unsigned char*)d_ws;
#ifdef DBG_FILL
    (void)hipMemsetAsync(d_out, 0, (size_t)23920640 * 4, stream);
#endif
#if MK_PER_PHASE
    for (int ph = 0; ph < NPH; ++ph) { a.ph_lo = ph; a.ph_hi = ph + 1; hipLaunchKernelGGL(mk_fwd, dim3(grid), dim3(NTHR), LDS_BYTES, stream, a); }
#else
    a.ph_lo = 0; a.ph_hi = SEQ_N;
    void* args[] = {&a};
    hipError_t e = hipLaunchCooperativeKernel((const void*)mk_fwd, dim3(grid), dim3(NTHR), args, LDS_BYTES, stream);
    if (e != hipSuccess) fprintf(stderr, "cooperative launch failed: %s (grid %d)\n", hipGetErrorString(e), grid);
#endif
}
```

```cpp
#include <hip/hip_runtime.h>
#include <hip/hip_cooperative_groups.h>
#include <cstdio>
#include <cstdint>
namespace cg = cooperative_groups;
namespace pg8 {
#define PG8_LAS __attribute__((address_space(3)))
typedef unsigned short bf16_t;
typedef short bf16x8 __attribute__((ext_vector_type(8)));
typedef float f32x4 __attribute__((ext_vector_type(4)));
typedef unsigned u32x4 __attribute__((ext_vector_type(4)));
constexpr int BM = 256, BK = 64, HALF = 128, HTB = HALF * BK * 2  , STAGE_BYTES = 8 * HTB, NXCD = 8, WGM = 8;

__host__ __device__ __forceinline__ int lds_byte(int r, int c) { const int st = (r >> 4) * 2 + (c >> 5), rr = r & 15, cc = c & 31, ob = rr * 64 + cc * 2; return st * 1024 + (ob ^ (((ob >> 9) & 1) << 5)); }
__host__ __device__ __forceinline__ void stage_rc(int b, int& R, int& C) { const int st = b / 1024, sb = b % 1024, swz = sb ^ (((sb >> 9) & 1) << 5); R = (st >> 1) * 16 + swz / 64; C = (st & 1) * 32 + (swz % 64) / 2; }
__host__ __device__ __forceinline__ int perm32(int rho) { const int n = rho >> 4, i = rho & 15; return 8 * (i >> 2) + 4 * n + (i & 3); }

struct Unit { int pm, pn, k0, nt, part; };
struct Gemm { const bf16_t* A; const bf16_t* Bt; int M, N, K; };

struct StaticOrder {
    int nM, nN, nwg, G, c, ntk;
    __host__ __device__ void init(int M, int N, int G_, int c_, int K_ = 2048) { nM = M / BM; nN = N / BM; nwg = nM * nN; G = G_; c = c_; ntk = K_ / BK; }
    __host__ __device__ bool next(int i, Unit& u) const {
        const long L = (long)i * G + c; if (L >= nwg) return false;
        int wgid = (int)L; { const int q = nwg / NXCD, r = nwg % NXCD, xcd = wgid % NXCD, off = wgid / NXCD; wgid = (xcd < r ? xcd * (q + 1) : r * (q + 1) + (xcd - r) * q) + off; }
        const int nig = WGM * nN, gid = wgid / nig, fm = gid * WGM, gsz = (nM - fm) < WGM ? (nM - fm) : WGM;
        u.pm = fm + ((wgid % nig) % gsz); u.pn = (wgid % nig) / gsz; u.k0 = 0; u.nt = ntk; u.part = 0; return true;
    }
    __device__ __forceinline__ void a_ready(const Unit&) const {}
    __device__ __forceinline__ void done(const Unit&) const {}
};
struct SplitOrder {
    int c, ntk, nsl;
    __host__ __device__ void init(int c_, int K_) { c = c_; ntk = K_ / BK; nsl = 8; }
    __host__ __device__ bool next(int i, Unit& u) const {
        if (i == 0) { const int wgid = (c % 8) * 32 + c / 8, w = wgid % 64; u.pm = (wgid / 64) * 8 + (w % 8); u.pn = w / 8; u.k0 = 0; u.nt = ntk; u.part = 0; return true; }
        if (i == 1 && c < 16 * nsl) { const int ts = c / nsl, sl = c % nsl; u.pm = 32 + (ts >> 3); u.pn = ts & 7; u.nt = ntk / nsl; u.k0 = sl * u.nt; u.part = 1 + sl; return true; }
        return false;
    }
    __device__ __forceinline__ void a_ready(const Unit&) const {}
    __device__ __forceinline__ void done(const Unit&) const {}
};

typedef float f32x2c_t __attribute__((ext_vector_type(2))); typedef __bf16 bf16x2c_t __attribute__((ext_vector_type(2)));
__device__ __forceinline__ unsigned cvt_pk_bf16(float lo, float hi) { const f32x2c_t v = {lo, hi}; const bf16x2c_t b = __builtin_convertvector(v, bf16x2c_t); return __builtin_bit_cast(unsigned, b); }
typedef float f32x2 __attribute__((ext_vector_type(2)));
typedef unsigned u32x2 __attribute__((ext_vector_type(2)));
constexpr int O_YP = 0, O_YS = 16777216, O_KP = 17825792, O_VP = 17858560, O_KS = 17891328, O_VS = 18415616, O_GV = 18939904, O_SP = 19464192, O_SS = 19726336;
constexpr int MROWS = 8704, MPR = 8192, DM = 2048;
__device__ __forceinline__ unsigned short f2bf1(float f) { unsigned u = __builtin_bit_cast(unsigned, f); return (unsigned short)((u + 0x7fffu + ((u >> 16) & 1u)) >> 16); }
__device__ __forceinline__ float gelu_tanh(float x) {
    const float uu = 0.7978845608028654f * (x + 0.044715f * x * x * x);
    const float e = __expf(2.f * uu);
    const float t = 1.f - 2.f * __builtin_amdgcn_rcpf(e + 1.f);
    return 0.5f * x * (1.f + t);
}
__device__ __forceinline__ float sigm(float x) { return __builtin_amdgcn_rcpf(1.f + __expf(-x)); }

__device__ __forceinline__ float xsum16(float s) { const auto r = __builtin_amdgcn_permlane16_swap(__builtin_bit_cast(unsigned, s), __builtin_bit_cast(unsigned, s), false, false); return __builtin_bit_cast(float, r[0]) + __builtin_bit_cast(float, r[1]); }
__device__ __forceinline__ float xsum32(float s) { const auto r = __builtin_amdgcn_permlane32_swap(__builtin_bit_cast(unsigned, s), __builtin_bit_cast(unsigned, s), false, false); return __builtin_bit_cast(float, r[0]) + __builtin_bit_cast(float, r[1]); }
__device__ __forceinline__ float xpart32(float v, bool upper) { const auto r = __builtin_amdgcn_permlane32_swap(__builtin_bit_cast(unsigned, v), __builtin_bit_cast(unsigned, v), false, false); return __builtin_bit_cast(float, upper ? r[0] : r[1]); }
__device__ __forceinline__ float row_rstd(const float* ssp, int row, int fq) {
    const float* p = ssp + (size_t)row * 32 + fq * 8;
    const f32x4 a = *(const f32x4*)p, b = *(const f32x4*)(p + 4);
    float t = ((a[0] + a[1]) + (a[2] + a[3])) + ((b[0] + b[1]) + (b[2] + b[3]));
    t += __shfl_xor(t, 16); t += __shfl_xor(t, 32);
    return rsqrtf(t * (1.f / 2048.f) + 1e-6f);
}
struct EpiInEven {
    static constexpr bool PERM = false, AFTER_DRAIN = false;
    const float* ss; const float* cs; bf16_t *Q, *Kp, *Ks, *Vtp, *Vts, *U; float* GVr; float* out;
    template <int KIND> __device__ __forceinline__ void body(const f32x4 (&acc)[2][2][4][2], const Unit& u, int wr, int wc, int fr, int fq) const {
        const int pn = u.pn;
        const float* ssk = ss; int frk = fr; asm volatile("" : "+v"(frk), "+v"(fq)); asm volatile("" : "+s"(wc), "+s"(wr));
        float rs8[8];
#pragma unroll
        for (int q = 0; q < 8; ++q) rs8[q] = row_rstd(ssk, u.pm * BM + (q >> 2) * HALF + wr * 64 + (q & 3) * 16 + frk, fq);
#pragma unroll
        for (int ai = 0; ai < 2; ++ai)
#pragma unroll
            for (int m = 0; m < 4; ++m) {
                const int row = u.pm * BM + ai * HALF + wr * 64 + m * 16 + frk;
                const float rstd = rs8[ai * 4 + m];
                const bool smp = row >= MPR; const int sb = (row - MPR) >> 5, st = (row - MPR) & 31;
#pragma unroll
                for (int bj = 0; bj < 2; ++bj)
#pragma unroll
                    for (int n = 0; n < 2; ++n) {
                        f32x4 v = acc[ai][bj][m][n] * rstd;
                        const int cl = bj * HALF + wc * 32 + n * 16 + fq * 4;
                        if (KIND <= 1) {
                            if (n == 0 && (wc & 1) == 0) {
                                f32x4 p; p[0] = __shfl_xor(v[0], 32); p[1] = __shfl_xor(v[1], 32); p[2] = __shfl_xor(v[2], 32); p[3] = __shfl_xor(v[3], 32);
                                const f32x4 c0 = *(const f32x4*)(cs + (size_t)row * 16 + (fq & 1) * 8), c1 = *(const f32x4*)(cs + (size_t)row * 16 + (fq & 1) * 8 + 4);
                                const float sg = (fq < 2) ? -1.f : 1.f;
                                v[0] = v[0] * c0[0] + sg * p[0] * c0[1]; v[1] = v[1] * c0[2] + sg * p[1] * c0[3];
                                v[2] = v[2] * c1[0] + sg * p[2] * c1[1]; v[3] = v[3] * c1[2] + sg * p[3] * c1[3];
                            }
                            if (KIND == 0) {
                                v = v * 0.125f; u32x2 w; w.x = cvt_pk_bf16(v[0], v[1]); w.y = cvt_pk_bf16(v[2], v[3]);
                                *(u32x2*)(Q + (size_t)row * 1024 + pn * 256 + cl) = w;
                            } else {
                                u32x2 w; w.x = cvt_pk_bf16(v[0], v[1]); w.y = cvt_pk_bf16(v[2], v[3]);
                                if (smp) { *(u32x2*)(Ks + ((size_t)(sb * 160 + 128 + st)) * 256 + cl) = w; *(f32x4*)(out + O_KS + ((size_t)(sb * 128 + 96 + st)) * 256 + cl) = v; }
                                else { *(u32x2*)(Kp + (size_t)row * 256 + cl) = w; if (row >= MPR - 128) *(f32x4*)(out + O_KP + (size_t)(row - (MPR - 128)) * 256 + cl) = v; }
                            }
                        } else if (KIND == 2) {
                            if (smp) { *(f32x4*)(out + O_VS + ((size_t)(sb * 128 + 96 + st)) * 256 + cl) = v;
#pragma unroll
                                for (int j = 0; j < 4; ++j) Vts[((size_t)(sb * 256 + cl + j)) * 160 + 128 + st] = f2bf1(v[j]); }
                            else { if (row >= MPR - 128) *(f32x4*)(out + O_VP + (size_t)(row - (MPR - 128)) * 256 + cl) = v;
#pragma unroll
                                for (int j = 0; j < 4; ++j) Vtp[(size_t)(cl + j) * MPR + row] = f2bf1(v[j]); }
                        } else if (KIND == 3) {
                            u32x2 w; w.x = cvt_pk_bf16(gelu_tanh(v[0]), gelu_tanh(v[1])); w.y = cvt_pk_bf16(gelu_tanh(v[2]), gelu_tanh(v[3]));
                            *(u32x2*)(U + (size_t)row * 1024 + (pn - 6) * 256 + cl) = w;
                        } else {
                            f32x4 g; g[0] = gelu_tanh(v[0]); g[1] = gelu_tanh(v[1]); g[2] = gelu_tanh(v[2]); g[3] = gelu_tanh(v[3]);
                            *(f32x4*)(GVr + (size_t)row * 1024 + (pn - 10) * 256 + cl) = g;
                        }
                        asm volatile("" ::: "memory");
                    }
            }
    }
    __device__ __forceinline__ void operator()(const f32x4 (&acc)[2][2][4][2], const Unit& u, int wr, int wc, int fr, int fq) const {
        const int pn = u.pn;
        if (pn < 4) body<0>(acc, u, wr, wc, fr, fq);
        else if (pn == 4) body<1>(acc, u, wr, wc, fr, fq);
        else if (pn == 5) body<2>(acc, u, wr, wc, fr, fq);
        else if (pn < 10) body<3>(acc, u, wr, wc, fr, fq);
        else body<4>(acc, u, wr, wc, fr, fq);
    }
};
template <bool FROMX> struct EpiRes {
    static constexpr bool PERM = false, AFTER_DRAIN = false;
    const float* xp; const float* xs; float* H; bf16_t* Hb; float* ssout; float* part;
    __device__ __forceinline__ void operator()(const f32x4 (&acc)[2][2][4][2], const Unit& u, int wr, int wc, int fr, int fq) const {
        asm volatile("" : "+v"(fr), "+v"(fq), "+s"(wc), "+s"(wr));
        if (u.part) {
#pragma unroll
            for (int ai = 0; ai < 2; ++ai)
#pragma unroll
                for (int m = 0; m < 4; ++m) {
                    float* hp = part + ((size_t)(u.part - 1) * 512 + (size_t)((u.pm - 32) * BM + ai * HALF + wr * 64 + m * 16 + fr)) * DM + u.pn * BM + wc * 32 + fq * 4;
#pragma unroll
                    for (int bj = 0; bj < 2; ++bj)
#pragma unroll
                        for (int n = 0; n < 2; ++n) *(f32x4*)(hp + bj * HALF + n * 16) = acc[ai][bj][m][n];
                    asm volatile("" ::: "memory");
                }
            return;
        }
        const int colb = u.pn * BM + wc * 32 + fq * 4;
        f32x4 bcur[4], bnxt[4];
        { const int row = u.pm * BM + wr * 64 + fr; const float* base = FROMX ? (row < MPR ? xp + (size_t)row * DM : xs + (size_t)(row - MPR) * DM) : H + (size_t)row * DM;
#pragma unroll
          for (int p = 0; p < 4; ++p) bcur[p] = *(const f32x4*)(base + colb + (p >> 1) * HALF + (p & 1) * 16); }
#pragma unroll
        for (int q = 0; q < 8; ++q) {
            const int ai = q >> 2, m = q & 3;
            const int row = u.pm * BM + ai * HALF + wr * 64 + m * 16 + fr;
            if (q < 7) { const int rown = u.pm * BM + ((q + 1) >> 2) * HALF + wr * 64 + ((q + 1) & 3) * 16 + fr;
                const float* basen = FROMX ? (rown < MPR ? xp + (size_t)rown * DM : xs + (size_t)(rown - MPR) * DM) : H + (size_t)rown * DM;
#pragma unroll
                for (int p = 0; p < 4; ++p) bnxt[p] = *(const f32x4*)(basen + colb + (p >> 1) * HALF + (p & 1) * 16); }
            float s = 0.f;
#pragma unroll
            for (int p = 0; p < 4; ++p) {
                const int bj = p >> 1, n = p & 1, col = colb + bj * HALF + n * 16;
                const f32x4 h = bcur[p] + acc[ai][bj][m][n];
                *(f32x4*)(H + (size_t)row * DM + col) = h;
                u32x2 w; w.x = cvt_pk_bf16(h[0], h[1]); w.y = cvt_pk_bf16(h[2], h[3]);
                *(u32x2*)(Hb + (size_t)row * DM + col) = w;
                s += (h[0] * h[0] + h[1] * h[1]) + (h[2] * h[2] + h[3] * h[3]);
            }
            s += __shfl_xor(s, 16); s += __shfl_xor(s, 32);
            if (fq == 0) ssout[(size_t)row * 32 + u.pn * 4 + wc] = s;
#pragma unroll
            for (int p = 0; p < 4; ++p) bcur[p] = bnxt[p];
        }
    }
};
struct EpiUp {
    static constexpr bool PERM = true, AFTER_DRAIN = false;
    const float* ss; bf16_t* HID;
    __device__ __forceinline__ void operator()(const f32x4 (&acc)[2][2][4][2], const Unit& u, int wr, int wc, int fr, int fq) const {
        asm volatile("" : "+v"(fr), "+v"(fq), "+s"(wc), "+s"(wr));
        float rs8[8];
#pragma unroll
        for (int q = 0; q < 8; ++q) rs8[q] = row_rstd(ss, u.pm * BM + (q >> 2) * HALF + wr * 64 + (q & 3) * 16 + fr, fq);
#pragma unroll
        for (int ai = 0; ai < 2; ++ai)
#pragma unroll
            for (int m = 0; m < 4; ++m) {
                const int row = u.pm * BM + ai * HALF + wr * 64 + m * 16 + fr;
                const float rstd = rs8[ai * 4 + m];
                bf16_t* rowp = HID + (size_t)row * 8192 + u.pn * BM + wc * 32 + 8 * fq;
#pragma unroll
                for (int bj = 0; bj < 2; ++bj) {
                    f32x4 v0 = acc[ai][bj][m][0] * rstd, v1 = acc[ai][bj][m][1] * rstd;
#pragma unroll
                    for (int j = 0; j < 4; ++j) { const float a = fmaxf(v0[j], 0.f), b = fmaxf(v1[j], 0.f); v0[j] = a * a; v1[j] = b * b; }
                    u32x4 w; w.x = cvt_pk_bf16(v0[0], v0[1]); w.y = cvt_pk_bf16(v0[2], v0[3]); w.z = cvt_pk_bf16(v1[0], v1[1]); w.w = cvt_pk_bf16(v1[2], v1[3]);
                    *(u32x4*)(rowp + bj * HALF) = w;
                }
            }
    }
};
struct EpiInOdd {
    static constexpr bool PERM = true, AFTER_DRAIN = false;
    const float* ss; const float* lbw; float* QH; float* FH; bf16_t* VH; bf16_t* GH;
    __device__ __forceinline__ void operator()(const f32x4 (&acc)[2][2][4][2], const Unit& u, int wr, int wc, int fr, int fq) const {
        const int sec = u.pn >> 3, pnl = u.pn & 7;
        asm volatile("" : "+v"(fr), "+v"(fq), "+s"(wc), "+s"(wr));
        float rs8[8];
#pragma unroll
        for (int q = 0; q < 8; ++q) rs8[q] = row_rstd(ss, u.pm * BM + (q >> 2) * HALF + wr * 64 + (q & 3) * 16 + fr, fq);
#pragma unroll
        for (int ai = 0; ai < 2; ++ai)
#pragma unroll
            for (int m = 0; m < 4; ++m) {
                const int row = u.pm * BM + ai * HALF + wr * 64 + m * 16 + fr;
                const float rstd = rs8[ai * 4 + m];
#pragma unroll
                for (int bj = 0; bj < 2; ++bj) {
                    f32x4 v0 = acc[ai][bj][m][0] * rstd, v1 = acc[ai][bj][m][1] * rstd;
                    const int col = pnl * BM + bj * HALF + wc * 32 + fq * 8;
                    if (sec == 0) {
#pragma unroll
                        for (int j = 0; j < 4; ++j) { v0[j] = v0[j] * sigm(v0[j]); v1[j] = v1[j] * sigm(v1[j]); }
                        *(f32x4*)(QH + (size_t)row * DM + col) = v0; *(f32x4*)(QH + (size_t)row * DM + col + 4) = v1;
                    } else if (sec == 1) {
                        const f32x4 l0a = *(const f32x4*)(lbw + col), l0b = *(const f32x4*)(lbw + col + 4), l1a = *(const f32x4*)(lbw + DM + col), l1b = *(const f32x4*)(lbw + DM + col + 4);
#pragma unroll
                        for (int j = 0; j < 4; ++j) { const float la = sigm(l1a[j] - l0a[j]), lb2 = sigm(l1b[j] - l0b[j]); v0[j] = la + (1.f - la) * sigm(v0[j]); v1[j] = lb2 + (1.f - lb2) * sigm(v1[j]); }
                        *(f32x4*)(FH + (size_t)row * DM + col) = v0; *(f32x4*)(FH + (size_t)row * DM + col + 4) = v1;
                    } else if (sec == 2) {
                        u32x4 w; w.x = cvt_pk_bf16(v0[0], v0[1]); w.y = cvt_pk_bf16(v0[2], v0[3]); w.z = cvt_pk_bf16(v1[0], v1[1]); w.w = cvt_pk_bf16(v1[2], v1[3]);
                        *(u32x4*)(VH + (size_t)row * DM + col) = w;
                    } else {
                        u32x4 w; w.x = cvt_pk_bf16(sigm(v0[0]), sigm(v0[1])); w.y = cvt_pk_bf16(sigm(v0[2]), sigm(v0[3])); w.z = cvt_pk_bf16(sigm(v1[0]), sigm(v1[1])); w.w = cvt_pk_bf16(sigm(v1[2]), sigm(v1[3]));
                        *(u32x4*)(GH + (size_t)row * DM + col) = w;
                    }
                }
            }
    }
};
template <class Epi, class Sched, bool ALIGN_EPI = false, bool SP2 = false>
__device__ __forceinline__ void gemm_phase(PG8_LAS unsigned char* lds, const Gemm g, const Sched& S, const Epi& E, const int tid) {
    const int wid = __builtin_amdgcn_readfirstlane(tid >> 6), lane = tid & 63, wr = wid >> 2, wc = wid & 3, fr = lane & 15, fq = lane >> 4;
    const int K = g.K;
    unsigned voffA[2], voffB[2];
#pragma unroll
    for (int i = 0; i < 2; ++i) { int R, C; stage_rc(tid * 16 + i * 8192, R, C); const int Rb = Epi::PERM ? ((R & ~31) + perm32(R & 31)) : R;
        voffA[i] = (unsigned)(R * K + C) * 2u; voffB[i] = (unsigned)(Rb * K + C) * 2u; }
    const size_t kstep = (size_t)(BK * 2);
    const size_t hstep = (size_t)HALF * K * 2;
    const size_t tstep = 2 * hstep;
    const unsigned ldsw = (unsigned)wid * 1024u;
    const int aoff = lds_byte(wr * 64 + fr, fq * 8), boff = lds_byte(wc * 32 + fr, fq * 8);
#define PG8_SA(b, h) (((b) * 2 + (h)) * HTB)
#define PG8_SB(b, h) ((4 + (b) * 2 + (h)) * HTB)
#define PG8_STAGE(bufoff, gbase, voff) do { _Pragma("unroll") for (int _i = 0; _i < 2; ++_i) \
        __builtin_amdgcn_global_load_lds((const unsigned*)((const char*)(gbase) + (voff)[_i]), (PG8_LAS unsigned*)(lds + (bufoff) + ldsw + _i * 8192), 16, 0, 0); } while (0)
#define PG8_LDA(dst, b, h) do { _Pragma("unroll") for (int m = 0; m < 4; ++m) _Pragma("unroll") for (int k = 0; k < 2; ++k) dst[m][k] = *(const PG8_LAS bf16x8*)(lds + PG8_SA(b, h) + aoff + m * 2048 + k * 1024); } while (0)
#define PG8_LDB(dst, b, h) do { _Pragma("unroll") for (int n = 0; n < 2; ++n) _Pragma("unroll") for (int k = 0; k < 2; ++k) dst[n][k] = *(const PG8_LAS bf16x8*)(lds + PG8_SB(b, h) + boff + n * 2048 + k * 1024); } while (0)
#define PG8_MMA(ai, bj, At, Bt) do { __builtin_amdgcn_s_setprio(1); _Pragma("unroll") for (int m = 0; m < 4; ++m) _Pragma("unroll") for (int n = 0; n < 2; ++n) _Pragma("unroll") for (int k = 0; k < 2; ++k) \
        acc[ai][bj][m][n] = __builtin_amdgcn_mfma_f32_16x16x32_bf16(Bt[n][k], At[m][k], acc[ai][bj][m][n], 0, 0, 0); __builtin_amdgcn_s_setprio(0); } while (0)
#define PG8_WAIT_V(n) asm volatile("s_waitcnt vmcnt(" #n ")" ::: "memory")
#define PG8_WAIT_L(n) asm volatile("s_waitcnt lgkmcnt(" #n ")" ::: "memory")
#define PG8_BAR __builtin_amdgcn_s_barrier()
#define PG8_SCHED __builtin_amdgcn_sched_barrier(0)
    Unit cur, nxt; int ui = 0;
    if (!S.next(0, cur)) return;
    f32x4 acc[2][2][4][2];
#pragma unroll
    for (int a = 0; a < 2; ++a)
#pragma unroll
        for (int b = 0; b < 2; ++b)
#pragma unroll
            for (int m = 0; m < 4; ++m)
#pragma unroll
                for (int n = 0; n < 2; ++n) acc[a][b][m][n] = (f32x4){0.f, 0.f, 0.f, 0.f};
    bf16x8 At[4][2], B0[2][2], B1[2][2];
    const char* cA = (const char*)g.A + (size_t)cur.pm * tstep + (size_t)cur.k0 * kstep; const char* cB = (const char*)g.Bt + (size_t)cur.pn * tstep + (size_t)cur.k0 * kstep;
    S.a_ready(cur);
    if constexpr (SP2) {
        PG8_STAGE(PG8_SB(0, 0), cB, voffB); PG8_STAGE(PG8_SB(0, 1), cB + hstep, voffB); PG8_STAGE(PG8_SA(0, 0), cA, voffA); PG8_STAGE(PG8_SA(0, 1), cA + hstep, voffA);
        if (wr == 1) PG8_BAR;
        PG8_WAIT_V(2); PG8_BAR;
        PG8_STAGE(PG8_SB(1, 0), cB + kstep, voffB); PG8_STAGE(PG8_SA(1, 0), cA + kstep, voffA); PG8_STAGE(PG8_SB(1, 1), cB + hstep + kstep, voffB);
        PG8_WAIT_V(6); PG8_BAR;
    } else {
        PG8_STAGE(PG8_SB(0, 0), cB, voffB); PG8_STAGE(PG8_SA(0, 0), cA, voffA); PG8_STAGE(PG8_SB(0, 1), cB + hstep, voffB); PG8_STAGE(PG8_SA(0, 1), cA + hstep, voffA);
        if (wr == 1) PG8_BAR;
        PG8_WAIT_V(4); PG8_BAR;
        PG8_STAGE(PG8_SB(1, 0), cB + kstep, voffB); PG8_STAGE(PG8_SA(1, 0), cA + kstep, voffA); PG8_STAGE(PG8_SB(1, 1), cB + hstep + kstep, voffB);
        PG8_WAIT_V(6); PG8_BAR;
    }
    for (;;) {
        const bool has_next = S.next(ui + 1, nxt);
        const char* nA = has_next ? (const char*)g.A + (size_t)nxt.pm * tstep + (size_t)nxt.k0 * kstep : cA; const char* nB = has_next ? (const char*)g.Bt + (size_t)nxt.pn * tstep + (size_t)nxt.k0 * kstep : cB;
        const int nt = cur.nt;
        for (int t = 0; t < nt; t += 2) {
            const bool last = (t == nt - 2);
            const char* a1 = cA + (size_t)(t + 1) * kstep;
            const char* a2 = last ? nA : cA + (size_t)(t + 2) * kstep; const char* b2 = last ? nB : cB + (size_t)(t + 2) * kstep;
            const char* a3 = a2 + kstep; const char* b3 = b2 + kstep;
            if (last && has_next) S.a_ready(nxt);
            if constexpr (SP2) {
            PG8_LDB(B0, 0, 0); PG8_LDB(B1, 0, 1); PG8_SCHED; PG8_LDA(At, 0, 0); PG8_STAGE(PG8_SA(1, 1), a1 + hstep, voffA);
            PG8_WAIT_V(8); PG8_WAIT_L(0); PG8_BAR; PG8_MMA(0, 0, At, B0); PG8_MMA(0, 1, At, B1); PG8_BAR; PG8_SCHED;
            PG8_LDA(At, 0, 1); PG8_STAGE(PG8_SB(0, 0), b2, voffB); PG8_STAGE(PG8_SB(0, 1), b2 + hstep, voffB); PG8_STAGE(PG8_SA(0, 0), a2, voffA);
            PG8_WAIT_V(8); PG8_WAIT_L(0); PG8_BAR; PG8_MMA(1, 0, At, B0); PG8_MMA(1, 1, At, B1); PG8_BAR; PG8_SCHED;
            PG8_LDB(B0, 1, 0); PG8_LDB(B1, 1, 1); PG8_SCHED; PG8_LDA(At, 1, 0); PG8_STAGE(PG8_SA(0, 1), a2 + hstep, voffA);
            PG8_WAIT_V(8); PG8_WAIT_L(0); PG8_BAR; PG8_MMA(0, 0, At, B0); PG8_MMA(0, 1, At, B1); PG8_BAR; PG8_SCHED;
            PG8_LDA(At, 1, 1); PG8_STAGE(PG8_SB(1, 0), b3, voffB); PG8_STAGE(PG8_SB(1, 1), b3 + hstep, voffB); PG8_STAGE(PG8_SA(1, 0), a3, voffA);
            PG8_WAIT_V(8); PG8_WAIT_L(0); PG8_BAR; PG8_MMA(1, 0, At, B0); PG8_MMA(1, 1, At, B1); PG8_BAR; PG8_SCHED;
            } else {
            PG8_LDB(B0, 0, 0); PG8_SCHED; PG8_LDA(At, 0, 0); PG8_STAGE(PG8_SA(1, 1), a1 + hstep, voffA);
            PG8_WAIT_L(8); PG8_BAR; PG8_WAIT_L(0); PG8_MMA(0, 0, At, B0); PG8_BAR; PG8_SCHED;
            PG8_LDB(B1, 0, 1); PG8_STAGE(PG8_SB(0, 0), b2, voffB);
            PG8_BAR; PG8_WAIT_L(0); PG8_MMA(0, 1, At, B1); PG8_BAR;
            PG8_LDA(At, 0, 1); PG8_STAGE(PG8_SA(0, 0), a2, voffA);
            PG8_BAR; PG8_WAIT_L(0); PG8_MMA(1, 0, At, B0); PG8_BAR; PG8_SCHED;
            PG8_STAGE(PG8_SB(0, 1), b2 + hstep, voffB);
            PG8_WAIT_V(6); PG8_BAR; PG8_MMA(1, 1, At, B1); PG8_BAR;
            PG8_LDB(B0, 1, 0); PG8_SCHED; PG8_LDA(At, 1, 0); PG8_STAGE(PG8_SA(0, 1), a2 + hstep, voffA);
            PG8_WAIT_L(8); PG8_BAR; PG8_WAIT_L(0); PG8_MMA(0, 0, At, B0); PG8_BAR; PG8_SCHED;
            PG8_LDB(B1, 1, 1); PG8_STAGE(PG8_SB(1, 0), b3, voffB);
            PG8_BAR; PG8_WAIT_L(0); PG8_MMA(0, 1, At, B1); PG8_BAR;
            PG8_LDA(At, 1, 1); PG8_STAGE(PG8_SA(1, 0), a3, voffA);
            PG8_BAR; PG8_WAIT_L(0); PG8_MMA(1, 0, At, B0); PG8_BAR; PG8_SCHED;
            PG8_STAGE(PG8_SB(1, 1), b3 + hstep, voffB);
            PG8_WAIT_V(6); PG8_BAR; PG8_MMA(1, 1, At, B1); PG8_BAR;
            }
        }
        if constexpr (ALIGN_EPI) { if (wr == 0) PG8_BAR; }
        if constexpr (!Epi::AFTER_DRAIN) { E(acc, cur, wr, wc, fr, fq); S.done(cur); }
        if (!has_next) break;
#pragma unroll
        for (int a = 0; a < 2; ++a)
#pragma unroll
            for (int b = 0; b < 2; ++b)
#pragma unroll
                for (int m = 0; m < 4; ++m)
#pragma unroll
                    for (int n = 0; n < 2; ++n) acc[a][b][m][n] = (f32x4){0.f, 0.f, 0.f, 0.f};
        cur = nxt; cA = nA; cB = nB; ++ui;
        if constexpr (ALIGN_EPI) { if (wr == 1) PG8_BAR; }
    }
    PG8_WAIT_V(0);
    if constexpr (!ALIGN_EPI) { if (wr == 0) PG8_BAR; }
    PG8_BAR;
    if constexpr (Epi::AFTER_DRAIN) { E.fused(acc, cur, wr, wc, fr, fq, lds, wid, lane); S.done(cur); }
#undef PG8_SA
#undef PG8_SB
#undef PG8_STAGE
#undef PG8_LDA
#undef PG8_LDB
#undef PG8_MMA
#undef PG8_WAIT_V
#undef PG8_WAIT_L
#undef PG8_BAR
#undef PG8_SCHED
}
}
#define LAS __attribute__((address_space(3)))
typedef unsigned short bf16;
typedef unsigned v4u __attribute__((ext_vector_type(4)));
typedef unsigned v2u __attribute__((ext_vector_type(2)));
typedef float f32x4 __attribute__((ext_vector_type(4)));
typedef float f32x2 __attribute__((ext_vector_type(2)));
typedef float f32x16 __attribute__((ext_vector_type(16)));
typedef short bf16x8 __attribute__((ext_vector_type(8)));
typedef short s16x4 __attribute__((ext_vector_type(4)));
using pg8::O_YP; using pg8::O_YS; using pg8::O_KP; using pg8::O_VP; using pg8::O_KS; using pg8::O_VS; using pg8::O_GV; using pg8::O_SP; using pg8::O_SS;
constexpr int M = 8704, MP = 8192, D = 2048, NIN_E = 3584, DFF = 8192, NWAVES = 8, NTHR = 512;
constexpr size_t MiB = 1u << 20;
constexpr size_t WS_SS = 464 * MiB;
constexpr size_t SSN = (size_t)8704 * 32;
constexpr size_t WS_CS = 1 * MiB;
constexpr size_t WS_W5 = 2 * MiB, WS_W6 = 34 * MiB, WS_WU1 = 42 * MiB, WS_WD1 = 74 * MiB;
constexpr size_t WS_W1 = 106 * MiB, WS_W2 = 120 * MiB, WS_WU0 = 128 * MiB, WS_WD0 = 160 * MiB;
constexpr size_t WS_BIG = 192 * MiB;
constexpr size_t WS_Q = WS_BIG, WS_KP = WS_BIG + 17 * MiB, WS_KS = WS_BIG + 21 * MiB, WS_VTP = WS_BIG + 23 * MiB, WS_VTS = WS_BIG + 27 * MiB, WS_U = WS_BIG + 29 * MiB, WS_GVR = WS_BIG + 46 * MiB;
constexpr size_t WS_QH = 106 * MiB, WS_FH = 174 * MiB, WS_VH = 242 * MiB, WS_GH = 276 * MiB;
constexpr size_t WS_H = 328 * MiB;
constexpr size_t WS_A1 = 396 * MiB;
constexpr size_t WS_A2 = 430 * MiB;
constexpr size_t WS_END = 470 * MiB;
constexpr size_t WS_SEG = WS_A1, WS_DEC = WS_A1 + 16 * MiB;
constexpr int LDS_BYTES = 147456;
constexpr int NPH = 16;

__device__ __forceinline__ unsigned f2bf(float f) { unsigned u = __builtin_bit_cast(unsigned, f); return (u + 0x7fffu + ((u >> 16) & 1u)) >> 16; }
__device__ __forceinline__ unsigned pk2(float lo, float hi) { return pg8::cvt_pk_bf16(lo, hi); }
__device__ __forceinline__ float bf2f(unsigned short b) { return __builtin_bit_cast(float, (unsigned)b << 16); }
__device__ __forceinline__ float wave_sum(float v) {
#pragma unroll
    for (int o = 1; o < 64; o <<= 1) v += __shfl_xor(v, o);
    return v;
}
struct Args { const float* in[20]; float* out; unsigned char* ws; int ph_lo, ph_hi; };

__device__ __forceinline__ void tr64_item(const float* __restrict__ W, int K, int N, bf16* WT, const float* __restrict__ g, LAS float* scr, int item, int lane) {
    const int nblk = N / 64, kb = item / nblk, nb = item % nblk, k0 = 64 * kb, n0 = 64 * nb;
    const int kr = lane >> 4, l4 = lane & 15;
    f32x4 v[16];
#pragma unroll
    for (int i = 0; i < 16; ++i) v[i] = __builtin_nontemporal_load((const f32x4*)(W + (size_t)(k0 + 4 * i + kr) * N + n0 + 4 * l4));
#pragma unroll
    for (int i = 0; i < 16; ++i) { const int k = 4 * i + kr; if (g) v[i] = v[i] * g[k0 + k];
        *(LAS f32x4*)(scr + k * 64 + ((4 * l4) ^ ((k >> 3) << 2))) = v[i]; }
    asm volatile("s_waitcnt lgkmcnt(0)" ::: "memory");
    const int c = lane & 7, nn = lane >> 3;
#pragma unroll
    for (int j = 0; j < 8; ++j) { const int n = nn + 8 * j; const LAS float* s = scr + (8 * c) * 64 + (n ^ (c << 2));
        v4u o; o.x = pk2(s[0 * 64], s[1 * 64]); o.y = pk2(s[2 * 64], s[3 * 64]); o.z = pk2(s[4 * 64], s[5 * 64]); o.w = pk2(s[6 * 64], s[7 * 64]);
        *(v4u*)(WT + (size_t)(n0 + n) * K + k0 + 8 * c) = o; }
    asm volatile("s_waitcnt lgkmcnt(0)" ::: "memory");
}
__device__ __forceinline__ void attn_wave(const bf16* Qp, const bf16* Kp, int kstride, const bf16* Vt, int vstride, int nkb, float sink, bf16* Op, int lane) {
    const int r = lane & 31, h = lane >> 5;
    bf16x8 qf[4];
#pragma unroll
    for (int s = 0; s < 4; ++s) qf[s] = *(const bf16x8*)(Qp + (size_t)r * 1024 + 16 * s + 8 * h);
    f32x16 S[6];
#pragma unroll
    for (int kb = 0; kb < 6; ++kb) {
        S[kb] = (f32x16){0.f,0.f,0.f,0.f,0.f,0.f,0.f,0.f,0.f,0.f,0.f,0.f,0.f,0.f,0.f,0.f};
        if (kb < nkb) {
#pragma unroll
            for (int s = 0; s < 4; ++s) { const bf16x8 kf = *(const bf16x8*)(Kp + (size_t)(kb * 32 + r) * kstride + 16 * s + 8 * h);
                S[kb] = __builtin_amdgcn_mfma_f32_32x32x16_bf16(kf, qf[s], S[kb], 0, 0, 0); }
        }
    }
    float mx = sink;
#pragma unroll
    for (int kb = 0; kb < 6; ++kb) if (kb < nkb) {
#pragma unroll
        for (int i = 0; i < 16; ++i) mx = fmaxf(mx, S[kb][i]); }
    mx = fmaxf(mx, __shfl_xor(mx, 32));
    float l = 0.f;
#pragma unroll
    for (int kb = 0; kb < 6; ++kb) if (kb < nkb) {
#pragma unroll
        for (int i = 0; i < 16; ++i) { const float p = __expf(S[kb][i] - mx); S[kb][i] = p; l += p; } }
    l += __shfl_xor(l, 32);
    l += __expf(sink - mx);
    f32x16 O[2];
    O[0] = (f32x16){0.f,0.f,0.f,0.f,0.f,0.f,0.f,0.f,0.f,0.f,0.f,0.f,0.f,0.f,0.f,0.f}; O[1] = O[0];
#pragma unroll
    for (int kb = 0; kb < 6; ++kb) if (kb < nkb) {
#pragma unroll
        for (int s = 0; s < 2; ++s) {
            v4u pw; pw.x = pk2(S[kb][8 * s + 0], S[kb][8 * s + 1]); pw.y = pk2(S[kb][8 * s + 2], S[kb][8 * s + 3]); pw.z = pk2(S[kb][8 * s + 4], S[kb][8 * s + 5]); pw.w = pk2(S[kb][8 * s + 6], S[kb][8 * s + 7]);
            const bf16x8 pf = __builtin_bit_cast(bf16x8, pw);
#pragma unroll
            for (int db = 0; db < 2; ++db) {
                const bf16* vp = Vt + (size_t)(db * 32 + r) * vstride + kb * 32 + 16 * s + 4 * h;
                const v2u lo = *(const v2u*)vp, hi = *(const v2u*)(vp + 8);
                v4u vw; vw.x = lo.x; vw.y = lo.y; vw.z = hi.x; vw.w = hi.y;
                O[db] = __builtin_amdgcn_mfma_f32_32x32x16_bf16(__builtin_bit_cast(bf16x8, vw), pf, O[db], 0, 0, 0);
            }
        }
    }
    const float il = 1.f / l;
#pragma unroll
    for (int db = 0; db < 2; ++db)
#pragma unroll
        for (int g4 = 0; g4 < 4; ++g4) {
            v2u w; w.x = pk2(O[db][4 * g4 + 0] * il, O[db][4 * g4 + 1] * il); w.y = pk2(O[db][4 * g4 + 2] * il, O[db][4 * g4 + 3] * il);
            *(v2u*)(Op + (size_t)r * 2048 + db * 32 + 8 * g4 + 4 * h) = w;
        }
}

__device__ __forceinline__ void gmlp_unit(unsigned char* lds, const float* GVr, const bf16* U, const float* gamma, const float* Wsp, const float* bias, bf16* AB, float* gvout, int row0, int nrows, int hg, int tid) {
    bf16* gvT = (bf16*)lds;
    const int lane = tid & 63, wave = tid >> 6;
    {
        const int q = tid >> 2, part = tid & 3;
        f32x4 v[8]; float s = 0.f;
        if (q < nrows) {
#pragma unroll
            for (int j = 0; j < 8; ++j) { v[j] = *(const f32x4*)(GVr + (size_t)(row0 + q) * 1024 + hg * 128 + part * 32 + 4 * j); s += (v[j][0] + v[j][1]) + (v[j][2] + v[j][3]); }
        } else {
#pragma unroll
            for (int j = 0; j < 8; ++j) v[j] = (f32x4){0.f, 0.f, 0.f, 0.f};
        }
        s += __shfl_xor(s, 1); s += __shfl_xor(s, 2);
        const float mu = s * (1.f / 128.f); float s2 = 0.f;
#pragma unroll
        for (int j = 0; j < 8; ++j) { v[j] = v[j] - mu; s2 += (v[j][0] * v[j][0] + v[j][1] * v[j][1]) + (v[j][2] * v[j][2] + v[j][3] * v[j][3]); }
        s2 += __shfl_xor(s2, 1); s2 += __shfl_xor(s2, 2);
        const float rstd = rsqrtf(s2 * (1.f / 128.f) + 1e-6f);
#pragma unroll
        for (int j = 0; j < 8; ++j) {
            const f32x4 gm = *(const f32x4*)(gamma + hg * 128 + part * 32 + 4 * j);
            f32x4 o = v[j] * rstd * gm;
            if (q >= nrows) o = (f32x4){0.f, 0.f, 0.f, 0.f};
            if (gvout && q < nrows) *(f32x4*)(gvout + ((size_t)q * 8 + hg) * 128 + part * 32 + 4 * j) = o;
#pragma unroll
            for (int e = 0; e < 4; ++e) gvT[(part * 32 + 4 * j + e) * 136 + q] = (bf16)f2bf(o[e]);
        }
    }
    __syncthreads();
    const int r = lane & 31, hh = lane >> 5;
    const int pb = wave >> 1;
    if (pb * 32 < nrows) {
        const int nks = (nrows == 32) ? 2 : (pb < 2 ? 4 : 8);
        f32x16 acc[2];
        acc[0] = (f32x16){0.f,0.f,0.f,0.f,0.f,0.f,0.f,0.f,0.f,0.f,0.f,0.f,0.f,0.f,0.f,0.f}; acc[1] = acc[0];
        for (int s = 0; s < nks; ++s) {
            const float* wp = Wsp + ((size_t)hg * 128 + pb * 32 + r) * 128 + 16 * s + 8 * hh;
            const f32x4 w0 = *(const f32x4*)wp, w1 = *(const f32x4*)(wp + 4);
            v4u aw; aw.x = pk2(w0[0], w0[1]); aw.y = pk2(w0[2], w0[3]); aw.z = pk2(w1[0], w1[1]); aw.w = pk2(w1[2], w1[3]);
            const bf16x8 af = __builtin_bit_cast(bf16x8, aw);
#pragma unroll
            for (int t = 0; t < 2; ++t) {
                const int db = (wave & 1) * 2 + t;
                const bf16x8 bfr = *(const bf16x8*)(gvT + (db * 32 + r) * 136 + 16 * s + 8 * hh);
                acc[t] = __builtin_amdgcn_mfma_f32_32x32x16_bf16(bfr, af, acc[t], 0, 0, 0);
            }
        }
        {
            const int p = pb * 32 + r; const float bs = bias[hg * 128 + p];
#pragma unroll
            for (int t = 0; t < 2; ++t)
#pragma unroll
                for (int g4 = 0; g4 < 4; ++g4) {
                    const int dcol = hg * 128 + ((wave & 1) * 2 + t) * 32 + 8 * g4 + 4 * hh;
                    const v2u uw = *(const v2u*)(U + (size_t)(row0 + p) * 1024 + dcol);
                    v2u ow; ow.x = pk2(bf2f((unsigned short)(uw.x & 0xffff)) * (acc[t][4 * g4 + 0] + bs), bf2f((unsigned short)(uw.x >> 16)) * (acc[t][4 * g4 + 1] + bs));
                    ow.y = pk2(bf2f((unsigned short)(uw.y & 0xffff)) * (acc[t][4 * g4 + 2] + bs), bf2f((unsigned short)(uw.y >> 16)) * (acc[t][4 * g4 + 3] + bs));
                    *(v2u*)(AB + (size_t)(row0 + p) * 2048 + 1024 + dcol) = ow;
                }
        }
    }
    __syncthreads();
}

template <bool OUT, bool DECAY>
__device__ __forceinline__ void hgrn_unit(unsigned char* lds, const float* QH, const float* FH, const bf16* VH, const bf16* GH, const float* gon, bf16* Oo,
                                          int hd, int row0, int L, int init, const float* sin, const float* SEG, const float* DEC, int gseg, float* sout, float* decout, int tid) {
    float* qs = (float*)lds;
    float* fs = qs + 2 * 2048;
    float* vs = fs + 2 * 2048;
    float* op = vs + 2 * 2048;
    const int lane = tid & 63, w = tid >> 6, e = (w & 1) * 64 + lane, dq = w >> 1, d0 = dq * 32;
    f32x2 S[16];
    if (init == 1) {
#pragma unroll
        for (int i = 0; i < 16; ++i) { S[i].x = sin[(size_t)(d0 + 2 * i) * 128 + e]; S[i].y = sin[(size_t)(d0 + 2 * i + 1) * 128 + e]; }
    } else {
#pragma unroll
        for (int i = 0; i < 16; ++i) S[i] = (f32x2){0.f, 0.f};
        if (init == 2) {
            for (int g = 0; g < gseg; ++g) {
                const float* Lp = SEG + ((size_t)(hd * 16 + g) * 128 + d0) * 128 + e; const float* Dp = DEC + (size_t)(hd * 16 + g) * 128 + d0;
#pragma unroll
                for (int i = 0; i < 16; ++i) { S[i].x = Dp[2 * i] * S[i].x + Lp[(size_t)(2 * i) * 128]; S[i].y = Dp[2 * i + 1] * S[i].y + Lp[(size_t)(2 * i + 1) * 128]; }
            }
        }
    }
    float dec = 1.f;
    const int tt = tid >> 5, c4 = (tid & 31) * 4;
    const int nb = L >> 4;
    f32x4 rq, rf; v2u rv;
    {
        const size_t off = (size_t)(row0 + tt) * 2048 + hd * 128 + c4;
        if (OUT) rq = *(const f32x4*)(QH + off);
        rf = *(const f32x4*)(FH + off); rv = *(const v2u*)(VH + off);
        if (OUT) *(f32x4*)(qs + tt * 128 + c4) = rq;
        *(f32x4*)(fs + tt * 128 + c4) = rf;
        *(f32x4*)(vs + tt * 128 + c4) = (f32x4){bf2f((unsigned short)(rv.x & 0xffff)), bf2f((unsigned short)(rv.x >> 16)), bf2f((unsigned short)(rv.y & 0xffff)), bf2f((unsigned short)(rv.y >> 16))};
    }
    __syncthreads();
    for (int b = 0; b < nb; ++b) {
        const int buf = b & 1;
        if (b + 1 < nb) {
            const size_t off = (size_t)(row0 + (b + 1) * 16 + tt) * 2048 + hd * 128 + c4;
            if (OUT) rq = *(const f32x4*)(QH + off);
            rf = *(const f32x4*)(FH + off); rv = *(const v2u*)(VH + off);
        }
        const float* qb = qs + buf * 2048 + d0; const float* fb = fs + buf * 2048 + d0; const float* vb = vs + buf * 2048 + e;
#pragma unroll 2
        for (int t = 0; t < 16; ++t) {
            const float v = vb[t * 128]; const f32x2 v2 = (f32x2){v, v};
            f32x2 o2 = (f32x2){0.f, 0.f};
#pragma unroll
            for (int i = 0; i < 8; ++i) {
                const f32x4 f4 = *(const f32x4*)(fb + t * 128 + 4 * i);
                S[2 * i] = (f32x2){f4[0], f4[1]} * (S[2 * i] - v2) + v2;
                S[2 * i + 1] = (f32x2){f4[2], f4[3]} * (S[2 * i + 1] - v2) + v2;
                if (OUT) { const f32x4 q4 = *(const f32x4*)(qb + t * 128 + 4 * i); o2 += (f32x2){q4[0], q4[1]} * S[2 * i]; o2 += (f32x2){q4[2], q4[3]} * S[2 * i + 1]; }
            }
            if (OUT) op[((buf * 16 + t) * 4 + dq) * 128 + e] = o2.x + o2.y;
        }
        if (DECAY) { if (tid < 128) {
#pragma unroll
            for (int t = 0; t < 16; ++t) dec *= fs[buf * 2048 + t * 128 + tid]; } }
        if (b + 1 < nb) {
            const int nbuf = buf ^ 1;
            if (OUT) *(f32x4*)(qs + nbuf * 2048 + tt * 128 + c4) = rq;
            *(f32x4*)(fs + nbuf * 2048 + tt * 128 + c4) = rf;
            *(f32x4*)(vs + nbuf * 2048 + tt * 128 + c4) = (f32x4){bf2f((unsigned short)(rv.x & 0xffff)), bf2f((unsigned short)(rv.x >> 16)), bf2f((unsigned short)(rv.y & 0xffff)), bf2f((unsigned short)(rv.y >> 16))};
        }
        __syncthreads();
        if (OUT) {
            const float* ob = op + (buf * 16 + tt) * 512 + c4;
            f32x4 o = *(const f32x4*)ob + *(const f32x4*)(ob + 128) + *(const f32x4*)(ob + 256) + *(const f32x4*)(ob + 384);
            float sq = (o[0] * o[0] + o[1] * o[1]) + (o[2] * o[2] + o[3] * o[3]);
#pragma unroll
            for (int x = 1; x < 32; x <<= 1) sq += __shfl_xor(sq, x);
            const float rms = rsqrtf(sq * (1.f / 128.f) + 1e-6f);
            const size_t off = (size_t)(row0 + b * 16 + tt) * 2048 + hd * 128 + c4;
            const v2u gw = *(const v2u*)(GH + off); const f32x4 gn = *(const f32x4*)(gon + hd * 128 + c4);
            const float r0 = o[0] * rms * gn[0] * bf2f((unsigned short)(gw.x & 0xffff)), r1 = o[1] * rms * gn[1] * bf2f((unsigned short)(gw.x >> 16));
            const float r2 = o[2] * rms * gn[2] * bf2f((unsigned short)(gw.y & 0xffff)), r3 = o[3] * rms * gn[3] * bf2f((unsigned short)(gw.y >> 16));
            v2u ow; ow.x = pk2(r0, r1); ow.y = pk2(r2, r3);
            *(v2u*)(Oo + off) = ow;
        }
    }
    if (sout) {
#pragma unroll
        for (int i = 0; i < 16; ++i) { sout[(size_t)(d0 + 2 * i) * 128 + e] = S[i].x; sout[(size_t)(d0 + 2 * i + 1) * 128 + e] = S[i].y; }
    }
    if (DECAY) { if (decout && tid < 128) decout[tid] = dec; }
    __syncthreads();
}
#define XB_TMO      128
#define XB_XCNT(j)  (256  + 64 * (j))
#define XB_XSUB(j)  (1280 + 64 * (j))
#define XB_XGEN(j)  (2304 + 64 * (j))
#define XB_TOP      3328
#define XB_TOPGEN   3392
#define XCD_BAR_WORDS 3456
#define XB_SPIN_CAP (1u << 18)

__device__ __forceinline__ unsigned xb_ld(unsigned* p)              { return __hip_atomic_load(p, __ATOMIC_RELAXED, __HIP_MEMORY_SCOPE_AGENT); }
__device__ __forceinline__ unsigned xb_add(unsigned* p, unsigned v) { return __hip_atomic_fetch_add(p, v, __ATOMIC_RELAXED, __HIP_MEMORY_SCOPE_AGENT); }
__device__ __forceinline__ unsigned xb_xcc_id() { return (unsigned)__builtin_amdgcn_s_getreg((3 << 11) | 20) & 0xFu; }
#define XB_SPIN(cond, bar) do { unsigned _sp = 0; while (cond) { __builtin_amdgcn_s_sleep(1); \
    if ((++_sp & 255u) == 0u) { if (xb_ld(&(bar)[XB_TMO])) break; if (_sp > XB_SPIN_CAP) { atomicAdd(&(bar)[XB_TMO], 1u); break; } } } } while (0)

struct XcdBarrier {
    unsigned* bar; unsigned x;
    volatile LAS unsigned* st;
};

__device__ __forceinline__ XcdBarrier xcd_barrier_post(unsigned* bar, volatile LAS unsigned* st) {
    XcdBarrier b; b.bar = bar; b.x = xb_xcc_id(); b.st = st;
    if (threadIdx.x == 0) (void)xb_add(&bar[XB_XCNT(b.x)], 1u);
    return b;
}
__device__ __forceinline__ void xcd_barrier_complete(unsigned* bar, unsigned x, unsigned& nloc, unsigned& nx) {
    const unsigned G = gridDim.x * gridDim.y * gridDim.z;
    unsigned sum, cnt, mine, sp = 0u;
    for (;;) {
        sum = 0u; cnt = 0u; mine = 0u;
#pragma unroll
        for (unsigned j = 0; j < 16; ++j) { const unsigned c = xb_ld(&bar[XB_XCNT(j)]); sum += c; cnt += (c > 0u) ? 1u : 0u; mine = (j == x) ? c : mine; }
        if (sum == G) break;
        __builtin_amdgcn_s_sleep(1);
        if ((++sp & 255u) == 0u) { if (xb_ld(&bar[XB_TMO])) break; if (sp > XB_SPIN_CAP) { atomicAdd(&bar[XB_TMO], 1u); break; } }
    }
    nloc = mine > 0u ? mine : 1u; nx = cnt > 0u ? cnt : 1u;
}

__device__ __forceinline__ void xcd_barrier(const XcdBarrier& b) {
    asm volatile("s_waitcnt vmcnt(0)" ::: "memory");
    __syncthreads();
    if (threadIdx.x == 0) {
        unsigned* bar = b.bar;
        __builtin_amdgcn_s_waitcnt(0);
        unsigned nloc = b.st[0], nx = b.st[1];
        if (nloc == 0u) { xcd_barrier_complete(bar, b.x, nloc, nx); b.st[0] = nloc; b.st[1] = nx; }
        const unsigned old = xb_add(&bar[XB_XSUB(b.x)], 1u);
        const unsigned gen = old / nloc;
        if (old + 1u == (gen + 1u) * nloc) {
            __builtin_amdgcn_fence(__ATOMIC_RELEASE, "agent");
            asm volatile("s_waitcnt vmcnt(0)" ::: "memory");
            const unsigned og = xb_add(&bar[XB_TOP], 1u);
            const unsigned tg = og / nx;
            if (og + 1u == (tg + 1u) * nx) xb_add(&bar[XB_TOPGEN], 1u);
            else XB_SPIN(xb_ld(&bar[XB_TOPGEN]) == tg, bar);
            __builtin_amdgcn_fence(__ATOMIC_ACQUIRE, "agent");
            xb_add(&bar[XB_XGEN(b.x)], 1u);
            asm volatile("s_waitcnt vmcnt(0)" ::: "memory");
        } else {
            XB_SPIN(xb_ld(&bar[XB_XGEN(b.x)]) == gen, bar);
            __builtin_amdgcn_fence(__ATOMIC_ACQUIRE, "agent");
            asm volatile("s_waitcnt vmcnt(0)" ::: "memory");
        }
    }
    __syncthreads();
}
constexpr int HG_QH = 0, HG_KT = 8704, HG_KHT = 17408, HG_VT = 27648, HG_D = 37888, HG_PART = 38400, HG_OST = 40448;
__device__ __forceinline__ bf16x8 pack8(const f32x16& x, int o) {
    v4u w; w.x = pg8::cvt_pk_bf16(x[o + 0], x[o + 1]); w.y = pg8::cvt_pk_bf16(x[o + 2], x[o + 3]); w.z = pg8::cvt_pk_bf16(x[o + 4], x[o + 5]); w.w = pg8::cvt_pk_bf16(x[o + 6], x[o + 7]);
    return __builtin_bit_cast(bf16x8, w);
}
template <bool OUT>
__device__ __forceinline__ void hg_unit(unsigned char* lds, const float* QH, const float* FH, const bf16* VH, const bf16* GH, const float* gon, bf16* Oo,
                                        int hd, int row0, int nch, int init, const float* sin, const float* SEG, const float* DEC, int gseg, float* sout, float* decout, int tid, float* zflag = nullptr) {
    bf16* Qh = (bf16*)(lds + HG_QH); bf16* Kt = (bf16*)(lds + HG_KT); bf16* KhT = (bf16*)(lds + HG_KHT); bf16* VT = (bf16*)(lds + HG_VT);
    float* Dv = (float*)(lds + HG_D); float* Pp = (float*)(lds + HG_PART); float* Ost = (float*)(lds + HG_OST);
    const int lane = tid & 63, w = __builtin_amdgcn_readfirstlane(tid >> 6), r = lane & 31, hh = lane >> 5;
    const int d = tid & 127, tq = __builtin_amdgcn_readfirstlane(tid >> 7);
    const f32x16 Z16 = (f32x16){0.f,0.f,0.f,0.f,0.f,0.f,0.f,0.f,0.f,0.f,0.f,0.f,0.f,0.f,0.f,0.f};
    f32x16 S[4];
#pragma unroll
    for (int db = 0; db < 4; ++db) S[db] = Z16;
    if (w < 4) {
        if (init == 1) {
#pragma unroll
            for (int db = 0; db < 4; ++db)
#pragma unroll
                for (int i = 0; i < 16; ++i) S[db][i] = sin[(size_t)(db * 32 + (i & 3) + 8 * (i >> 2) + 4 * hh) * 128 + w * 32 + r];
        }
    }
    float dec = 1.f;
    float pf[8], pq[8]; unsigned short pv[8];
    {
        const size_t off = (size_t)(row0 + tq * 8) * 2048 + hd * 128 + d;
#pragma unroll
        for (int j = 0; j < 8; ++j) { pf[j] = FH[off + (size_t)j * 2048]; pv[j] = VH[off + (size_t)j * 2048]; if (OUT) pq[j] = QH[off + (size_t)j * 2048]; }
    }
    for (int c = 0; c < nch; ++c) {
        v4u gw = (v4u){0u, 0u, 0u, 0u};
        if (OUT) gw = *(const v4u*)(GH + (size_t)(row0 + c * 32 + (tid >> 4)) * 2048 + hd * 128 + (tid & 15) * 8);
        float A[8]; float run = 1.f;
#pragma unroll
        for (int j = 0; j < 8; ++j) { run *= pf[j]; A[j] = run; }
        Pp[tq * 128 + d] = run;
        __syncthreads();
        const float p0 = Pp[d], p1 = Pp[128 + d], p2 = Pp[256 + d], p3 = Pp[384 + d];
        const float offp = tq == 0 ? 1.f : tq == 1 ? p0 : tq == 2 ? p0 * p1 : p0 * p1 * p2;
        const float tot = (p0 * p1) * (p2 * p3);
#pragma unroll
        for (int j = 0; j < 8; ++j) {
            const int t = tq * 8 + j; const float a = A[j] * offp, ia = __builtin_amdgcn_rcpf(a), k = 1.f - pf[j];
            if (OUT) Qh[t * 136 + d] = (bf16)f2bf(pq[j] * a);
            if (OUT) Kt[t * 136 + d] = (bf16)f2bf(k * ia);
            KhT[d * 40 + t] = (bf16)f2bf(k * tot * ia);
            VT[d * 40 + t] = pv[j];
        }
        if (tq == 0) { Dv[d] = tot; if (!OUT) dec *= tot; }
        if (c + 1 < nch) {
            const size_t off = (size_t)(row0 + (c + 1) * 32 + tq * 8) * 2048 + hd * 128 + d;
#pragma unroll
            for (int j = 0; j < 8; ++j) { pf[j] = FH[off + (size_t)j * 2048]; pv[j] = VH[off + (size_t)j * 2048]; if (OUT) pq[j] = QH[off + (size_t)j * 2048]; }
        }
        __syncthreads();
        if (w < 4) {
            if (OUT) {
                f32x16 P = Z16;
#pragma unroll
                for (int kk = 0; kk < 8; ++kk) {
                    const bf16x8 a = *(const bf16x8*)(Kt + r * 136 + 16 * kk + 8 * hh), b = *(const bf16x8*)(Qh + r * 136 + 16 * kk + 8 * hh);
                    P = __builtin_amdgcn_mfma_f32_32x32x16_bf16(a, b, P, 0, 0, 0);
                }
#pragma unroll
                for (int i = 0; i < 16; ++i) { const int s = (i & 3) + 8 * (i >> 2) + 4 * hh; if (s > r) P[i] = 0.f; }
                f32x16 o = Z16;
#pragma unroll
                for (int db = 0; db < 4; ++db)
#pragma unroll
                    for (int kk = 0; kk < 2; ++kk) {
                        const bf16* qp = Qh + r * 136 + db * 32 + 16 * kk + 4 * hh;
                        const v2u lo = *(const v2u*)qp, hi = *(const v2u*)(qp + 8);
                        v4u bw; bw.x = lo.x; bw.y = lo.y; bw.z = hi.x; bw.w = hi.y;
                        o = __builtin_amdgcn_mfma_f32_32x32x16_bf16(pack8(S[db], 8 * kk), __builtin_bit_cast(bf16x8, bw), o, 0, 0, 0);
                    }
#pragma unroll
                for (int kk = 0; kk < 2; ++kk) {
                    const bf16* vp = VT + (w * 32 + r) * 40 + 16 * kk + 4 * hh;
                    const v2u lo = *(const v2u*)vp, hi = *(const v2u*)(vp + 8);
                    v4u aw; aw.x = lo.x; aw.y = lo.y; aw.z = hi.x; aw.w = hi.y;
                    o = __builtin_amdgcn_mfma_f32_32x32x16_bf16(__builtin_bit_cast(bf16x8, aw), pack8(P, 8 * kk), o, 0, 0, 0);
                }
#pragma unroll
                for (int g4 = 0; g4 < 4; ++g4) *(f32x4*)(Ost + r * 132 + w * 32 + 8 * g4 + 4 * hh) = (f32x4){o[4 * g4], o[4 * g4 + 1], o[4 * g4 + 2], o[4 * g4 + 3]};
            }
#pragma unroll
            for (int db = 0; db < 4; ++db) {
#pragma unroll
                for (int g4 = 0; g4 < 4; ++g4) { const f32x4 dv = *(const f32x4*)(Dv + db * 32 + 8 * g4 + 4 * hh);
#pragma unroll
                    for (int j = 0; j < 4; ++j) S[db][4 * g4 + j] *= dv[j]; }
#pragma unroll
                for (int kk = 0; kk < 2; ++kk) {
                    const bf16x8 a = *(const bf16x8*)(KhT + (db * 32 + r) * 40 + 16 * kk + 8 * hh), b = *(const bf16x8*)(VT + (w * 32 + r) * 40 + 16 * kk + 8 * hh);
                    S[db] = __builtin_amdgcn_mfma_f32_32x32x16_bf16(a, b, S[db], 0, 0, 0);
                }
            }
        }
        if (OUT) {
            __syncthreads();
            const int t = tid >> 4, e8 = (tid & 15) * 8;
            const f32x4 o0 = *(const f32x4*)(Ost + t * 132 + e8), o1 = *(const f32x4*)(Ost + t * 132 + e8 + 4);
            float sq = ((o0[0] * o0[0] + o0[1] * o0[1]) + (o0[2] * o0[2] + o0[3] * o0[3])) + ((o1[0] * o1[0] + o1[1] * o1[1]) + (o1[2] * o1[2] + o1[3] * o1[3]));
#pragma unroll
            for (int x = 1; x < 16; x <<= 1) sq += __shfl_xor(sq, x);
            const float rms = rsqrtf(sq * (1.f / 128.f) + 1e-6f);
            const size_t off = (size_t)(row0 + c * 32 + t) * 2048 + hd * 128 + e8;
            const f32x4 g0 = *(const f32x4*)(gon + hd * 128 + e8), g1 = *(const f32x4*)(gon + hd * 128 + e8 + 4);
            v4u ow;
            ow.x = pk2(o0[0] * rms * g0[0] * bf2f((unsigned short)(gw.x & 0xffff)), o0[1] * rms * g0[1] * bf2f((unsigned short)(gw.x >> 16)));
            ow.y = pk2(o0[2] * rms * g0[2] * bf2f((unsigned short)(gw.y & 0xffff)), o0[3] * rms * g0[3] * bf2f((unsigned short)(gw.y >> 16)));
            ow.z = pk2(o1[0] * rms * g1[0] * bf2f((unsigned short)(gw.z & 0xffff)), o1[1] * rms * g1[1] * bf2f((unsigned short)(gw.z >> 16)));
            ow.w = pk2(o1[2] * rms * g1[2] * bf2f((unsigned short)(gw.w & 0xffff)), o1[3] * rms * g1[3] * bf2f((unsigned short)(gw.w >> 16)));
            *(v4u*)(Oo + off) = ow;
        }
    }
    if (sout && w < 4) {
#pragma unroll
        for (int db = 0; db < 4; ++db)
#pragma unroll
            for (int i = 0; i < 16; ++i) sout[(size_t)(db * 32 + (i & 3) + 8 * (i >> 2) + 4 * hh) * 128 + w * 32 + r] = S[db][i];
    }
    if (!OUT) {
        if (decout && tid < 128) decout[tid] = dec;
        const int anynz = __syncthreads_or(tid < 128 && dec > 0.f);
        if (zflag && tid == 0) *zflag = anynz ? 0.f : 1.f;
    }
    __syncthreads();
}
#ifndef DBG_A2PTR
#define DBG_A2PTR A2
#endif
#ifndef SEQ_LO
#define SEQ_LO 0xbad98e76d54d3210ull
#define SEQ_HI 0xcull
#define SEQ_N 17
#endif
#ifndef DBG_SSI
#define DBG_SSI 4
#endif
#ifndef PHMASK
#define PHMASK 0xffff
#endif
#define PHEN(k) (((PHMASK) >> (k)) & 1)
#ifndef MK_PER_PHASE
#define MK_PER_PHASE 0
#endif
#define CAS __attribute__((address_space(4)))
#define INP(i) (*(const float* const CAS*)(kp + 8 * (i)))
#define xp INP(0)
#define xs INP(1)
#define ss ((float*)(ws + WS_SS))
#define cs ((float*)(ws + WS_CS))
#define A1 ((bf16*)(ws + WS_A1))
#define A2 ((bf16*)(ws + WS_A2))
#define H ((float*)(ws + WS_H))
#define HID ((bf16*)(ws + WS_BIG))
#define Qb ((bf16*)(ws + WS_Q))
#define Kpb ((bf16*)(ws + WS_KP))
#define Ksb ((bf16*)(ws + WS_KS))
#define Vtp ((bf16*)(ws + WS_VTP))
#define Vts ((bf16*)(ws + WS_VTS))
#define Ub ((bf16*)(ws + WS_U))
#define GVr ((float*)(ws + WS_GVR))
#define QH ((float*)(ws + WS_QH))
#define FH ((float*)(ws + WS_FH))
#define VH ((bf16*)(ws + WS_VH))
#define GH ((bf16*)(ws + WS_GH))
#define SEG ((float*)(ws + WS_SEG))
#define DEC ((float*)(ws + WS_DEC))

#define CONV_L1(j_) do { int r_ = (j_); \
    if (r_ < 4096) { tr64_item(INP(14), 2048, 8192, (bf16*)(ws + WS_W5), INP(5) + 2048, scr, r_, lane); break; } r_ -= 4096; \
    if (r_ < 1024) { tr64_item(INP(15), 2048, 2048, (bf16*)(ws + WS_W6), nullptr, scr, r_, lane); break; } r_ -= 1024; \
    if (r_ < 4096) { tr64_item(INP(18) + (size_t)2048 * 8192, 2048, 8192, (bf16*)(ws + WS_WU1), INP(6) + 2048, scr, r_, lane); break; } r_ -= 4096; \
    tr64_item(INP(19) + (size_t)2048 * 8192, 8192, 2048, (bf16*)(ws + WS_WD1), nullptr, scr, r_, lane); } while (0)
#define CONV_RANGE(j0_, j1_, w0_, nw_) do { LAS float* scr = (LAS float*)(lds3 + wave * 16384); \
    for (int j__ = (j0_) + (w0_) * NWAVES + wave; j__ < (j1_); j__ += (nw_) * NWAVES) CONV_L1(j__); } while (0)
__global__ void __launch_bounds__(NTHR, 2) mk_fwd(Args a) {
    extern __shared__ __attribute__((aligned(16))) unsigned char lds[];
    const int G = gridDim.x, bid = blockIdx.x;
    cg::grid_group grid = cg::this_grid();
    volatile LAS unsigned* xb_misc = (volatile LAS unsigned*)((LAS unsigned char*)lds + 131072 + 320);
    if (threadIdx.x < 32) xb_misc[threadIdx.x] = 0u;
    __syncthreads();
    XcdBarrier xbar = xcd_barrier_post((unsigned*)a.ws, xb_misc + 8);

    int nfin = 0;
    for (int st = a.ph_lo; st < a.ph_hi; ++st) {
        const int ph = (int)(((st < 16 ? (unsigned long long)SEQ_LO >> (4 * st) : (unsigned long long)SEQ_HI >> (4 * (st - 16)))) & 15ull);
        int tid = threadIdx.x;
        const CAS unsigned char* kp = (const CAS unsigned char*)__builtin_amdgcn_kernarg_segment_ptr();
        asm volatile("" : "+v"(tid)); asm volatile("" : "+s"(kp));
        unsigned char* ws = *(unsigned char* const CAS*)(kp + 168); float* out = *(float* const CAS*)(kp + 160);
        const int lane = tid & 63, wave = __builtin_amdgcn_readfirstlane(tid >> 6);
        LAS unsigned char* lds3 = (LAS unsigned char*)lds;
        if (ph == 0 && PHEN(0)) {
            LAS float* scr = (LAS float*)(lds3 + wave * 16384);
            const int gw = bid * NWAVES + wave, NGW = G * NWAVES;
            constexpr int J_1 = 32 * 56, J_2 = 32 * 32, J_U = 32 * 128, J_D = 128 * 32;
            for (int it = gw; it < J_1 + J_2 + J_U + J_D; it += NGW) {
                int r = it;
                if (r < J_1) { tr64_item(INP(8), 2048, 3584, (bf16*)(ws + WS_W1), INP(5), scr, r, lane); continue; } r -= J_1;
                if (r < J_2) { tr64_item(INP(9), 2048, 2048, (bf16*)(ws + WS_W2), nullptr, scr, r, lane); continue; } r -= J_2;
                if (r < J_U) { tr64_item(INP(18), 2048, 8192, (bf16*)(ws + WS_WU0), INP(6), scr, r, lane); continue; } r -= J_U;
                tr64_item(INP(19), 8192, 2048, (bf16*)(ws + WS_WD0), nullptr, scr, r, lane);
            }
            CONV_RANGE(920, 2046, bid, G); CONV_RANGE(12572, 13312, bid, G);
            for (int m = gw; m < M; m += NGW) {
                const float* xr = m < MP ? xp + (size_t)m * D : xs + (size_t)(m - MP) * D;
                f32x4 v[8]; float s = 0.f;
#pragma unroll
                for (int j = 0; j < 8; ++j) { v[j] = __builtin_nontemporal_load((const f32x4*)(xr + 4 * lane + 256 * j)); s += (v[j][0] * v[j][0] + v[j][1] * v[j][1]) + (v[j][2] * v[j][2] + v[j][3] * v[j][3]); }
                s = wave_sum(s);
#pragma unroll
                for (int j = 0; j < 8; ++j) { v2u w; w.x = pk2(v[j][0], v[j][1]); w.y = pk2(v[j][2], v[j][3]); *(v2u*)(A1 + (size_t)m * D + 4 * lane + 256 * j) = w;
                    if (m >= MP) *(f32x4*)(H + (size_t)m * D + 4 * lane + 256 * j) = v[j]; }
                if (lane < 32) ss[(size_t)m * 32 + lane] = lane == 0 ? s : 0.f;
            }
            const int gt = bid * NTHR + tid, NGT = G * NTHR;
            for (int idx = gt; idx < M * 8; idx += NGT) {
                const int m = idx >> 3, i = idx & 7;
                const int pos = m < MP ? m : 2048 + ((m - MP) & 31);
                const float inv = i == 0 ? 1.f : i == 1 ? 1.939227432e-01f : i == 2 ? 3.760603070e-02f : i == 3 ? 7.292664610e-03f : i == 4 ? 1.414213562e-03f : i == 5 ? 2.742481884e-04f : i == 6 ? 5.318295734e-05f : 1.031338525e-05f;
                const float ang = (float)pos * inv;
                const float th = ang * 1.591549367e-01f, te = __builtin_fmaf(ang, 1.591549367e-01f, -th) + ang * 6.420638243e-09f;
                const float fr_ = (th - __builtin_rintf(th)) + te;
                cs[2 * idx] = __builtin_amdgcn_cosf(fr_); cs[2 * idx + 1] = __builtin_amdgcn_sinf(fr_);
            }
            const float* ck = INP(2); const float* cv = INP(3);
            for (int idx = gt; idx < 16 * 128 * 256; idx += NGT) {
                const int b = idx >> 15, rem = idx & 32767, j = rem >> 8, c = rem & 255;
                const float kv = ck[idx], vv = cv[idx];
                Ksb[(size_t)b * 40960 + rem] = (bf16)f2bf(kv);
                Vts[((size_t)b * 256 + c) * 160 + j] = (bf16)f2bf(vv);
                if (j >= 32) { out[O_KS + ((size_t)b * 128 + j - 32) * 256 + c] = kv; out[O_VS + ((size_t)b * 128 + j - 32) * 256 + c] = vv; }
            }
        } else if (ph == 1 && PHEN(1)) {
            pg8::Gemm g{A1, (const bf16*)(ws + WS_W1), M, NIN_E, D}; pg8::StaticOrder S; S.init(M, NIN_E, G, bid);
            pg8::EpiInEven E{ss, cs, Qb, Kpb, Ksb, Vtp, Vts, Ub, GVr, out};
            pg8::gemm_phase<pg8::EpiInEven, pg8::StaticOrder, true, true>(lds3, g, S, E, tid);
            if (bid >= 220) CONV_RANGE(0, 650, bid - 220, 36);
        } else if (ph == 2 && PHEN(2)) {
            const int vb = (G & 7) == 0 ? (bid & 7) * (G >> 3) + (bid >> 3) : bid;
            for (int w_ = vb; w_ < 1216; w_ += G) {
                const int u = w_ < 512 ? w_ : w_ < 1024 ? w_ + 64 : w_ < 1088 ? w_ - 512 : w_;
                if (u < 576) {
                    bf16* Ks = (bf16*)lds; bf16* Vs = (bf16*)(lds + 27648);
                    const bf16* Kg; const bf16* Vg; int vstr, nkb;
                    if (u < 512) { const int c = u >> 2, kvh = u & 3, kc0 = c > 2 ? c - 2 : 0; nkb = (c - kc0 + 1) * 2;
                        Kg = Kpb + (size_t)(kc0 * 64) * 256 + kvh * 64; Vg = Vtp + (size_t)(kvh * 64) * 8192 + kc0 * 64; vstr = 8192; }
                    else { const int su = u - 512, b = su >> 2, kvh = su & 3; nkb = 5;
                        Kg = Ksb + (size_t)b * 40960 + kvh * 64; Vg = Vts + ((size_t)b * 256 + kvh * 64) * 160; vstr = 160; }
                    const int nkeys = nkb * 32, cpr = nkeys >> 3;
                    for (int p = tid; p < nkeys * 8; p += NTHR) { const int row = p >> 3, ch = p & 7; *(v4u*)(Ks + row * 72 + ch * 8) = *(const v4u*)(Kg + (size_t)row * 256 + ch * 8); }
                    for (int p = tid; p < 64 * cpr; p += NTHR) { const int dd = p / cpr, ch = p - dd * cpr; *(v4u*)(Vs + dd * 200 + ch * 8) = *(const v4u*)(Vg + (size_t)dd * vstr + ch * 8); }
                    __syncthreads();
                    if (u < 512) { const int c = u >> 2, kvh = u & 3, hq = kvh * 4 + (wave >> 1), tok0 = c * 64 + (wave & 1) * 32;
                        attn_wave(Qb + (size_t)tok0 * 1024 + hq * 64, Ks, 72, Vs, 200, nkb, INP(10)[hq], A2 + (size_t)tok0 * 2048 + hq * 64, lane);
                    } else if (wave < 4) { const int su = u - 512, b = su >> 2, kvh = su & 3, hq = kvh * 4 + wave;
                        attn_wave(Qb + (size_t)(MP + b * 32) * 1024 + hq * 64, Ks, 72, Vs, 200, nkb, INP(10)[hq], A2 + (size_t)(MP + b * 32) * 2048 + hq * 64, lane); }
                    __syncthreads();
                } else if (u < 1088) {
                    const int gu = u - 576;
                    gmlp_unit(lds, GVr, Ub, INP(11), INP(12), INP(13), A2, nullptr, (gu >> 3) * 128, 128, gu & 7, tid);
                } else {
                    const int gu = u - 1088, b = gu >> 3;
                    gmlp_unit(lds, GVr, Ub, INP(11), INP(12), INP(13), A2, out + O_GV + (size_t)b * 32 * 1024, MP + b * 32, 32, gu & 7, tid);
                }
            }
        } else if (ph == 3 && PHEN(3)) {
            pg8::Gemm g{A2, (const bf16*)(ws + WS_W2), M, D, D}; pg8::SplitOrder S; S.init(bid, D);
            pg8::EpiRes<true> E{xp, xs, H, A1, ss + SSN, (float*)(ws + WS_BIG)};
            pg8::gemm_phase<pg8::EpiRes<true>, pg8::SplitOrder, true, true>(lds3, g, S, E, tid);
            if (bid >= 128) CONV_RANGE(650, 920, bid - 128, 128);
        } else if ((ph == 4 || ph == 10) && PHEN(ph)) {
#ifdef DBG_HIDFILL
            { const int gt = bid * NTHR + tid, NGT = G * NTHR;
              for (size_t i = gt; i < (size_t)M * DFF / 2; i += NGT) { const unsigned a_ = (unsigned)((i * 37u) & 255u); ((unsigned*)HID)[i] = pk2((float)a_ * (1.f / 256.f), (float)(255u - a_) * (1.f / 512.f)); } }
            if (false)
#endif
            {
            pg8::Gemm g{A1, (const bf16*)(ws + (ph == 4 ? WS_WU0 : WS_WU1)), M, DFF, D}; pg8::StaticOrder S; S.init(M, DFF, G, bid);
            pg8::EpiUp E{ss + (ph == 4 ? SSN : 3 * SSN), HID};
            pg8::gemm_phase<pg8::EpiUp, pg8::StaticOrder, true, true>(lds3, g, S, E, tid);
            }
            if (bid >= 64) {
                if (ph == 4) CONV_RANGE(2046, 5120, bid - 64, 192); else CONV_RANGE(9498, 12572, bid - 64, 192);
            }
        } else if ((ph == 5 || ph == 9 || ph == 11) && PHEN(ph)) {
            const bf16* Aop = ph == 9 ? A2 : HID; const bf16* Bop = (const bf16*)(ws + (ph == 5 ? WS_WD0 : ph == 9 ? WS_W6 : WS_WD1));
            pg8::Gemm g{Aop, Bop, M, D, ph == 9 ? D : DFF}; pg8::SplitOrder S; S.init(bid, ph == 9 ? D : DFF);
#ifndef DBG_P5X
#define DBG_P5X false
#endif
            pg8::EpiRes<DBG_P5X> E{xp, xs, H, A1, ss + (ph == 5 ? 2 * SSN : ph == 9 ? 3 * SSN : 4 * SSN), (float*)(ws + (ph == 9 ? WS_BIG : WS_A2))};
            pg8::gemm_phase<pg8::EpiRes<DBG_P5X>, pg8::SplitOrder, true, true>(lds3, g, S, E, tid);
            if (bid >= 128) { if (ph == 5) CONV_RANGE(5120, 6156, bid - 128, 128); else if (ph == 9) CONV_RANGE(9230, 9498, bid - 128, 128); }
        } else if (ph == 6 && PHEN(6)) {
            pg8::Gemm g{A1, (const bf16*)(ws + WS_W5), M, DFF, D}; pg8::StaticOrder S; S.init(M, DFF, G, bid);
            pg8::EpiInOdd E{ss + 2 * SSN, INP(16), QH, FH, VH, GH};
            pg8::gemm_phase<pg8::EpiInOdd, pg8::StaticOrder, true, true>(lds3, g, S, E, tid);
            if (bid >= 64) CONV_RANGE(6156, 9230, bid - 64, 192);
        } else if (ph == 7 && PHEN(7)) {
            for (int u = bid; u < 240; u += G) { const int hd = u / 15, g = u % 15;
                hg_unit<false>(lds, QH, FH, VH, GH, INP(17), A2, hd, g * 512, 16, 0, nullptr, SEG, DEC, 0, SEG + (size_t)(hd * 16 + g) * 16384, DEC + (size_t)(hd * 16 + g) * 128, tid, DEC + 32768 + hd * 16 + g); }
        } else if (ph == 14 && PHEN(14)) {
            const int gt = bid * NTHR + tid, NGT = G * NTHR;
            for (int el = gt; el < 16 * 16384; el += NGT) {
                const int hd = el >> 14, de = el & 16383, dd = de >> 7;
                float L[15], Dg[15];
#pragma unroll
                for (int g = 0; g < 15; ++g) { L[g] = SEG[(size_t)(hd * 16 + g) * 16384 + de]; Dg[g] = DEC[(size_t)(hd * 16 + g) * 128 + dd]; }
                float acc = 0.f;
#pragma unroll
                for (int g = 0; g < 15; ++g) { acc = Dg[g] * acc + L[g]; SEG[(size_t)(hd * 16 + g) * 16384 + de] = acc; }
            }
        } else if (ph == 8 && PHEN(8)) {
            for (int u = bid; u < 512; u += G) {
                if (u < 256) { const int hd = u >> 4, g = u & 15;
                    hg_unit<true>(lds, QH, FH, VH, GH, INP(17), A2, hd, g * 512, 16, g ? 1 : 0, SEG + (size_t)(hd * 16 + (g ? g - 1 : 0)) * 16384, SEG, DEC, g, g == 15 ? out + O_SP + (size_t)hd * 16384 : nullptr, nullptr, tid);
                } else { const int su = u - 256, b = su >> 4, hd = su & 15;
                    hg_unit<true>(lds, QH, FH, VH, GH, INP(17), A2, hd, MP + b * 32, 1, 1, INP(4) + (size_t)(b * 16 + hd) * 16384, SEG, DEC, 0, out + O_SS + (size_t)(b * 16 + hd) * 16384, nullptr, tid); }
            }
        } else if (ph == 13 && PHEN(13)) {
            const int ssi = ++nfin;
            const float* part = (const float*)(ws + ((ssi & 1) == 0 ? WS_A2 : WS_BIG));
            const int gw = bid * NWAVES + wave, NGW = G * NWAVES;
            for (int it = gw; it < 512 * 4; it += NGW) {
                const int rs = it >> 2, qd = it & 3, m = MP + rs; const size_t co = (size_t)qd * 512 + 4 * lane;
                f32x4 h0 = *(const f32x4*)(H + (size_t)m * D + co), h1 = *(const f32x4*)(H + (size_t)m * D + co + 256);
#pragma unroll
                for (int sl = 0; sl < 8; ++sl) { const float* pp = part + ((size_t)sl * 512 + rs) * D + co; h0 += __builtin_nontemporal_load((const f32x4*)pp); h1 += __builtin_nontemporal_load((const f32x4*)(pp + 256)); }
                *(f32x4*)(H + (size_t)m * D + co) = h0; *(f32x4*)(H + (size_t)m * D + co + 256) = h1;
                v2u w; w.x = pk2(h0[0], h0[1]); w.y = pk2(h0[2], h0[3]); *(v2u*)(A1 + (size_t)m * D + co) = w;
                w.x = pk2(h1[0], h1[1]); w.y = pk2(h1[2], h1[3]); *(v2u*)(A1 + (size_t)m * D + co + 256) = w;
                float sq = ((h0[0] * h0[0] + h0[1] * h0[1]) + (h0[2] * h0[2] + h0[3] * h0[3])) + ((h1[0] * h1[0] + h1[1] * h1[1]) + (h1[2] * h1[2] + h1[3] * h1[3]));
                sq = wave_sum(sq);
                if (lane < 8) ss[(size_t)ssi * SSN + (size_t)m * 32 + qd * 8 + lane] = lane == 0 ? sq : 0.f;
            }
        } else if (ph == 12 && PHEN(12)) {
            const int gw = bid * NWAVES + wave, NGW = G * NWAVES;
            for (int m = gw; m < M; m += NGW) {
                f32x4 hv[8]; float sq = 0.f;
#ifdef DBG_DUMPQH
#pragma unroll
                for (int j = 0; j < 8; ++j) *(f32x4*)(out + (size_t)m * D + 4 * lane + 256 * j) = *(const f32x4*)(DBG_DUMPQH + (size_t)m * D + 4 * lane + 256 * j);
                continue;
#endif
#ifdef DBG_DUMPA2
                if (DBG_DUMPA2 == 2 && (m >= MP || (m & 511) < 64)) continue;
                if (DBG_DUMPA2 == 3 && m < MP) continue;
#pragma unroll
                for (int j = 0; j < 8; ++j) { const v2u w = *(const v2u*)(DBG_A2PTR + (size_t)m * D + 4 * lane + 256 * j);
                    *(f32x4*)(out + (size_t)m * D + 4 * lane + 256 * j) = (f32x4){bf2f((unsigned short)(w.x & 0xffff)), bf2f((unsigned short)(w.x >> 16)), bf2f((unsigned short)(w.y & 0xffff)), bf2f((unsigned short)(w.y >> 16))}; }
                continue;
#endif
#pragma unroll
                for (int j = 0; j < 8; ++j) { hv[j] = __builtin_nontemporal_load((const f32x4*)(H + (size_t)m * D + 4 * lane + 256 * j));
                    if (m >= MP) {
#pragma unroll
                        for (int sl = 0; sl < 8; ++sl) hv[j] += __builtin_nontemporal_load((const f32x4*)((const float*)(ws + WS_A2) + ((size_t)sl * 512 + (m - MP)) * D + 4 * lane + 256 * j)); } sq += (hv[j][0] * hv[j][0] + hv[j][1] * hv[j][1]) + (hv[j][2] * hv[j][2] + hv[j][3] * hv[j][3]); }
                const float rstd = rsqrtf(wave_sum(sq) * (1.f / 2048.f) + 1e-6f);
#pragma unroll
                for (int j = 0; j < 8; ++j) { const f32x4 gn = *(const f32x4*)(INP(7) + 4 * lane + 256 * j);
                    __builtin_nontemporal_store(hv[j] * rstd * gn, (f32x4*)(out + (size_t)m * D + 4 * lane + 256 * j)); }
            }
        }
        if (st + 1 < a.ph_hi) { if (a.ph_lo < 0) grid.sync(); else xcd_barrier(xbar); }
    }
#ifdef EXTRA_SYNC
    for (int i = 0; i < EXTRA_SYNC; ++i) xcd_barrier(xbar);
#endif
}

#undef xp
#undef xs
#undef ss
#undef cs
#undef A1
#undef A2
#undef H
#undef HID
#undef Qb
#undef Kpb
#undef Ksb
#undef Vtp
#undef Vts
#undef Ub
#undef GVr
#undef QH
#undef FH
#undef VH
#undef GH
#undef SEG
#undef DEC
#undef CONV_L1
#undef CONV_RANGE
extern "C" void kernel_launch(void* const* d_in, const int* in_sizes, int n_in, void* d_out, int out_size, void* d_ws, size_t ws_size, hipStream_t stream) {
    static int grid = 0;
    if (grid == 0) {
        if (n_in != 20 || ws_size < WS_END) { fprintf(stderr, "kernel_launch: unexpected n_in %d / ws %zu\n", n_in, ws_size); grid = -1; return; }
        int dev = 0, cus = 0, per_cu = 0;
        (void)hipGetDevice(&dev); (void)hipDeviceGetAttribute(&cus, hipDeviceAttributeMultiprocessorCount, dev);
        if (hipFuncSetAttribute((const void*)mk_fwd, hipFuncAttributeMaxDynamicSharedMemorySize, LDS_BYTES) != hipSuccess) { fprintf(stderr, "kernel_launch: hipFuncSetAttribute failed\n"); grid = -1; return; }
        if (hipOccupancyMaxActiveBlocksPerMultiprocessor(&per_cu, (const void*)mk_fwd, NTHR, LDS_BYTES) != hipSuccess || per_cu < 1) { fprintf(stderr, "kernel_launch: occupancy query says %d\n", per_cu); per_cu = 1; }
        (void)hipGetLastError();
        grid = cus * 1;
        if (grid <= 0) grid = 256;
    }
    if (grid < 0) return;
    (void)hipMemsetAsync(d_ws, 0, 65536, stream);
    Args a{};
    for (int i = 0; i < 20; ++i) a.in[i] = (const float*)d_in[i];
    a.out = (float*)d_out; a.ws = (unsigned char*)d_ws;
#ifdef DBG_FILL
    (void)hipMemsetAsync(d_out, 0, (size_t)23920640 * 4, stream);
#endif
#if MK_PER_PHASE
    for (int ph = 0; ph < NPH; ++ph) { a.ph_lo = ph; a.ph_hi = ph + 1; hipLaunchKernelGGL(mk_fwd, dim3(grid), dim3(NTHR), LDS_BYTES, stream, a); }
#else
    a.ph_lo = 0; a.ph_hi = SEQ_N;
    void* args[] = {&a};
    hipError_t e = hipLaunchCooperativeKernel((const void*)mk_fwd, dim3(grid), dim3(NTHR), args, LDS_BYTES, stream);
    if (e != hipSuccess) fprintf(stderr, "cooperative launch failed: %s (grid %d)\n", hipGetErrorString(e), grid);
#endif
}
```

```cpp
#include <hip/hip_runtime.h>
#include <hip/hip_cooperative_groups.h>
#include <cstdio>
#include <cstdint>
namespace cg = cooperative_groups;
namespace pg8 {
#define PG8_LAS __attribute__((address_space(3)))
typedef unsigned short bf16_t;
typedef short bf16x8 __attribute__((ext_vector_type(8)));
typedef float f32x4 __attribute__((ext_vector_type(4)));
typedef unsigned u32x4 __attribute__((ext_vector_type(4)));
constexpr int BM = 256, BK = 64, HALF = 128, HTB = HALF * BK * 2  , STAGE_BYTES = 8 * HTB, NXCD = 8, WGM = 8;

__host__ __device__ __forceinline__ int lds_byte(int r, int c) { const int st = (r >> 4) * 2 + (c >> 5), rr = r & 15, cc = c & 31, ob = rr * 64 + cc * 2; return st * 1024 + (ob ^ (((ob >> 9) & 1) << 5)); }
__host__ __device__ __forceinline__ void stage_rc(int b, int& R, int& C) { const int st = b / 1024, sb = b % 1024, swz = sb ^ (((sb >> 9) & 1) << 5); R = (st >> 1) * 16 + swz / 64; C = (st & 1) * 32 + (swz % 64) / 2; }
__host__ __device__ __forceinline__ int perm32(int rho) { const int n = rho >> 4, i = rho & 15; return 8 * (i >> 2) + 4 * n + (i & 3); }

struct Unit { int pm, pn, k0, nt, part; };
struct Gemm { const bf16_t* A; const bf16_t* Bt; int M, N, K; };

struct StaticOrder {
    int nM, nN, nwg, G, c, ntk;
    __host__ __device__ void init(int M, int N, int G_, int c_, int K_ = 2048) { nM = M / BM; nN = N / BM; nwg = nM * nN; G = G_; c = c_; ntk = K_ / BK; }
    __host__ __device__ bool next(int i, Unit& u) const {
        const long L = (long)i * G + c; if (L >= nwg) return false;
        int wgid = (int)L; { const int q = nwg / NXCD, r = nwg % NXCD, xcd = wgid % NXCD, off = wgid / NXCD; wgid = (xcd < r ? xcd * (q + 1) : r * (q + 1) + (xcd - r) * q) + off; }
        const int nig = WGM * nN, gid = wgid / nig, fm = gid * WGM, gsz = (nM - fm) < WGM ? (nM - fm) : WGM;
        u.pm = fm + ((wgid % nig) % gsz); u.pn = (wgid % nig) / gsz; u.k0 = 0; u.nt = ntk; u.part = 0; return true;
    }
    __device__ __forceinline__ void a_ready(const Unit&) const {}
    __device__ __forceinline__ void done(const Unit&) const {}
};
struct SplitOrder {
    int c, ntk, nsl;
    __host__ __device__ void init(int c_, int K_) { c = c_; ntk = K_ / BK; nsl = 8; }
    __host__ __device__ bool next(int i, Unit& u) const {
        if (i == 0) { const int wgid = (c % 8) * 32 + c / 8, w = wgid % 64; u.pm = (wgid / 64) * 8 + (w % 8); u.pn = w / 8; u.k0 = 0; u.nt = ntk; u.part = 0; return true; }
        if (i == 1 && c < 16 * nsl) { const int ts = c / nsl, sl = c % nsl; u.pm = 32 + (ts >> 3); u.pn = ts & 7; u.nt = ntk / nsl; u.k0 = sl * u.nt; u.part = 1 + sl; return true; }
        return false;
    }
    __device__ __forceinline__ void a_ready(const Unit&) const {}
    __device__ __forceinline__ void done(const Unit&) const {}
};

typedef float f32x2c_t __attribute__((ext_vector_type(2))); typedef __bf16 bf16x2c_t __attribute__((ext_vector_type(2)));
__device__ __forceinline__ unsigned cvt_pk_bf16(float lo, float hi) { const f32x2c_t v = {lo, hi}; const bf16x2c_t b = __builtin_convertvector(v, bf16x2c_t); return __builtin_bit_cast(unsigned, b); }
typedef float f32x2 __attribute__((ext_vector_type(2)));
typedef unsigned u32x2 __attribute__((ext_vector_type(2)));
constexpr int O_YP = 0, O_YS = 16777216, O_KP = 17825792, O_VP = 17858560, O_KS = 17891328, O_VS = 18415616, O_GV = 18939904, O_SP = 19464192, O_SS = 19726336;
constexpr int MROWS = 8704, MPR = 8192, DM = 2048;
__device__ __forceinline__ unsigned short f2bf1(float f) { unsigned u = __builtin_bit_cast(unsigned, f); return (unsigned short)((u + 0x7fffu + ((u >> 16) & 1u)) >> 16); }
__device__ __forceinline__ float gelu_tanh(float x) {
    const float uu = 0.7978845608028654f * (x + 0.044715f * x * x * x);
    const float e = __expf(2.f * uu);
    const float t = 1.f - 2.f * __builtin_amdgcn_rcpf(e + 1.f);
    return 0.5f * x * (1.f + t);
}
__device__ __forceinline__ float sigm(float x) { return __builtin_amdgcn_rcpf(1.f + __expf(-x)); }

__device__ __forceinline__ float xsum16(float s) { const auto r = __builtin_amdgcn_permlane16_swap(__builtin_bit_cast(unsigned, s), __builtin_bit_cast(unsigned, s), false, false); return __builtin_bit_cast(float, r[0]) + __builtin_bit_cast(float, r[1]); }
__device__ __forceinline__ float xsum32(float s) { const auto r = __builtin_amdgcn_permlane32_swap(__builtin_bit_cast(unsigned, s), __builtin_bit_cast(unsigned, s), false, false); return __builtin_bit_cast(float, r[0]) + __builtin_bit_cast(float, r[1]); }
__device__ __forceinline__ float xpart32(float v, bool upper) { const auto r = __builtin_amdgcn_permlane32_swap(__builtin_bit_cast(unsigned, v), __builtin_bit_cast(unsigned, v), false, false); return __builtin_bit_cast(float, upper ? r[0] : r[1]); }
__device__ __forceinline__ float row_rstd(const float* ssp, int row, int fq) {
    const float* p = ssp + (size_t)row * 32 + fq * 8;
    const f32x4 a = *(const f32x4*)p, b = *(const f32x4*)(p + 4);
    float t = ((a[0] + a[1]) + (a[2] + a[3])) + ((b[0] + b[1]) + (b[2] + b[3]));
    t += __shfl_xor(t, 16); t += __shfl_xor(t, 32);
    return rsqrtf(t * (1.f / 2048.f) + 1e-6f);
}
struct EpiInEven {
    static constexpr bool PERM = false, AFTER_DRAIN = false;
    const float* ss; const float* cs; bf16_t *Q, *Kp, *Ks, *Vtp, *Vts, *U; float* GVr; float* out;
    template <int KIND> __device__ __forceinline__ void body(const f32x4 (&acc)[2][2][4][2], const Unit& u, int wr, int wc, int fr, int fq) const {
        const int pn = u.pn;
        const float* ssk = ss; int frk = fr; asm volatile("" : "+v"(frk), "+v"(fq)); asm volatile("" : "+s"(wc), "+s"(wr));
        float rs8[8];
#pragma unroll
        for (int q = 0; q < 8; ++q) rs8[q] = row_rstd(ssk, u.pm * BM + (q >> 2) * HALF + wr * 64 + (q & 3) * 16 + frk, fq);
#pragma unroll
        for (int ai = 0; ai < 2; ++ai)
#pragma unroll
            for (int m = 0; m < 4; ++m) {
                const int row = u.pm * BM + ai * HALF + wr * 64 + m * 16 + frk;
                const float rstd = rs8[ai * 4 + m];
                const bool smp = row >= MPR; const int sb = (row - MPR) >> 5, st = (row - MPR) & 31;
#pragma unroll
                for (int bj = 0; bj < 2; ++bj)
#pragma unroll
                    for (int n = 0; n < 2; ++n) {
                        f32x4 v = acc[ai][bj][m][n] * rstd;
                        const int cl = bj * HALF + wc * 32 + n * 16 + fq * 4;
                        if (KIND <= 1) {
                            if (n == 0 && (wc & 1) == 0) {
                                f32x4 p; p[0] = __shfl_xor(v[0], 32); p[1] = __shfl_xor(v[1], 32); p[2] = __shfl_xor(v[2], 32); p[3] = __shfl_xor(v[3], 32);
                                const f32x4 c0 = *(const f32x4*)(cs + (size_t)row * 16 + (fq & 1) * 8), c1 = *(const f32x4*)(cs + (size_t)row * 16 + (fq & 1) * 8 + 4);
                                const float sg = (fq < 2) ? -1.f : 1.f;
                                v[0] = v[0] * c0[0] + sg * p[0] * c0[1]; v[1] = v[1] * c0[2] + sg * p[1] * c0[3];
                                v[2] = v[2] * c1[0] + sg * p[2] * c1[1]; v[3] = v[3] * c1[2] + sg * p[3] * c1[3];
                            }
                            if (KIND == 0) {
                                v = v * 0.125f; u32x2 w; w.x = cvt_pk_bf16(v[0], v[1]); w.y = cvt_pk_bf16(v[2], v[3]);
                                *(u32x2*)(Q + (size_t)row * 1024 + pn * 256 + cl) = w;
                            } else {
                                u32x2 w; w.x = cvt_pk_bf16(v[0], v[1]); w.y = cvt_pk_bf16(v[2], v[3]);
                                if (smp) { *(u32x2*)(Ks + ((size_t)(sb * 160 + 128 + st)) * 256 + cl) = w; *(f32x4*)(out + O_KS + ((size_t)(sb * 128 + 96 + st)) * 256 + cl) = v; }
                                else { *(u32x2*)(Kp + (size_t)row * 256 + cl) = w; if (row >= MPR - 128) *(f32x4*)(out + O_KP + (size_t)(row - (MPR - 128)) * 256 + cl) = v; }
                            }
                        } else if (KIND == 2) {
                            if (smp) { *(f32x4*)(out + O_VS + ((size_t)(sb * 128 + 96 + st)) * 256 + cl) = v;
#pragma unroll
                                for (int j = 0; j < 4; ++j) Vts[((size_t)(sb * 256 + cl + j)) * 160 + 128 + st] = f2bf1(v[j]); }
                            else { if (row >= MPR - 128) *(f32x4*)(out + O_VP + (size_t)(row - (MPR - 128)) * 256 + cl) = v;
#pragma unroll
                                for (int j = 0; j < 4; ++j) Vtp[(size_t)(cl + j) * MPR + row] = f2bf1(v[j]); }
                        } else if (KIND == 3) {
                            u32x2 w; w.x = cvt_pk_bf16(gelu_tanh(v[0]), gelu_tanh(v[1])); w.y = cvt_pk_bf16(gelu_tanh(v[2]), gelu_tanh(v[3]));
                            *(u32x2*)(U + (size_t)row * 1024 + (pn - 6) * 256 + cl) = w;
                        } else {
                            f32x4 g; g[0] = gelu_tanh(v[0]); g[1] = gelu_tanh(v[1]); g[2] = gelu_tanh(v[2]); g[3] = gelu_tanh(v[3]);
                            *(f32x4*)(GVr + (size_t)row * 1024 + (pn - 10) * 256 + cl) = g;
                        }
                        asm volatile("" ::: "memory");
                    }
            }
    }
    __device__ __forceinline__ void operator()(const f32x4 (&acc)[2][2][4][2], const Unit& u, int wr, int wc, int fr, int fq) const {
        const int pn = u.pn;
        if (pn < 4) body<0>(acc, u, wr, wc, fr, fq);
        else if (pn == 4) body<1>(acc, u, wr, wc, fr, fq);
        else if (pn == 5) body<2>(acc, u, wr, wc, fr, fq);
        else if (pn < 10) body<3>(acc, u, wr, wc, fr, fq);
        else body<4>(acc, u, wr, wc, fr, fq);
    }
};
template <bool FROMX> struct EpiRes {
    static constexpr bool PERM = false, AFTER_DRAIN = false;
    const float* xp; const float* xs; float* H; bf16_t* Hb; float* ssout; float* part;
    __device__ __forceinline__ void operator()(const f32x4 (&acc)[2][2][4][2], const Unit& u, int wr, int wc, int fr, int fq) const {
        asm volatile("" : "+v"(fr), "+v"(fq), "+s"(wc), "+s"(wr));
        if (u.part) {
#pragma unroll
            for (int ai = 0; ai < 2; ++ai)
#pragma unroll
                for (int m = 0; m < 4; ++m) {
                    float* hp = part + ((size_t)(u.part - 1) * 512 + (size_t)((u.pm - 32) * BM + ai * HALF + wr * 64 + m * 16 + fr)) * DM + u.pn * BM + wc * 32 + fq * 4;
#pragma unroll
                    for (int bj = 0; bj < 2; ++bj)
#pragma unroll
                        for (int n = 0; n < 2; ++n) *(f32x4*)(hp + bj * HALF + n * 16) = acc[ai][bj][m][n];
                    asm volatile("" ::: "memory");
                }
            return;
        }
        const int colb = u.pn * BM + wc * 32 + fq * 4;
        f32x4 bcur[4], bnxt[4];
        { const int row = u.pm * BM + wr * 64 + fr; const float* base = FROMX ? (row < MPR ? xp + (size_t)row * DM : xs + (size_t)(row - MPR) * DM) : H + (size_t)row * DM;
#pragma unroll
          for (int p = 0; p < 4; ++p) bcur[p] = *(const f32x4*)(base + colb + (p >> 1) * HALF + (p & 1) * 16); }
#pragma unroll
        for (int q = 0; q < 8; ++q) {
            const int ai = q >> 2, m = q & 3;
            const int row = u.pm * BM + ai * HALF + wr * 64 + m * 16 + fr;
            if (q < 7) { const int rown = u.pm * BM + ((q + 1) >> 2) * HALF + wr * 64 + ((q + 1) & 3) * 16 + fr;
                const float* basen = FROMX ? (rown < MPR ? xp + (size_t)rown * DM : xs + (size_t)(rown - MPR) * DM) : H + (size_t)rown * DM;
#pragma unroll
                for (int p = 0; p < 4; ++p) bnxt[p] = *(const f32x4*)(basen + colb + (p >> 1) * HALF + (p & 1) * 16); }
            float s = 0.f;
#pragma unroll
            for (int p = 0; p < 4; ++p) {
                const int bj = p >> 1, n = p & 1, col = colb + bj * HALF + n * 16;
                const f32x4 h = bcur[p] + acc[ai][bj][m][n];
                *(f32x4*)(H + (size_t)row * DM + col) = h;
                u32x2 w; w.x = cvt_pk_bf16(h[0], h[1]); w.y = cvt_pk_bf16(h[2], h[3]);
                *(u32x2*)(Hb + (size_t)row * DM + col) = w;
                s += (h[0] * h[0] + h[1] * h[1]) + (h[2] * h[2] + h[3] * h[3]);
            }
            s += __shfl_xor(s, 16); s += __shfl_xor(s, 32);
            if (fq == 0) ssout[(size_t)row * 32 + u.pn * 4 + wc] = s;
#pragma unroll
            for (int p = 0; p < 4; ++p) bcur[p] = bnxt[p];
        }
    }
};
struct EpiUp {
    static constexpr bool PERM = true, AFTER_DRAIN = false;
    const float* ss; bf16_t* HID;
    __device__ __forceinline__ void operator()(const f32x4 (&acc)[2][2][4][2], const Unit& u, int wr, int wc, int fr, int fq) const {
        asm volatile("" : "+v"(fr), "+v"(fq), "+s"(wc), "+s"(wr));
        float rs8[8];
#pragma unroll
        for (int q = 0; q < 8; ++q) rs8[q] = row_rstd(ss, u.pm * BM + (q >> 2) * HALF + wr * 64 + (q & 3) * 16 + fr, fq);
#pragma unroll
        for (int ai = 0; ai < 2; ++ai)
#pragma unroll
            for (int m = 0; m < 4; ++m) {
                const int row = u.pm * BM + ai * HALF + wr * 64 + m * 16 + fr;
                const float rstd = rs8[ai * 4 + m];
                bf16_t* rowp = HID + (size_t)row * 8192 + u.pn * BM + wc * 32 + 8 * fq;
#pragma unroll
                for (int bj = 0; bj < 2; ++bj) {
                    f32x4 v0 = acc[ai][bj][m][0] * rstd, v1 = acc[ai][bj][m][1] * rstd;
#pragma unroll
                    for (int j = 0; j < 4; ++j) { const float a = fmaxf(v0[j], 0.f), b = fmaxf(v1[j], 0.f); v0[j] = a * a; v1[j] = b * b; }
                    u32x4 w; w.x = cvt_pk_bf16(v0[0], v0[1]); w.y = cvt_pk_bf16(v0[2], v0[3]); w.z = cvt_pk_bf16(v1[0], v1[1]); w.w = cvt_pk_bf16(v1[2], v1[3]);
                    *(u32x4*)(rowp + bj * HALF) = w;
                }
            }
    }
};
struct EpiInOdd {
    static constexpr bool PERM = true, AFTER_DRAIN = false;
    const float* ss; const float* lbw; float* QH; float* FH; bf16_t* VH; bf16_t* GH;
    __device__ __forceinline__ void operator()(const f32x4 (&acc)[2][2][4][2], const Unit& u, int wr, int wc, int fr, int fq) const {
        const int sec = u.pn >> 3, pnl = u.pn & 7;
        asm volatile("" : "+v"(fr), "+v"(fq), "+s"(wc), "+s"(wr));
        float rs8[8];
#pragma unroll
        for (int q = 0; q < 8; ++q) rs8[q] = row_rstd(ss, u.pm * BM + (q >> 2) * HALF + wr * 64 + (q & 3) * 16 + fr, fq);
#pragma unroll
        for (int ai = 0; ai < 2; ++ai)
#pragma unroll
            for (int m = 0; m < 4; ++m) {
                const int row = u.pm * BM + ai * HALF + wr * 64 + m * 16 + fr;
                const float rstd = rs8[ai * 4 + m];
#pragma unroll
                for (int bj = 0; bj < 2; ++bj) {
                    f32x4 v0 = acc[ai][bj][m][0] * rstd, v1 = acc[ai][bj][m][1] * rstd;
                    const int col = pnl * BM + bj * HALF + wc * 32 + fq * 8;
                    if (sec == 0) {
#pragma unroll
                        for (int j = 0; j < 4; ++j) { v0[j] = v0[j] * sigm(v0[j]); v1[j] = v1[j] * sigm(v1[j]); }
                        *(f32x4*)(QH + (size_t)row * DM + col) = v0; *(f32x4*)(QH + (size_t)row * DM + col + 4) = v1;
                    } else if (sec == 1) {
                        const f32x4 l0a = *(const f32x4*)(lbw + col), l0b = *(const f32x4*)(lbw + col + 4), l1a = *(const f32x4*)(lbw + DM + col), l1b = *(const f32x4*)(lbw + DM + col + 4);
#pragma unroll
                        for (int j = 0; j < 4; ++j) { const float la = sigm(l1a[j] - l0a[j]), lb2 = sigm(l1b[j] - l0b[j]); v0[j] = la + (1.f - la) * sigm(v0[j]); v1[j] = lb2 + (1.f - lb2) * sigm(v1[j]); }
                        *(f32x4*)(FH + (size_t)row * DM + col) = v0; *(f32x4*)(FH + (size_t)row * DM + col + 4) = v1;
                    } else if (sec == 2) {
                        u32x4 w; w.x = cvt_pk_bf16(v0[0], v0[1]); w.y = cvt_pk_bf16(v0[2], v0[3]); w.z = cvt_pk_bf16(v1[0], v1[1]); w.w = cvt_pk_bf16(v1[2], v1[3]);
                        *(u32x4*)(VH + (size_t)row * DM + col) = w;
                    } else {
                        u32x4 w; w.x = cvt_pk_bf16(sigm(v0[0]), sigm(v0[1])); w.y = cvt_pk_bf16(sigm(v0[2]), sigm(v0[3])); w.z = cvt_pk_bf16(sigm(v1[0]), sigm(v1[1])); w.w = cvt_pk_bf16(sigm(v1[2]), sigm(v1[3]));
                        *(u32x4*)(GH + (size_t)row * DM + col) = w;
                    }
                }
            }
    }
};
template <class Epi, class Sched, bool ALIGN_EPI = false, bool SP2 = false>
__device__ __forceinline__ void gemm_phase(PG8_LAS unsigned char* lds, const Gemm g, const Sched& S, const Epi& E, const int tid) {
    const int wid = __builtin_amdgcn_readfirstlane(tid >> 6), lane = tid & 63, wr = wid >> 2, wc = wid & 3, fr = lane & 15, fq = lane >> 4;
    const int K = g.K;
    unsigned voffA[2], voffB[2];
#pragma unroll
    for (int i = 0; i < 2; ++i) { int R, C; stage_rc(tid * 16 + i * 8192, R, C); const int Rb = Epi::PERM ? ((R & ~31) + perm32(R & 31)) : R;
        voffA[i] = (unsigned)(R * K + C) * 2u; voffB[i] = (unsigned)(Rb * K + C) * 2u; }
    const size_t kstep = (size_t)(BK * 2);
    const size_t hstep = (size_t)HALF * K * 2;
    const size_t tstep = 2 * hstep;
    const unsigned ldsw = (unsigned)wid * 1024u;
    const int aoff = lds_byte(wr * 64 + fr, fq * 8), boff = lds_byte(wc * 32 + fr, fq * 8);
#define PG8_SA(b, h) (((b) * 2 + (h)) * HTB)
#define PG8_SB(b, h) ((4 + (b) * 2 + (h)) * HTB)
#define PG8_STAGE(bufoff, gbase, voff) do { _Pragma("unroll") for (int _i = 0; _i < 2; ++_i) \
        __builtin_amdgcn_global_load_lds((const unsigned*)((const char*)(gbase) + (voff)[_i]), (PG8_LAS unsigned*)(lds + (bufoff) + ldsw + _i * 8192), 16, 0, 0); } while (0)
#define PG8_LDA(dst, b, h) do { _Pragma("unroll") for (int m = 0; m < 4; ++m) _Pragma("unroll") for (int k = 0; k < 2; ++k) dst[m][k] = *(const PG8_LAS bf16x8*)(lds + PG8_SA(b, h) + aoff + m * 2048 + k * 1024); } while (0)
#define PG8_LDB(dst, b, h) do { _Pragma("unroll") for (int n = 0; n < 2; ++n) _Pragma("unroll") for (int k = 0; k < 2; ++k) dst[n][k] = *(const PG8_LAS bf16x8*)(lds + PG8_SB(b, h) + boff + n * 2048 + k * 1024); } while (0)
#define PG8_MMA(ai, bj, At, Bt) do { __builtin_amdgcn_s_setprio(1); _Pragma("unroll") for (int m = 0; m < 4; ++m) _Pragma("unroll") for (int n = 0; n < 2; ++n) _Pragma("unroll") for (int k = 0; k < 2; ++k) \
        acc[ai][bj][m][n] = __builtin_amdgcn_mfma_f32_16x16x32_bf16(Bt[n][k], At[m][k], acc[ai][bj][m][n], 0, 0, 0); __builtin_amdgcn_s_setprio(0); } while (0)
#define PG8_WAIT_V(n) asm volatile("s_waitcnt vmcnt(" #n ")" ::: "memory")
#define PG8_WAIT_L(n) asm volatile("s_waitcnt lgkmcnt(" #n ")" ::: "memory")
#define PG8_BAR __builtin_amdgcn_s_barrier()
#define PG8_SCHED __builtin_amdgcn_sched_barrier(0)
    Unit cur, nxt; int ui = 0;
    if (!S.next(0, cur)) return;
    f32x4 acc[2][2][4][2];
#pragma unroll
    for (int a = 0; a < 2; ++a)
#pragma unroll
        for (int b = 0; b < 2; ++b)
#pragma unroll
            for (int m = 0; m < 4; ++m)
#pragma unroll
                for (int n = 0; n < 2; ++n) acc[a][b][m][n] = (f32x4){0.f, 0.f, 0.f, 0.f};
    bf16x8 At[4][2], B0[2][2], B1[2][2];
    const char* cA = (const char*)g.A + (size_t)cur.pm * tstep + (size_t)cur.k0 * kstep; const char* cB = (const char*)g.Bt + (size_t)cur.pn * tstep + (size_t)cur.k0 * kstep;
    S.a_ready(cur);
    if constexpr (SP2) {
        PG8_STAGE(PG8_SB(0, 0), cB, voffB); PG8_STAGE(PG8_SB(0, 1), cB + hstep, voffB); PG8_STAGE(PG8_SA(0, 0), cA, voffA); PG8_STAGE(PG8_SA(0, 1), cA + hstep, voffA);
        if (wr == 1) PG8_BAR;
        PG8_WAIT_V(2); PG8_BAR;
        PG8_STAGE(PG8_SB(1, 0), cB + kstep, voffB); PG8_STAGE(PG8_SA(1, 0), cA + kstep, voffA); PG8_STAGE(PG8_SB(1, 1), cB + hstep + kstep, voffB);
        PG8_WAIT_V(6); PG8_BAR;
    } else {
        PG8_STAGE(PG8_SB(0, 0), cB, voffB); PG8_STAGE(PG8_SA(0, 0), cA, voffA); PG8_STAGE(PG8_SB(0, 1), cB + hstep, voffB); PG8_STAGE(PG8_SA(0, 1), cA + hstep, voffA);
        if (wr == 1) PG8_BAR;
        PG8_WAIT_V(4); PG8_BAR;
        PG8_STAGE(PG8_SB(1, 0), cB + kstep, voffB); PG8_STAGE(PG8_SA(1, 0), cA + kstep, voffA); PG8_STAGE(PG8_SB(1, 1), cB + hstep + kstep, voffB);
        PG8_WAIT_V(6); PG8_BAR;
    }
    for (;;) {
        const bool has_next = S.next(ui + 1, nxt);
        const char* nA = has_next ? (const char*)g.A + (size_t)nxt.pm * tstep + (size_t)nxt.k0 * kstep : cA; const char* nB = has_next ? (const char*)g.Bt + (size_t)nxt.pn * tstep + (size_t)nxt.k0 * kstep : cB;
        const int nt = cur.nt;
        for (int t = 0; t < nt; t += 2) {
            const bool last = (t == nt - 2);
            const char* a1 = cA + (size_t)(t + 1) * kstep;
            const char* a2 = last ? nA : cA + (size_t)(t + 2) * kstep; const char* b2 = last ? nB : cB + (size_t)(t + 2) * kstep;
            const char* a3 = a2 + kstep; const char* b3 = b2 + kstep;
            if (last && has_next) S.a_ready(nxt);
            if constexpr (SP2) {
            PG8_LDB(B0, 0, 0); PG8_LDB(B1, 0, 1); PG8_SCHED; PG8_LDA(At, 0, 0); PG8_STAGE(PG8_SA(1, 1), a1 + hstep, voffA);
            PG8_WAIT_V(8); PG8_WAIT_L(0); PG8_BAR; PG8_MMA(0, 0, At, B0); PG8_MMA(0, 1, At, B1); PG8_BAR; PG8_SCHED;
            PG8_LDA(At, 0, 1); PG8_STAGE(PG8_SB(0, 0), b2, voffB); PG8_STAGE(PG8_SB(0, 1), b2 + hstep, voffB); PG8_STAGE(PG8_SA(0, 0), a2, voffA);
            PG8_WAIT_V(8); PG8_WAIT_L(0); PG8_BAR; PG8_MMA(1, 0, At, B0); PG8_MMA(1, 1, At, B1); PG8_BAR; PG8_SCHED;
            PG8_LDB(B0, 1, 0); PG8_LDB(B1, 1, 1); PG8_SCHED; PG8_LDA(At, 1, 0); PG8_STAGE(PG8_SA(0, 1), a2 + hstep, voffA);
            PG8_WAIT_V(8); PG8_WAIT_L(0); PG8_BAR; PG8_MMA(0, 0, At, B0); PG8_MMA(0, 1, At, B1); PG8_BAR; PG8_SCHED;
            PG8_LDA(At, 1, 1); PG8_STAGE(PG8_SB(1, 0), b3, voffB); PG8_STAGE(PG8_SB(1, 1), b3 + hstep, voffB); PG8_STAGE(PG8_SA(1, 0), a3, voffA);
            PG8_WAIT_V(8); PG8_WAIT_L(0); PG8_BAR; PG8_MMA(1, 0, At, B0); PG8_MMA(1, 1, At, B1); PG8_BAR; PG8_SCHED;
            } else {
            PG8_LDB(B0, 0, 0); PG8_SCHED; PG8_LDA(At, 0, 0); PG8_STAGE(PG8_SA(1, 1), a1 + hstep, voffA);
            PG8_WAIT_L(8); PG8_BAR; PG8_WAIT_L(0); PG8_MMA(0, 0, At, B0); PG8_BAR; PG8_SCHED;
            PG8_LDB(B1, 0, 1); PG8_STAGE(PG8_SB(0, 0), b2, voffB);
            PG8_BAR; PG8_WAIT_L(0); PG8_MMA(0, 1, At, B1); PG8_BAR;
            PG8_LDA(At, 0, 1); PG8_STAGE(PG8_SA(0, 0), a2, voffA);
            PG8_BAR; PG8_WAIT_L(0); PG8_MMA(1, 0, At, B0); PG8_BAR; PG8_SCHED;
            PG8_STAGE(PG8_SB(0, 1), b2 + hstep, voffB);
            PG8_WAIT_V(6); PG8_BAR; PG8_MMA(1, 1, At, B1); PG8_BAR;
            PG8_LDB(B0, 1, 0); PG8_SCHED; PG8_LDA(At, 1, 0); PG8_STAGE(PG8_SA(0, 1), a2 + hstep, voffA);
            PG8_WAIT_L(8); PG8_BAR; PG8_WAIT_L(0); PG8_MMA(0, 0, At, B0); PG8_BAR; PG8_SCHED;
            PG8_LDB(B1, 1, 1); PG8_STAGE(PG8_SB(1, 0), b3, voffB);
            PG8_BAR; PG8_WAIT_L(0); PG8_MMA(0, 1, At, B1); PG8_BAR;
            PG8_LDA(At, 1, 1); PG8_STAGE(PG8_SA(1, 0), a3, voffA);
            PG8_BAR; PG8_WAIT_L(0); PG8_MMA(1, 0, At, B0); PG8_BAR; PG8_SCHED;
            PG8_STAGE(PG8_SB(1, 1), b3 + hstep, voffB);
            PG8_WAIT_V(6); PG8_BAR; PG8_MMA(1, 1, At, B1); PG8_BAR;
            }
        }
        if constexpr (ALIGN_EPI) { if (wr == 0) PG8_BAR; }
        if constexpr (!Epi::AFTER_DRAIN) { E(acc, cur, wr, wc, fr, fq); S.done(cur); }
        if (!has_next) break;
#pragma unroll
        for (int a = 0; a < 2; ++a)
#pragma unroll
            for (int b = 0; b < 2; ++b)
#pragma unroll
                for (int m = 0; m < 4; ++m)
#pragma unroll
                    for (int n = 0; n < 2; ++n) acc[a][b][m][n] = (f32x4){0.f, 0.f, 0.f, 0.f};
        cur = nxt; cA = nA; cB = nB; ++ui;
        if constexpr (ALIGN_EPI) { if (wr == 1) PG8_BAR; }
    }
    PG8_WAIT_V(0);
    if constexpr (!ALIGN_EPI) { if (wr == 0) PG8_BAR; }
    PG8_BAR;
    if constexpr (Epi::AFTER_DRAIN) { E.fused(acc, cur, wr, wc, fr, fq, lds, wid, lane); S.done(cur); }
#undef PG8_SA
#undef PG8_SB
#undef PG8_STAGE
#undef PG8_LDA
#undef PG8_LDB
#undef PG8_MMA
#undef PG8_WAIT_V
#undef PG8_WAIT_L
#undef PG8_BAR
#undef PG8_SCHED
}
}
#define LAS __attribute__((address_space(3)))
typedef unsigned short bf16;
typedef unsigned v4u __attribute__((ext_vector_type(4)));
typedef unsigned v2u __attribute__((ext_vector_type(2)));
typedef float f32x4 __attribute__((ext_vector_type(4)));
typedef float f32x2 __attribute__((ext_vector_type(2)));
typedef float f32x16 __attribute__((ext_vector_type(16)));
typedef short bf16x8 __attribute__((ext_vector_type(8)));
typedef short s16x4 __attribute__((ext_vector_type(4)));
using pg8::O_YP; using pg8::O_YS; using pg8::O_KP; using pg8::O_VP; using pg8::O_KS; using pg8::O_VS; using pg8::O_GV; using pg8::O_SP; using pg8::O_SS;
constexpr int M = 8704, MP = 8192, D = 2048, NIN_E = 3584, DFF = 8192, NWAVES = 8, NTHR = 512;
constexpr size_t MiB = 1u << 20;
constexpr size_t WS_SS = 464 * MiB;
constexpr size_t SSN = (size_t)8704 * 32;
constexpr size_t WS_CS = 1 * MiB;
constexpr size_t WS_W5 = 2 * MiB, WS_W6 = 34 * MiB, WS_WU1 = 42 * MiB, WS_WD1 = 74 * MiB;
constexpr size_t WS_W1 = 106 * MiB, WS_W2 = 120 * MiB, WS_WU0 = 128 * MiB, WS_WD0 = 160 * MiB;
constexpr size_t WS_BIG = 192 * MiB;
constexpr size_t WS_Q = WS_BIG, WS_KP = WS_BIG + 17 * MiB, WS_KS = WS_BIG + 21 * MiB, WS_VTP = WS_BIG + 23 * MiB, WS_VTS = WS_BIG + 27 * MiB, WS_U = WS_BIG + 29 * MiB, WS_GVR = WS_BIG + 46 * MiB;
constexpr size_t WS_QH = 106 * MiB, WS_FH = 174 * MiB, WS_VH = 242 * MiB, WS_GH = 276 * MiB;
constexpr size_t WS_H = 328 * MiB;
constexpr size_t WS_A1 = 396 * MiB;
constexpr size_t WS_A2 = 430 * MiB;
constexpr size_t WS_END = 470 * MiB;
constexpr size_t WS_SEG = WS_A1, WS_DEC = WS_A1 + 16 * MiB;
constexpr int LDS_BYTES = 147456;
constexpr int NPH = 16;

__device__ __forceinline__ unsigned f2bf(float f) { unsigned u = __builtin_bit_cast(unsigned, f); return (u + 0x7fffu + ((u >> 16) & 1u)) >> 16; }
__device__ __forceinline__ unsigned pk2(float lo, float hi) { return pg8::cvt_pk_bf16(lo, hi); }
__device__ __forceinline__ float bf2f(unsigned short b) { return __builtin_bit_cast(float, (unsigned)b << 16); }
__device__ __forceinline__ float wave_sum(float v) {
#pragma unroll
    for (int o = 1; o < 64; o <<= 1) v += __shfl_xor(v, o);
    return v;
}
struct Args { const float* in[20]; float* out; unsigned char* ws; int ph_lo, ph_hi; };

__device__ __forceinline__ void tr64_item(const float* __restrict__ W, int K, int N, bf16* WT, const float* __restrict__ g, LAS float* scr, int item, int lane) {
    const int nblk = N / 64, kb = item / nblk, nb = item % nblk, k0 = 64 * kb, n0 = 64 * nb;
    const int kr = lane >> 4, l4 = lane & 15;
    f32x4 v[16];
#pragma unroll
    for (int i = 0; i < 16; ++i) v[i] = __builtin_nontemporal_load((const f32x4*)(W + (size_t)(k0 + 4 * i + kr) * N + n0 + 4 * l4));
#pragma unroll
    for (int i = 0; i < 16; ++i) { const int k = 4 * i + kr; if (g) v[i] = v[i] * g[k0 + k];
        *(LAS f32x4*)(scr + k * 64 + ((4 * l4) ^ ((k >> 3) << 2))) = v[i]; }
    asm volatile("s_waitcnt lgkmcnt(0)" ::: "memory");
    const int c = lane & 7, nn = lane >> 3;
#pragma unroll
    for (int j = 0; j < 8; ++j) { const int n = nn + 8 * j; const LAS float* s = scr + (8 * c) * 64 + (n ^ (c << 2));
        v4u o; o.x = pk2(s[0 * 64], s[1 * 64]); o.y = pk2(s[2 * 64], s[3 * 64]); o.z = pk2(s[4 * 64], s[5 * 64]); o.w = pk2(s[6 * 64], s[7 * 64]);
        *(v4u*)(WT + (size_t)(n0 + n) * K + k0 + 8 * c) = o; }
    asm volatile("s_waitcnt lgkmcnt(0)" ::: "memory");
}
__device__ __forceinline__ void attn_wave(const bf16* Qp, const bf16* Kp, int kstride, const bf16* Vt, int vstride, int nkb, float sink, bf16* Op, int lane) {
    const int r = lane & 31, h = lane >> 5;
    bf16x8 qf[4];
#pragma unroll
    for (int s = 0; s < 4; ++s) qf[s] = *(const bf16x8*)(Qp + (size_t)r * 1024 + 16 * s + 8 * h);
    f32x16 S[6];
#pragma unroll
    for (int kb = 0; kb < 6; ++kb) {
        S[kb] = (f32x16){0.f,0.f,0.f,0.f,0.f,0.f,0.f,0.f,0.f,0.f,0.f,0.f,0.f,0.f,0.f,0.f};
        if (kb < nkb) {
#pragma unroll
            for (int s = 0; s < 4; ++s) { const bf16x8 kf = *(const bf16x8*)(Kp + (size_t)(kb * 32 + r) * kstride + 16 * s + 8 * h);
                S[kb] = __builtin_amdgcn_mfma_f32_32x32x16_bf16(kf, qf[s], S[kb], 0, 0, 0); }
        }
    }
    float mx = sink;
#pragma unroll
    for (int kb = 0; kb < 6; ++kb) if (kb < nkb) {
#pragma unroll
        for (int i = 0; i < 16; ++i) mx = fmaxf(mx, S[kb][i]); }
    mx = fmaxf(mx, __shfl_xor(mx, 32));
    float l = 0.f;
#pragma unroll
    for (int kb = 0; kb < 6; ++kb) if (kb < nkb) {
#pragma unroll
        for (int i = 0; i < 16; ++i) { const float p = __expf(S[kb][i] - mx); S[kb][i] = p; l += p; } }
    l += __shfl_xor(l, 32);
    l += __expf(sink - mx);
    f32x16 O[2];
    O[0] = (f32x16){0.f,0.f,0.f,0.f,0.f,0.f,0.f,0.f,0.f,0.f,0.f,0.f,0.f,0.f,0.f,0.f}; O[1] = O[0];
#pragma unroll
    for (int kb = 0; kb < 6; ++kb) if (kb < nkb) {
#pragma unroll
        for (int s = 0; s < 2; ++s) {
            v4u pw; pw.x = pk2(S[kb][8 * s + 0], S[kb][8 * s + 1]); pw.y = pk2(S[kb][8 * s + 2], S[kb][8 * s + 3]); pw.z = pk2(S[kb][8 * s + 4], S[kb][8 * s + 5]); pw.w = pk2(S[kb][8 * s + 6], S[kb][8 * s + 7]);
            const bf16x8 pf = __builtin_bit_cast(bf16x8, pw);
#pragma unroll
            for (int db = 0; db < 2; ++db) {
                const bf16* vp = Vt + (size_t)(db * 32 + r) * vstride + kb * 32 + 16 * s + 4 * h;
                const v2u lo = *(const v2u*)vp, hi = *(const v2u*)(vp + 8);
                v4u vw; vw.x = lo.x; vw.y = lo.y; vw.z = hi.x; vw.w = hi.y;
                O[db] = __builtin_amdgcn_mfma_f32_32x32x16_bf16(__builtin_bit_cast(bf16x8, vw), pf, O[db], 0, 0, 0);
            }
        }
    }
    const float il = 1.f / l;
#pragma unroll
    for (int db = 0; db < 2; ++db)
#pragma unroll
        for (int g4 = 0; g4 < 4; ++g4) {
            v2u w; w.x = pk2(O[db][4 * g4 + 0] * il, O[db][4 * g4 + 1] * il); w.y = pk2(O[db][4 * g4 + 2] * il, O[db][4 * g4 + 3] * il);
            *(v2u*)(Op + (size_t)r * 2048 + db * 32 + 8 * g4 + 4 * h) = w;
        }
}

__device__ __forceinline__ void gmlp_unit(unsigned char* lds, const float* GVr, const bf16* U, const float* gamma, const float* Wsp, const float* bias, bf16* AB, float* gvout, int row0, int nrows, int hg, int tid) {
    bf16* gvT = (bf16*)lds;
    const int lane = tid & 63, wave = tid >> 6;
    {
        const int q = tid >> 2, part = tid & 3;
        f32x4 v[8]; float s = 0.f;
        if (q < nrows) {
#pragma unroll
            for (int j = 0; j < 8; ++j) { v[j] = *(const f32x4*)(GVr + (size_t)(row0 + q) * 1024 + hg * 128 + part * 32 + 4 * j); s += (v[j][0] + v[j][1]) + (v[j][2] + v[j][3]); }
        } else {
#pragma unroll
            for (int j = 0; j < 8; ++j) v[j] = (f32x4){0.f, 0.f, 0.f, 0.f};
        }
        s += __shfl_xor(s, 1); s += __shfl_xor(s, 2);
        const float mu = s * (1.f / 128.f); float s2 = 0.f;
#pragma unroll
        for (int j = 0; j < 8; ++j) { v[j] = v[j] - mu; s2 += (v[j][0] * v[j][0] + v[j][1] * v[j][1]) + (v[j][2] * v[j][2] + v[j][3] * v[j][3]); }
        s2 += __shfl_xor(s2, 1); s2 += __shfl_xor(s2, 2);
        const float rstd = rsqrtf(s2 * (1.f / 128.f) + 1e-6f);
#pragma unroll
        for (int j = 0; j < 8; ++j) {
            const f32x4 gm = *(const f32x4*)(gamma + hg * 128 + part * 32 + 4 * j);
            f32x4 o = v[j] * rstd * gm;
            if (q >= nrows) o = (f32x4){0.f, 0.f, 0.f, 0.f};
            if (gvout && q < nrows) *(f32x4*)(gvout + ((size_t)q * 8 + hg) * 128 + part * 32 + 4 * j) = o;
#pragma unroll
            for (int e = 0; e < 4; ++e) gvT[(part * 32 + 4 * j + e) * 136 + q] = (bf16)f2bf(o[e]);
        }
    }
    __syncthreads();
    const int r = lane & 31, hh = lane >> 5;
    const int pb = wave >> 1;
    if (pb * 32 < nrows) {
        const int nks = (nrows == 32) ? 2 : (pb < 2 ? 4 : 8);
        f32x16 acc[2];
        acc[0] = (f32x16){0.f,0.f,0.f,0.f,0.f,0.f,0.f,0.f,0.f,0.f,0.f,0.f,0.f,0.f,0.f,0.f}; acc[1] = acc[0];
        for (int s = 0; s < nks; ++s) {
            const float* wp = Wsp + ((size_t)hg * 128 + pb * 32 + r) * 128 + 16 * s + 8 * hh;
            const f32x4 w0 = *(const f32x4*)wp, w1 = *(const f32x4*)(wp + 4);
            v4u aw; aw.x = pk2(w0[0], w0[1]); aw.y = pk2(w0[2], w0[3]); aw.z = pk2(w1[0], w1[1]); aw.w = pk2(w1[2], w1[3]);
            const bf16x8 af = __builtin_bit_cast(bf16x8, aw);
#pragma unroll
            for (int t = 0; t < 2; ++t) {
                const int db = (wave & 1) * 2 + t;
                const bf16x8 bfr = *(const bf16x8*)(gvT + (db * 32 + r) * 136 + 16 * s + 8 * hh);
                acc[t] = __builtin_amdgcn_mfma_f32_32x32x16_bf16(bfr, af, acc[t], 0, 0, 0);
            }
        }
        {
            const int p = pb * 32 + r; const float bs = bias[hg * 128 + p];
#pragma unroll
            for (int t = 0; t < 2; ++t)
#pragma unroll
                for (int g4 = 0; g4 < 4; ++g4) {
                    const int dcol = hg * 128 + ((wave & 1) * 2 + t) * 32 + 8 * g4 + 4 * hh;
                    const v2u uw = *(const v2u*)(U + (size_t)(row0 + p) * 1024 + dcol);
                    v2u ow; ow.x = pk2(bf2f((unsigned short)(uw.x & 0xffff)) * (acc[t][4 * g4 + 0] + bs), bf2f((unsigned short)(uw.x >> 16)) * (acc[t][4 * g4 + 1] + bs));
                    ow.y = pk2(bf2f((unsigned short)(uw.y & 0xffff)) * (acc[t][4 * g4 + 2] + bs), bf2f((unsigned short)(uw.y >> 16)) * (acc[t][4 * g4 + 3] + bs));
                    *(v2u*)(AB + (size_t)(row0 + p) * 2048 + 1024 + dcol) = ow;
                }
        }
    }
    __syncthreads();
}

template <bool OUT, bool DECAY>
__device__ __forceinline__ void hgrn_unit(unsigned char* lds, const float* QH, const float* FH, const bf16* VH, const bf16* GH, const float* gon, bf16* Oo,
                                          int hd, int row0, int L, int init, const float* sin, const float* SEG, const float* DEC, int gseg, float* sout, float* decout, int tid) {
    float* qs = (float*)lds;
    float* fs = qs + 2 * 2048;
    float* vs = fs + 2 * 2048;
    float* op = vs + 2 * 2048;
    const int lane = tid & 63, w = tid >> 6, e = (w & 1) * 64 + lane, dq = w >> 1, d0 = dq * 32;
    f32x2 S[16];
    if (init == 1) {
#pragma unroll
        for (int i = 0; i < 16; ++i) { S[i].x = sin[(size_t)(d0 + 2 * i) * 128 + e]; S[i].y = sin[(size_t)(d0 + 2 * i + 1) * 128 + e]; }
    } else {
#pragma unroll
        for (int i = 0; i < 16; ++i) S[i] = (f32x2){0.f, 0.f};
        if (init == 2) {
            for (int g = 0; g < gseg; ++g) {
                const float* Lp = SEG + ((size_t)(hd * 16 + g) * 128 + d0) * 128 + e; const float* Dp = DEC + (size_t)(hd * 16 + g) * 128 + d0;
#pragma unroll
                for (int i = 0; i < 16; ++i) { S[i].x = Dp[2 * i] * S[i].x + Lp[(size_t)(2 * i) * 128]; S[i].y = Dp[2 * i + 1] * S[i].y + Lp[(size_t)(2 * i + 1) * 128]; }
            }
        }
    }
    float dec = 1.f;
    const int tt = tid >> 5, c4 = (tid & 31) * 4;
    const int nb = L >> 4;
    f32x4 rq, rf; v2u rv;
    {
        const size_t off = (size_t)(row0 + tt) * 2048 + hd * 128 + c4;
        if (OUT) rq = *(const f32x4*)(QH + off);
        rf = *(const f32x4*)(FH + off); rv = *(const v2u*)(VH + off);
        if (OUT) *(f32x4*)(qs + tt * 128 + c4) = rq;
        *(f32x4*)(fs + tt * 128 + c4) = rf;
        *(f32x4*)(vs + tt * 128 + c4) = (f32x4){bf2f((unsigned short)(rv.x & 0xffff)), bf2f((unsigned short)(rv.x >> 16)), bf2f((unsigned short)(rv.y & 0xffff)), bf2f((unsigned short)(rv.y >> 16))};
    }
    __syncthreads();
    for (int b = 0; b < nb; ++b) {
        const int buf = b & 1;
        if (b + 1 < nb) {
            const size_t off = (size_t)(row0 + (b + 1) * 16 + tt) * 2048 + hd * 128 + c4;
            if (OUT) rq = *(const f32x4*)(QH + off);
            rf = *(const f32x4*)(FH + off); rv = *(const v2u*)(VH + off);
        }
        const float* qb = qs + buf * 2048 + d0; const float* fb = fs + buf * 2048 + d0; const float* vb = vs + buf * 2048 + e;
#pragma unroll 2
        for (int t = 0; t < 16; ++t) {
            const float v = vb[t * 128]; const f32x2 v2 = (f32x2){v, v};
            f32x2 o2 = (f32x2){0.f, 0.f};
#pragma unroll
            for (int i = 0; i < 8; ++i) {
                const f32x4 f4 = *(const f32x4*)(fb + t * 128 + 4 * i);
                S[2 * i] = (f32x2){f4[0], f4[1]} * (S[2 * i] - v2) + v2;
                S[2 * i + 1] = (f32x2){f4[2], f4[3]} * (S[2 * i + 1] - v2) + v2;
                if (OUT) { const f32x4 q4 = *(const f32x4*)(qb + t * 128 + 4 * i); o2 += (f32x2){q4[0], q4[1]} * S[2 * i]; o2 += (f32x2){q4[2], q4[3]} * S[2 * i + 1]; }
            }
            if (OUT) op[((buf * 16 + t) * 4 + dq) * 128 + e] = o2.x + o2.y;
        }
        if (DECAY) { if (tid < 128) {
#pragma unroll
            for (int t = 0; t < 16; ++t) dec *= fs[buf * 2048 + t * 128 + tid]; } }
        if (b + 1 < nb) {
            const int nbuf = buf ^ 1;
            if (OUT) *(f32x4*)(qs + nbuf * 2048 + tt * 128 + c4) = rq;
            *(f32x4*)(fs + nbuf * 2048 + tt * 128 + c4) = rf;
            *(f32x4*)(vs + nbuf * 2048 + tt * 128 + c4) = (f32x4){bf2f((unsigned short)(rv.x & 0xffff)), bf2f((unsigned short)(rv.x >> 16)), bf2f((unsigned short)(rv.y & 0xffff)), bf2f((unsigned short)(rv.y >> 16))};
        }
        __syncthreads();
        if (OUT) {
            const float* ob = op + (buf * 16 + tt) * 512 + c4;
            f32x4 o = *(const f32x4*)ob + *(const f32x4*)(ob + 128) + *(const f32x4*)(ob + 256) + *(const f32x4*)(ob + 384);
            float sq = (o[0] * o[0] + o[1] * o[1]) + (o[2] * o[2] + o[3] * o[3]);
#pragma unroll
            for (int x = 1; x < 32; x <<= 1) sq += __shfl_xor(sq, x);
            const float rms = rsqrtf(sq * (1.f / 128.f) + 1e-6f);
            const size_t off = (size_t)(row0 + b * 16 + tt) * 2048 + hd * 128 + c4;
            const v2u gw = *(const v2u*)(GH + off); const f32x4 gn = *(const f32x4*)(gon + hd * 128 + c4);
            const float r0 = o[0] * rms * gn[0] * bf2f((unsigned short)(gw.x & 0xffff)), r1 = o[1] * rms * gn[1] * bf2f((unsigned short)(gw.x >> 16));
            const float r2 = o[2] * rms * gn[2] * bf2f((unsigned short)(gw.y & 0xffff)), r3 = o[3] * rms * gn[3] * bf2f((unsigned short)(gw.y >> 16));
            v2u ow; ow.x = pk2(r0, r1); ow.y = pk2(r2, r3);
            *(v2u*)(Oo + off) = ow;
        }
    }
    if (sout) {
#pragma unroll
        for (int i = 0; i < 16; ++i) { sout[(size_t)(d0 + 2 * i) * 128 + e] = S[i].x; sout[(size_t)(d0 + 2 * i + 1) * 128 + e] = S[i].y; }
    }
    if (DECAY) { if (decout && tid < 128) decout[tid] = dec; }
    __syncthreads();
}
#define XB_TMO      128
#define XB_XCNT(j)  (256  + 64 * (j))
#define XB_XSUB(j)  (1280 + 64 * (j))
#define XB_XGEN(j)  (2304 + 64 * (j))
#define XB_TOP      3328
#define XB_TOPGEN   3392
#define XCD_BAR_WORDS 3456
#define XB_SPIN_CAP (1u << 18)

__device__ __forceinline__ unsigned xb_ld(unsigned* p)              { return __hip_atomic_load(p, __ATOMIC_RELAXED, __HIP_MEMORY_SCOPE_AGENT); }
__device__ __forceinline__ unsigned xb_add(unsigned* p, unsigned v) { return __hip_atomic_fetch_add(p, v, __ATOMIC_RELAXED, __HIP_MEMORY_SCOPE_AGENT); }
__device__ __forceinline__ unsigned xb_xcc_id() { return (unsigned)__builtin_amdgcn_s_getreg((3 << 11) | 20) & 0xFu; }
#define XB_SPIN(cond, bar) do { unsigned _sp = 0; while (cond) { __builtin_amdgcn_s_sleep(1); \
    if ((++_sp & 255u) == 0u) { if (xb_ld(&(bar)[XB_TMO])) break; if (_sp > XB_SPIN_CAP) { atomicAdd(&(bar)[XB_TMO], 1u); break; } } } } while (0)

struct XcdBarrier {
    unsigned* bar; unsigned x;
    volatile LAS unsigned* st;
};

__device__ __forceinline__ XcdBarrier xcd_barrier_post(unsigned* bar, volatile LAS unsigned* st) {
    XcdBarrier b; b.bar = bar; b.x = xb_xcc_id(); b.st = st;
    if (threadIdx.x == 0) (void)xb_add(&bar[XB_XCNT(b.x)], 1u);
    return b;
}
__device__ __forceinline__ void xcd_barrier_complete(unsigned* bar, unsigned x, unsigned& nloc, unsigned& nx) {
    const unsigned G = gridDim.x * gridDim.y * gridDim.z;
    unsigned sum, cnt, mine, sp = 0u;
    for (;;) {
        sum = 0u; cnt = 0u; mine = 0u;
#pragma unroll
        for (unsigned j = 0; j < 16; ++j) { const unsigned c = xb_ld(&bar[XB_XCNT(j)]); sum += c; cnt += (c > 0u) ? 1u : 0u; mine = (j == x) ? c : mine; }
        if (sum == G) break;
        __builtin_amdgcn_s_sleep(1);
        if ((++sp & 255u) == 0u) { if (xb_ld(&bar[XB_TMO])) break; if (sp > XB_SPIN_CAP) { atomicAdd(&bar[XB_TMO], 1u); break; } }
    }
    nloc = mine > 0u ? mine : 1u; nx = cnt > 0u ? cnt : 1u;
}

__device__ __forceinline__ void xcd_barrier(const XcdBarrier& b) {
    asm volatile("s_waitcnt vmcnt(0)" ::: "memory");
    __syncthreads();
    if (threadIdx.x == 0) {
        unsigned* bar = b.bar;
        __builtin_amdgcn_s_waitcnt(0);
        unsigned nloc = b.st[0], nx = b.st[1];
        if (nloc == 0u) { xcd_barrier_complete(bar, b.x, nloc, nx); b.st[0] = nloc; b.st[1] = nx; }
        const unsigned old = xb_add(&bar[XB_XSUB(b.x)], 1u);
        const unsigned gen = old / nloc;
        if (old + 1u == (gen + 1u) * nloc) {
            __builtin_amdgcn_fence(__ATOMIC_RELEASE, "agent");
            asm volatile("s_waitcnt vmcnt(0)" ::: "memory");
            const unsigned og = xb_add(&bar[XB_TOP], 1u);
            const unsigned tg = og / nx;
            if (og + 1u == (tg + 1u) * nx) xb_add(&bar[XB_TOPGEN], 1u);
            else XB_SPIN(xb_ld(&bar[XB_TOPGEN]) == tg, bar);
            __builtin_amdgcn_fence(__ATOMIC_ACQUIRE, "agent");
            xb_add(&bar[XB_XGEN(b.x)], 1u);
            asm volatile("s_waitcnt vmcnt(0)" ::: "memory");
        } else {
            XB_SPIN(xb_ld(&bar[XB_XGEN(b.x)]) == gen, bar);
            __builtin_amdgcn_fence(__ATOMIC_ACQUIRE, "agent");
            asm volatile("s_waitcnt vmcnt(0)" ::: "memory");
        }
    }
    __syncthreads();
}
constexpr int HG_QH = 0, HG_KT = 8704, HG_KHT = 17408, HG_VT = 27648, HG_D = 37888, HG_PART = 38400, HG_OST = 40448;
__device__ __forceinline__ bf16x8 pack8(const f32x16& x, int o) {
    v4u w; w.x = pg8::cvt_pk_bf16(x[o + 0], x[o + 1]); w.y = pg8::cvt_pk_bf16(x[o + 2], x[o + 3]); w.z = pg8::cvt_pk_bf16(x[o + 4], x[o + 5]); w.w = pg8::cvt_pk_bf16(x[o + 6], x[o + 7]);
    return __builtin_bit_cast(bf16x8, w);
}
template <bool OUT>
__device__ __forceinline__ void hg_unit(unsigned char* lds, const float* QH, const float* FH, const bf16* VH, const bf16* GH, const float* gon, bf16* Oo,
                                        int hd, int row0, int nch, int init, const float* sin, const float* SEG, const float* DEC, int gseg, float* sout, float* decout, int tid, float* zflag = nullptr) {
    bf16* Qh = (bf16*)(lds + HG_QH); bf16* Kt = (bf16*)(lds + HG_KT); bf16* KhT = (bf16*)(lds + HG_KHT); bf16* VT = (bf16*)(lds + HG_VT);
    float* Dv = (float*)(lds + HG_D); float* Pp = (float*)(lds + HG_PART); float* Ost = (float*)(lds + HG_OST);
    const int lane = tid & 63, w = __builtin_amdgcn_readfirstlane(tid >> 6), r = lane & 31, hh = lane >> 5;
    const int d = tid & 127, tq = __builtin_amdgcn_readfirstlane(tid >> 7);
    const f32x16 Z16 = (f32x16){0.f,0.f,0.f,0.f,0.f,0.f,0.f,0.f,0.f,0.f,0.f,0.f,0.f,0.f,0.f,0.f};
    f32x16 S[4];
#pragma unroll
    for (int db = 0; db < 4; ++db) S[db] = Z16;
    if (w < 4) {
        if (init == 1) {
#pragma unroll
            for (int db = 0; db < 4; ++db)
#pragma unroll
                for (int i = 0; i < 16; ++i) S[db][i] = sin[(size_t)(db * 32 + (i & 3) + 8 * (i >> 2) + 4 * hh) * 128 + w * 32 + r];
        }
    }
    float dec = 1.f;
    float pf[8], pq[8]; unsigned short pv[8];
    {
        const size_t off = (size_t)(row0 + tq * 8) * 2048 + hd * 128 + d;
#pragma unroll
        for (int j = 0; j < 8; ++j) { pf[j] = FH[off + (size_t)j * 2048]; pv[j] = VH[off + (size_t)j * 2048]; if (OUT) pq[j] = QH[off + (size_t)j * 2048]; }
    }
    for (int c = 0; c < nch; ++c) {
        v4u gw = (v4u){0u, 0u, 0u, 0u};
        if (OUT) gw = *(const v4u*)(GH + (size_t)(row0 + c * 32 + (tid >> 4)) * 2048 + hd * 128 + (tid & 15) * 8);
        float A[8]; float run = 1.f;
#pragma unroll
        for (int j = 0; j < 8; ++j) { run *= pf[j]; A[j] = run; }
        Pp[tq * 128 + d] = run;
        __syncthreads();
        const float p0 = Pp[d], p1 = Pp[128 + d], p2 = Pp[256 + d], p3 = Pp[384 + d];
        const float offp = tq == 0 ? 1.f : tq == 1 ? p0 : tq == 2 ? p0 * p1 : p0 * p1 * p2;
        const float tot = (p0 * p1) * (p2 * p3);
#pragma unroll
        for (int j = 0; j < 8; ++j) {
            const int t = tq * 8 + j; const float a = A[j] * offp, ia = __builtin_amdgcn_rcpf(a), k = 1.f - pf[j];
            if (OUT) Qh[t * 136 + d] = (bf16)f2bf(pq[j] * a);
            if (OUT) Kt[t * 136 + d] = (bf16)f2bf(k * ia);
            KhT[d * 40 + t] = (bf16)f2bf(k * tot * ia);
            VT[d * 40 + t] = pv[j];
        }
        if (tq == 0) { Dv[d] = tot; if (!OUT) dec *= tot; }
        if (c + 1 < nch) {
            const size_t off = (size_t)(row0 + (c + 1) * 32 + tq * 8) * 2048 + hd * 128 + d;
#pragma unroll
            for (int j = 0; j < 8; ++j) { pf[j] = FH[off + (size_t)j * 2048]; pv[j] = VH[off + (size_t)j * 2048]; if (OUT) pq[j] = QH[off + (size_t)j * 2048]; }
        }
        __syncthreads();
        if (w < 4) {
            if (OUT) {
                f32x16 P = Z16;
#pragma unroll
                for (int kk = 0; kk < 8; ++kk) {
                    const bf16x8 a = *(const bf16x8*)(Kt + r * 136 + 16 * kk + 8 * hh), b = *(const bf16x8*)(Qh + r * 136 + 16 * kk + 8 * hh);
                    P = __builtin_amdgcn_mfma_f32_32x32x16_bf16(a, b, P, 0, 0, 0);
                }
#pragma unroll
                for (int i = 0; i < 16; ++i) { const int s = (i & 3) + 8 * (i >> 2) + 4 * hh; if (s > r) P[i] = 0.f; }
                f32x16 o = Z16;
#pragma unroll
                for (int db = 0; db < 4; ++db)
#pragma unroll
                    for (int kk = 0; kk < 2; ++kk) {
                        const bf16* qp = Qh + r * 136 + db * 32 + 16 * kk + 4 * hh;
                        const v2u lo = *(const v2u*)qp, hi = *(const v2u*)(qp + 8);
                        v4u bw; bw.x = lo.x; bw.y = lo.y; bw.z = hi.x; bw.w = hi.y;
                        o = __builtin_amdgcn_mfma_f32_32x32x16_bf16(pack8(S[db], 8 * kk), __builtin_bit_cast(bf16x8, bw), o, 0, 0, 0);
                    }
#pragma unroll
                for (int kk = 0; kk < 2; ++kk) {
                    const bf16* vp = VT + (w * 32 + r) * 40 + 16 * kk + 4 * hh;
                    const v2u lo = *(const v2u*)vp, hi = *(const v2u*)(vp + 8);
                    v4u aw; aw.x = lo.x; aw.y = lo.y; aw.z = hi.x; aw.w = hi.y;
                    o = __builtin_amdgcn_mfma_f32_32x32x16_bf16(__builtin_bit_cast(bf16x8, aw), pack8(P, 8 * kk), o, 0, 0, 0);
                }
#pragma unroll
                for (int g4 = 0; g4 < 4; ++g4) *(f32x4*)(Ost + r * 132 + w * 32 + 8 * g4 + 4 * hh) = (f32x4){o[4 * g4], o[4 * g4 + 1], o[4 * g4 + 2], o[4 * g4 + 3]};
            }
#pragma unroll
            for (int db = 0; db < 4; ++db) {
#pragma unroll
                for (int g4 = 0; g4 < 4; ++g4) { const f32x4 dv = *(const f32x4*)(Dv + db * 32 + 8 * g4 + 4 * hh);
#pragma unroll
                    for (int j = 0; j < 4; ++j) S[db][4 * g4 + j] *= dv[j]; }
#pragma unroll
                for (int kk = 0; kk < 2; ++kk) {
                    const bf16x8 a = *(const bf16x8*)(KhT + (db * 32 + r) * 40 + 16 * kk + 8 * hh), b = *(const bf16x8*)(VT + (w * 32 + r) * 40 + 16 * kk + 8 * hh);
                    S[db] = __builtin_amdgcn_mfma_f32_32x32x16_bf16(a, b, S[db], 0, 0, 0);
                }
            }
        }
        if (OUT) {
            __syncthreads();
            const int t = tid >> 4, e8 = (tid & 15) * 8;
            const f32x4 o0 = *(const f32x4*)(Ost + t * 132 + e8), o1 = *(const f32x4*)(Ost + t * 132 + e8 + 4);
            float sq = ((o0[0] * o0[0] + o0[1] * o0[1]) + (o0[2] * o0[2] + o0[3] * o0[3])) + ((o1[0] * o1[0] + o1[1] * o1[1]) + (o1[2] * o1[2] + o1[3] * o1[3]));
#pragma unroll
            for (int x = 1; x < 16; x <<= 1) sq += __shfl_xor(sq, x);
            const float rms = rsqrtf(sq * (1.f / 128.f) + 1e-6f);
            const size_t off = (size_t)(row0 + c * 32 + t) * 2048 + hd * 128 + e8;
            const f32x4 g0 = *(const f32x4*)(gon + hd * 128 + e8), g1 = *(const f32x4*)(gon + hd * 128 + e8 + 4);
            v4u ow;
            ow.x = pk2(o0[0] * rms * g0[0] * bf2f((unsigned short)(gw.x & 0xffff)), o0[1] * rms * g0[1] * bf2f((unsigned short)(gw.x >> 16)));
            ow.y = pk2(o0[2] * rms * g0[2] * bf2f((unsigned short)(gw.y & 0xffff)), o0[3] * rms * g0[3] * bf2f((unsigned short)(gw.y >> 16)));
            ow.z = pk2(o1[0] * rms * g1[0] * bf2f((unsigned short)(gw.z & 0xffff)), o1[1] * rms * g1[1] * bf2f((unsigned short)(gw.z >> 16)));
            ow.w = pk2(o1[2] * rms * g1[2] * bf2f((unsigned short)(gw.w & 0xffff)), o1[3] * rms * g1[3] * bf2f((unsigned short)(gw.w >> 16)));
            *(v4u*)(Oo + off) = ow;
        }
    }
    if (sout && w < 4) {
#pragma unroll
        for (int db = 0; db < 4; ++db)
#pragma unroll
            for (int i = 0; i < 16; ++i) sout[(size_t)(db * 32 + (i & 3) + 8 * (i >> 2) + 4 * hh) * 128 + w * 32 + r] = S[db][i];
    }
    if (!OUT) {
        if (decout && tid < 128) decout[tid] = dec;
        const int anynz = __syncthreads_or(tid < 128 && dec > 0.f);
        if (zflag && tid == 0) *zflag = anynz ? 0.f : 1.f;
    }
    __syncthreads();
}
#ifndef DBG_A2PTR
#define DBG_A2PTR A2
#endif
#ifndef SEQ_LO
#define SEQ_LO 0xbad98e76d54d3210ull
#define SEQ_HI 0xcull
#define SEQ_N 17
#endif
#ifndef DBG_SSI
#define DBG_SSI 4
#endif
#ifndef PHMASK
#define PHMASK 0xffff
#endif
#define PHEN(k) (((PHMASK) >> (k)) & 1)
#ifndef MK_PER_PHASE
#define MK_PER_PHASE 0
#endif
#define CAS __attribute__((address_space(4)))
#define INP(i) (*(const float* const CAS*)(kp + 8 * (i)))
#define xp INP(0)
#define xs INP(1)
#define ss ((float*)(ws + WS_SS))
#define cs ((float*)(ws + WS_CS))
#define A1 ((bf16*)(ws + WS_A1))
#define A2 ((bf16*)(ws + WS_A2))
#define H ((float*)(ws + WS_H))
#define HID ((bf16*)(ws + WS_BIG))
#define Qb ((bf16*)(ws + WS_Q))
#define Kpb ((bf16*)(ws + WS_KP))
#define Ksb ((bf16*)(ws + WS_KS))
#define Vtp ((bf16*)(ws + WS_VTP))
#define Vts ((bf16*)(ws + WS_VTS))
#define Ub ((bf16*)(ws + WS_U))
#define GVr ((float*)(ws + WS_GVR))
#define QH ((float*)(ws + WS_QH))
#define FH ((float*)(ws + WS_FH))
#define VH ((bf16*)(ws + WS_VH))
#define GH ((bf16*)(ws + WS_GH))
#define SEG ((float*)(ws + WS_SEG))
#define DEC ((float*)(ws + WS_DEC))

#define CONV_L1(j_) do { int r_ = (j_); \
    if (r_ < 4096) { tr64_item(INP(14), 2048, 8192, (bf16*)(ws + WS_W5), INP(5) + 2048, scr, r_, lane); break; } r_ -= 4096; \
    if (r_ < 1024) { tr64_item(INP(15), 2048, 2048, (bf16*)(ws + WS_W6), nullptr, scr, r_, lane); break; } r_ -= 1024; \
    if (r_ < 4096) { tr64_item(INP(18) + (size_t)2048 * 8192, 2048, 8192, (bf16*)(ws + WS_WU1), INP(6) + 2048, scr, r_, lane); break; } r_ -= 4096; \
    tr64_item(INP(19) + (size_t)2048 * 8192, 8192, 2048, (bf16*)(ws + WS_WD1), nullptr, scr, r_, lane); } while (0)
#define CONV_RANGE(j0_, j1_, w0_, nw_) do { LAS float* scr = (LAS float*)(lds3 + wave * 16384); \
    for (int j__ = (j0_) + (w0_) * NWAVES + wave; j__ < (j1_); j__ += (nw_) * NWAVES) CONV_L1(j__); } while (0)
__global__ void __launch_bounds__(NTHR, 2) mk_fwd(Args a) {
    extern __shared__ __attribute__((aligned(16))) unsigned char lds[];
    const int G = gridDim.x, bid = blockIdx.x;
    cg::grid_group grid = cg::this_grid();
    volatile LAS unsigned* xb_misc = (volatile LAS unsigned*)((LAS unsigned char*)lds + 131072 + 320);
    if (threadIdx.x < 32) xb_misc[threadIdx.x] = 0u;
    __syncthreads();
    XcdBarrier xbar = xcd_barrier_post((unsigned*)a.ws, xb_misc + 8);

    int nfin = 0;
    for (int st = a.ph_lo; st < a.ph_hi; ++st) {
        const int ph = (int)(((st < 16 ? (unsigned long long)SEQ_LO >> (4 * st) : (unsigned long long)SEQ_HI >> (4 * (st - 16)))) & 15ull);
        int tid = threadIdx.x;
        const CAS unsigned char* kp = (const CAS unsigned char*)__builtin_amdgcn_kernarg_segment_ptr();
        asm volatile("" : "+v"(tid)); asm volatile("" : "+s"(kp));
        unsigned char* ws = *(unsigned char* const CAS*)(kp + 168); float* out = *(float* const CAS*)(kp + 160);
        const int lane = tid & 63, wave = __builtin_amdgcn_readfirstlane(tid >> 6);
        LAS unsigned char* lds3 = (LAS unsigned char*)lds;
        if (ph == 0 && PHEN(0)) {
            LAS float* scr = (LAS float*)(lds3 + wave * 16384);
            const int gw = bid * NWAVES + wave, NGW = G * NWAVES;
            constexpr int J_1 = 32 * 56, J_2 = 32 * 32, J_U = 32 * 128, J_D = 128 * 32;
            for (int it = gw; it < J_1 + J_2 + J_U + J_D - 1000; it += NGW) {
                int r = it;
                if (r < J_1) { tr64_item(INP(8), 2048, 3584, (bf16*)(ws + WS_W1), INP(5), scr, r, lane); continue; } r -= J_1;
                if (r < J_2) { tr64_item(INP(9), 2048, 2048, (bf16*)(ws + WS_W2), nullptr, scr, r, lane); continue; } r -= J_2;
                if (r < J_U) { tr64_item(INP(18), 2048, 8192, (bf16*)(ws + WS_WU0), INP(6), scr, r, lane); continue; } r -= J_U;
                tr64_item(INP(19), 8192, 2048, (bf16*)(ws + WS_WD0), nullptr, scr, r, lane);
            }
            for (int m = gw; m < M; m += NGW) {
                const float* xr = m < MP ? xp + (size_t)m * D : xs + (size_t)(m - MP) * D;
                f32x4 v[8]; float s = 0.f;
#pragma unroll
                for (int j = 0; j < 8; ++j) { v[j] = __builtin_nontemporal_load((const f32x4*)(xr + 4 * lane + 256 * j)); s += (v[j][0] * v[j][0] + v[j][1] * v[j][1]) + (v[j][2] * v[j][2] + v[j][3] * v[j][3]); }
                s = wave_sum(s);
#pragma unroll
                for (int j = 0; j < 8; ++j) { v2u w; w.x = pk2(v[j][0], v[j][1]); w.y = pk2(v[j][2], v[j][3]); *(v2u*)(A1 + (size_t)m * D + 4 * lane + 256 * j) = w;
                    if (m >= MP) *(f32x4*)(H + (size_t)m * D + 4 * lane + 256 * j) = v[j]; }
                if (lane < 32) ss[(size_t)m * 32 + lane] = lane == 0 ? s : 0.f;
            }
            const int gt = bid * NTHR + tid, NGT = G * NTHR;
            for (int idx = gt; idx < M * 8; idx += NGT) {
                const int m = idx >> 3, i = idx & 7;
                const int pos = m < MP ? m : 2048 + ((m - MP) & 31);
                const float inv = i == 0 ? 1.f : i == 1 ? 1.939227432e-01f : i == 2 ? 3.760603070e-02f : i == 3 ? 7.292664610e-03f : i == 4 ? 1.414213562e-03f : i == 5 ? 2.742481884e-04f : i == 6 ? 5.318295734e-05f : 1.031338525e-05f;
                const float ang = (float)pos * inv;
                const float th = ang * 1.591549367e-01f, te = __builtin_fmaf(ang, 1.591549367e-01f, -th) + ang * 6.420638243e-09f;
                const float fr_ = (th - __builtin_rintf(th)) + te;
                cs[2 * idx] = __builtin_amdgcn_cosf(fr_); cs[2 * idx + 1] = __builtin_amdgcn_sinf(fr_);
            }
            const float* ck = INP(2); const float* cv = INP(3);
            for (int idx = gt; idx < 16 * 128 * 256; idx += NGT) {
                const int b = idx >> 15, rem = idx & 32767, j = rem >> 8, c = rem & 255;
                const float kv = ck[idx], vv = cv[idx];
                Ksb[(size_t)b * 40960 + rem] = (bf16)f2bf(kv);
                Vts[((size_t)b * 256 + c) * 160 + j] = (bf16)f2bf(vv);
                if (j >= 32) { out[O_KS + ((size_t)b * 128 + j - 32) * 256 + c] = kv; out[O_VS + ((size_t)b * 128 + j - 32) * 256 + c] = vv; }
            }
        } else if (ph == 1 && PHEN(1)) {
            pg8::Gemm g{A1, (const bf16*)(ws + WS_W1), M, NIN_E, D}; pg8::StaticOrder S; S.init(M, NIN_E, G, bid);
            pg8::EpiInEven E{ss, cs, Qb, Kpb, Ksb, Vtp, Vts, Ub, GVr, out};
            pg8::gemm_phase<pg8::EpiInEven, pg8::StaticOrder, true, true>(lds3, g, S, E, tid);
            if (bid >= 220) CONV_RANGE(0, 1000, bid - 220, 36);
        } else if (ph == 2 && PHEN(2)) {
            const int vb = (G & 7) == 0 ? (bid & 7) * (G >> 3) + (bid >> 3) : bid;
            for (int w_ = vb; w_ < 1216; w_ += G) {
                const int u = w_ < 512 ? w_ : w_ < 1024 ? w_ + 64 : w_ < 1088 ? w_ - 512 : w_;
                if (u < 576) {
                    bf16* Ks = (bf16*)lds; bf16* Vs = (bf16*)(lds + 27648);
                    const bf16* Kg; const bf16* Vg; int vstr, nkb;
                    if (u < 512) { const int c = u >> 2, kvh = u & 3, kc0 = c > 2 ? c - 2 : 0; nkb = (c - kc0 + 1) * 2;
                        Kg = Kpb + (size_t)(kc0 * 64) * 256 + kvh * 64; Vg = Vtp + (size_t)(kvh * 64) * 8192 + kc0 * 64; vstr = 8192; }
                    else { const int su = u - 512, b = su >> 2, kvh = su & 3; nkb = 5;
                        Kg = Ksb + (size_t)b * 40960 + kvh * 64; Vg = Vts + ((size_t)b * 256 + kvh * 64) * 160; vstr = 160; }
                    const int nkeys = nkb * 32, cpr = nkeys >> 3;
                    for (int p = tid; p < nkeys * 8; p += NTHR) { const int row = p >> 3, ch = p & 7; *(v4u*)(Ks + row * 72 + ch * 8) = *(const v4u*)(Kg + (size_t)row * 256 + ch * 8); }
                    for (int p = tid; p < 64 * cpr; p += NTHR) { const int dd = p / cpr, ch = p - dd * cpr; *(v4u*)(Vs + dd * 200 + ch * 8) = *(const v4u*)(Vg + (size_t)dd * vstr + ch * 8); }
                    __syncthreads();
                    if (u < 512) { const int c = u >> 2, kvh = u & 3, hq = kvh * 4 + (wave >> 1), tok0 = c * 64 + (wave & 1) * 32;
                        attn_wave(Qb + (size_t)tok0 * 1024 + hq * 64, Ks, 72, Vs, 200, nkb, INP(10)[hq], A2 + (size_t)tok0 * 2048 + hq * 64, lane);
                    } else if (wave < 4) { const int su = u - 512, b = su >> 2, kvh = su & 3, hq = kvh * 4 + wave;
                        attn_wave(Qb + (size_t)(MP + b * 32) * 1024 + hq * 64, Ks, 72, Vs, 200, nkb, INP(10)[hq], A2 + (size_t)(MP + b * 32) * 2048 + hq * 64, lane); }
                    __syncthreads();
                } else if (u < 1088) {
                    const int gu = u - 576;
                    gmlp_unit(lds, GVr, Ub, INP(11), INP(12), INP(13), A2, nullptr, (gu >> 3) * 128, 128, gu & 7, tid);
                } else {
                    const int gu = u - 1088, b = gu >> 3;
                    gmlp_unit(lds, GVr, Ub, INP(11), INP(12), INP(13), A2, out + O_GV + (size_t)b * 32 * 1024, MP + b * 32, 32, gu & 7, tid);
                }
            }
        } else if (ph == 3 && PHEN(3)) {
            pg8::Gemm g{A2, (const bf16*)(ws + WS_W2), M, D, D}; pg8::SplitOrder S; S.init(bid, D);
            pg8::EpiRes<true> E{xp, xs, H, A1, ss + SSN, (float*)(ws + WS_BIG)};
            pg8::gemm_phase<pg8::EpiRes<true>, pg8::SplitOrder, true, true>(lds3, g, S, E, tid);
            if (bid >= 128) CONV_RANGE(1000, 1400, bid - 128, 128);
        } else if ((ph == 4 || ph == 10) && PHEN(ph)) {
#ifdef DBG_HIDFILL
            { const int gt = bid * NTHR + tid, NGT = G * NTHR;
              for (size_t i = gt; i < (size_t)M * DFF / 2; i += NGT) { const unsigned a_ = (unsigned)((i * 37u) & 255u); ((unsigned*)HID)[i] = pk2((float)a_ * (1.f / 256.f), (float)(255u - a_) * (1.f / 512.f)); } }
            if (false)
#endif
            {
            pg8::Gemm g{A1, (const bf16*)(ws + (ph == 4 ? WS_WU0 : WS_WU1)), M, DFF, D}; pg8::StaticOrder S; S.init(M, DFF, G, bid);
            pg8::EpiUp E{ss + (ph == 4 ? SSN : 3 * SSN), HID};
            pg8::gemm_phase<pg8::EpiUp, pg8::StaticOrder, true, true>(lds3, g, S, E, tid);
            }
            if (bid >= 64) {
                if (ph == 4) { CONV_RANGE(1400, 5120, bid - 64, 192);
                    LAS float* scr2 = (LAS float*)(lds3 + wave * 16384);
                    for (int it = 3096 + (bid - 64) * NWAVES + wave; it < 4096; it += 192 * NWAVES) tr64_item(INP(19), 8192, 2048, (bf16*)(ws + WS_WD0), nullptr, scr2, it, lane); }
                else CONV_RANGE(9498, 13312, bid - 64, 192);
            }
        } else if ((ph == 5 || ph == 9 || ph == 11) && PHEN(ph)) {
            const bf16* Aop = ph == 9 ? A2 : HID; const bf16* Bop = (const bf16*)(ws + (ph == 5 ? WS_WD0 : ph == 9 ? WS_W6 : WS_WD1));
            pg8::Gemm g{Aop, Bop, M, D, ph == 9 ? D : DFF}; pg8::SplitOrder S; S.init(bid, ph == 9 ? D : DFF);
#ifndef DBG_P5X
#define DBG_P5X false
#endif
            pg8::EpiRes<DBG_P5X> E{xp, xs, H, A1, ss + (ph == 5 ? 2 * SSN : ph == 9 ? 3 * SSN : 4 * SSN), (float*)(ws + (ph == 9 ? WS_BIG : WS_A2))};
            pg8::gemm_phase<pg8::EpiRes<DBG_P5X>, pg8::SplitOrder, true, true>(lds3, g, S, E, tid);
            if (bid >= 128) { if (ph == 5) CONV_RANGE(5120, 6156, bid - 128, 128); else if (ph == 9) CONV_RANGE(9230, 9498, bid - 128, 128); }
        } else if (ph == 6 && PHEN(6)) {
            pg8::Gemm g{A1, (const bf16*)(ws + WS_W5), M, DFF, D}; pg8::StaticOrder S; S.init(M, DFF, G, bid);
            pg8::EpiInOdd E{ss + 2 * SSN, INP(16), QH, FH, VH, GH};
            pg8::gemm_phase<pg8::EpiInOdd, pg8::StaticOrder, true, true>(lds3, g, S, E, tid);
            if (bid >= 64) CONV_RANGE(6156, 9230, bid - 64, 192);
        } else if (ph == 7 && PHEN(7)) {
            for (int u = bid; u < 240; u += G) { const int hd = u / 15, g = u % 15;
                hg_unit<false>(lds, QH, FH, VH, GH, INP(17), A2, hd, g * 512, 16, 0, nullptr, SEG, DEC, 0, SEG + (size_t)(hd * 16 + g) * 16384, DEC + (size_t)(hd * 16 + g) * 128, tid, DEC + 32768 + hd * 16 + g); }
        } else if (ph == 14 && PHEN(14)) {
            const int gt = bid * NTHR + tid, NGT = G * NTHR;
            for (int el = gt; el < 16 * 16384; el += NGT) {
                const int hd = el >> 14, de = el & 16383, dd = de >> 7;
                float L[15], Dg[15];
#pragma unroll
                for (int g = 0; g < 15; ++g) { L[g] = SEG[(size_t)(hd * 16 + g) * 16384 + de]; Dg[g] = DEC[(size_t)(hd * 16 + g) * 128 + dd]; }
                float acc = 0.f;
#pragma unroll
                for (int g = 0; g < 15; ++g) { acc = Dg[g] * acc + L[g]; SEG[(size_t)(hd * 16 + g) * 16384 + de] = acc; }
            }
        } else if (ph == 8 && PHEN(8)) {
            for (int u = bid; u < 512; u += G) {
                if (u < 256) { const int hd = u >> 4, g = u & 15;
                    hg_unit<true>(lds, QH, FH, VH, GH, INP(17), A2, hd, g * 512, 16, g ? 1 : 0, SEG + (size_t)(hd * 16 + (g ? g - 1 : 0)) * 16384, SEG, DEC, g, g == 15 ? out + O_SP + (size_t)hd * 16384 : nullptr, nullptr, tid);
                } else { const int su = u - 256, b = su >> 4, hd = su & 15;
                    hg_unit<true>(lds, QH, FH, VH, GH, INP(17), A2, hd, MP + b * 32, 1, 1, INP(4) + (size_t)(b * 16 + hd) * 16384, SEG, DEC, 0, out + O_SS + (size_t)(b * 16 + hd) * 16384, nullptr, tid); }
            }
        } else if (ph == 13 && PHEN(13)) {
            const int ssi = ++nfin;
            const float* part = (const float*)(ws + ((ssi & 1) == 0 ? WS_A2 : WS_BIG));
            const int gw = bid * NWAVES + wave, NGW = G * NWAVES;
            for (int it = gw; it < 512 * 4; it += NGW) {
                const int rs = it >> 2, qd = it & 3, m = MP + rs; const size_t co = (size_t)qd * 512 + 4 * lane;
                f32x4 h0 = *(const f32x4*)(H + (size_t)m * D + co), h1 = *(const f32x4*)(H + (size_t)m * D + co + 256);
#pragma unroll
                for (int sl = 0; sl < 8; ++sl) { const float* pp = part + ((size_t)sl * 512 + rs) * D + co; h0 += __builtin_nontemporal_load((const f32x4*)pp); h1 += __builtin_nontemporal_load((const f32x4*)(pp + 256)); }
                *(f32x4*)(H + (size_t)m * D + co) = h0; *(f32x4*)(H + (size_t)m * D + co + 256) = h1;
                v2u w; w.x = pk2(h0[0], h0[1]); w.y = pk2(h0[2], h0[3]); *(v2u*)(A1 + (size_t)m * D + co) = w;
                w.x = pk2(h1[0], h1[1]); w.y = pk2(h1[2], h1[3]); *(v2u*)(A1 + (size_t)m * D + co + 256) = w;
                float sq = ((h0[0] * h0[0] + h0[1] * h0[1]) + (h0[2] * h0[2] + h0[3] * h0[3])) + ((h1[0] * h1[0] + h1[1] * h1[1]) + (h1[2] * h1[2] + h1[3] * h1[3]));
                sq = wave_sum(sq);
                if (lane < 8) ss[(size_t)ssi * SSN + (size_t)m * 32 + qd * 8 + lane] = lane == 0 ? sq : 0.f;
            }
        } else if (ph == 12 && PHEN(12)) {
            const int gw = bid * NWAVES + wave, NGW = G * NWAVES;
            for (int m = gw; m < M; m += NGW) {
                f32x4 hv[8]; float sq = 0.f;
#ifdef DBG_DUMPQH
#pragma unroll
                for (int j = 0; j < 8; ++j) *(f32x4*)(out + (size_t)m * D + 4 * lane + 256 * j) = *(const f32x4*)(DBG_DUMPQH + (size_t)m * D + 4 * lane + 256 * j);
                continue;
#endif
#ifdef DBG_DUMPA2
                if (DBG_DUMPA2 == 2 && (m >= MP || (m & 511) < 64)) continue;
                if (DBG_DUMPA2 == 3 && m < MP) continue;
#pragma unroll
                for (int j = 0; j < 8; ++j) { const v2u w = *(const v2u*)(DBG_A2PTR + (size_t)m * D + 4 * lane + 256 * j);
                    *(f32x4*)(out + (size_t)m * D + 4 * lane + 256 * j) = (f32x4){bf2f((unsigned short)(w.x & 0xffff)), bf2f((unsigned short)(w.x >> 16)), bf2f((unsigned short)(w.y & 0xffff)), bf2f((unsigned short)(w.y >> 16))}; }
                continue;
#endif
#pragma unroll
                for (int j = 0; j < 8; ++j) { hv[j] = __builtin_nontemporal_load((const f32x4*)(H + (size_t)m * D + 4 * lane + 256 * j));
                    if (m >= MP) {
#pragma unroll
                        for (int sl = 0; sl < 8; ++sl) hv[j] += __builtin_nontemporal_load((const f32x4*)((const float*)(ws + WS_A2) + ((size_t)sl * 512 + (m - MP)) * D + 4 * lane + 256 * j)); } sq += (hv[j][0] * hv[j][0] + hv[j][1] * hv[j][1]) + (hv[j][2] * hv[j][2] + hv[j][3] * hv[j][3]); }
                const float rstd = rsqrtf(wave_sum(sq) * (1.f / 2048.f) + 1e-6f);
#pragma unroll
                for (int j = 0; j < 8; ++j) { const f32x4 gn = *(const f32x4*)(INP(7) + 4 * lane + 256 * j);
                    __builtin_nontemporal_store(hv[j] * rstd * gn, (f32x4*)(out + (size_t)m * D + 4 * lane + 256 * j)); }
            }
        }
        if (st + 1 < a.ph_hi) { if (a.ph_lo < 0) grid.sync(); else xcd_barrier(xbar); }
    }
#ifdef EXTRA_SYNC
    for (int i = 0; i < EXTRA_SYNC; ++i) xcd_barrier(xbar);
#endif
}

#undef xp
#undef xs
#undef ss
#undef cs
#undef A1
#undef A2
#undef H
#undef HID
#undef Qb
#undef Kpb
#undef Ksb
#undef Vtp
#undef Vts
#undef Ub
#undef GVr
#undef QH
#undef FH
#undef VH
#undef GH
#undef SEG
#undef DEC
#undef CONV_L1
#undef CONV_RANGE
extern "C" void kernel_launch(void* const* d_in, const int* in_sizes, int n_in, void* d_out, int out_size, void* d_ws, size_t ws_size, hipStream_t stream) {
    static int grid = 0;
    if (grid == 0) {
        if (n_in != 20 || ws_size < WS_END) { fprintf(stderr, "kernel_launch: unexpected n_in %d / ws %zu\n", n_in, ws_size); grid = -1; return; }
        int dev = 0, cus = 0, per_cu = 0;
        (void)hipGetDevice(&dev); (void)hipDeviceGetAttribute(&cus, hipDeviceAttributeMultiprocessorCount, dev);
        if (hipFuncSetAttribute((const void*)mk_fwd, hipFuncAttributeMaxDynamicSharedMemorySize, LDS_BYTES) != hipSuccess) { fprintf(stderr, "kernel_launch: hipFuncSetAttribute failed\n"); grid = -1; return; }
        if (hipOccupancyMaxActiveBlocksPerMultiprocessor(&per_cu, (const void*)mk_fwd, NTHR, LDS_BYTES) != hipSuccess || per_cu < 1) { fprintf(stderr, "kernel_launch: occupancy query says %d\n", per_cu); per_cu = 1; }
        (void)hipGetLastError();
        grid = cus * 1;
        if (grid <= 0) grid = 256;
    }
    if (grid < 0) return;
    (void)hipMemsetAsync(d_ws, 0, 65536, stream);
    Args a{};
    for (int i = 0; i < 20; ++i) a.in[i] = (const float*)d_in[i];
    a.out = (float*)d_out; a.ws = (unsigned char*)d_ws;
#ifdef DBG_FILL
    (void)hipMemsetAsync(d_out, 0, (size_t)23920640 * 4, stream);
#endif
#if MK_PER_PHASE
    for (int ph = 0; ph < NPH; ++ph) { a.ph_lo = ph; a.ph_hi = ph + 1; hipLaunchKernelGGL(mk_fwd, dim3(grid), dim3(NTHR), LDS_BYTES, stream, a); }
#else
    a.ph_lo = 0; a.ph_hi = SEQ_N;
    void* args[] = {&a};
    hipError_t e = hipLaunchCooperativeKernel((const void*)mk_fwd, dim3(grid), dim3(NTHR), args, LDS_BYTES, stream);
    if (e != hipSuccess) fprintf(stderr, "cooperative launch failed: %s (grid %d)\n", hipGetErrorString(e), grid);
#endif
}
```
